# Optimizing an MI355X kernel written in HIP

```python
import math
import jax
import jax.numpy as jnp
from jax import lax
import numpy as np

D_MODEL = 2048
BATCH = 4
SEQ = 2048
DEPTH = 2
DEC_BATCH = 8
DEC_SEQ = 1
PAST_LEN = 16384
PAGE_SIZE = 128

HEAD_DIM = 128
MIX_WIDTH = D_MODEL
NSA_HEADS = MIX_WIDTH // (2 * HEAD_DIM)
NSA_KV = 2
NSA_HPG = NSA_HEADS // NSA_KV
GDN_HEADS = MIX_WIDTH // (2 * HEAD_DIM)
GDN_DK = HEAD_DIM
GDN_DV = HEAD_DIM
ROT_DIM = HEAD_DIM // 4
ROPE_THETA = 500000.0
BLOCK = 64
TOPN = 16
WINDOW = 512
CMP_HID = 256
NSA_QBLOCK = 64
CONV_W = 4
GDN_CHUNK = 64
D_FF = -(-8 * D_MODEL // (3 * 256)) * 256
EPS = 1e-6
NSA_Q_W = NSA_HEADS * HEAD_DIM
KV_W = NSA_KV * HEAD_DIM
GATE_W = 3 * NSA_HEADS
GDN_QK_W = GDN_HEADS * GDN_DK
GDN_V_W = GDN_HEADS * GDN_DV
CONV_CH = 2 * GDN_QK_W + GDN_V_W
IN_SPLITS = (NSA_Q_W, KV_W, KV_W, KV_W, KV_W, KV_W, KV_W, GATE_W, CONV_CH, GDN_HEADS, GDN_HEADS, GDN_V_W)
IN_W = sum(IN_SPLITS)

kernel_name = 'hymba_nsa_gdn_decode_step'


def rmsnorm(x, g):
    xf = x.astype(jnp.float32)
    y = xf * lax.rsqrt(jnp.mean(xf * xf, axis=-1, keepdims=True) + EPS) * g.astype(jnp.float32)
    return y.astype(x.dtype)


def l2norm(x):
    xf = x.astype(jnp.float32)
    return xf * lax.rsqrt(jnp.sum(xf * xf, axis=-1, keepdims=True) + EPS)


def rope(x, pos):
    half = ROT_DIM // 2
    inv = ROPE_THETA ** (-jnp.arange(half, dtype=jnp.float32) * 2.0 / ROT_DIM)
    ang = pos.astype(jnp.float32)[:, None] * inv
    cos, sin = jnp.cos(ang)[:, None, :], jnp.sin(ang)[:, None, :]
    xf = x.astype(jnp.float32)
    x1, x2, rest = xf[..., :half], xf[..., half:ROT_DIM], xf[..., ROT_DIM:]
    return jnp.concatenate([x1 * cos - x2 * sin, x2 * cos + x1 * sin, rest], -1).astype(x.dtype)


def masked_softmax(s, mask):
    s = jnp.where(mask, s.astype(jnp.float32), -jnp.inf)
    m = jnp.max(s, axis=-1, keepdims=True)
    m = jnp.where(jnp.isfinite(m), m, 0.0)
    e = jnp.where(mask, jnp.exp(s - m), 0.0)
    return e / jnp.maximum(jnp.sum(e, axis=-1, keepdims=True), 1e-30)


def kv_rows(k, v):
    return jnp.stack([k, v], axis=3).transpose(0, 2, 1, 3, 4)


def compress_blocks(rows, pe, w1, w2):
    B, L, G, D = rows.shape
    nb = L // BLOCK
    blk = rows.reshape(B, nb, BLOCK, G, D) + pe[None, None, :, None, :].astype(rows.dtype)
    blk = blk.transpose(0, 1, 3, 2, 4).reshape(B, nb, G, BLOCK * D)
    return jax.nn.gelu(blk @ w1) @ w2


def nsa_core(q, q_pos, gates, kc, vc, sel_gather, n_sel, kw, vw, kw_pos):
    B, Tq = q.shape[:2]
    scale = HEAD_DIM ** -0.5
    qf = q.reshape(B, Tq, NSA_KV, NSA_HPG, HEAD_DIM)
    nbc = kc.shape[1]
    j = jnp.arange(nbc)
    cmask = (j * BLOCK + (BLOCK - 1))[None, :] <= q_pos[:, None]
    s_c = jnp.einsum('btghd,bjgd->btghj', qf, kc).astype(jnp.float32) * scale
    p_c = masked_softmax(s_c, cmask[None, :, None, None, :])
    o_c = jnp.einsum('btghj,bjgd->btghd', p_c, vc)
    imp = jnp.sum(p_c, axis=3)
    cur = q_pos // BLOCK
    forced = (j[None] == 0) | (j[None] == cur[:, None]) | (j[None] == cur[:, None] - 1)
    future = j[None] > cur[:, None]
    score = jnp.where(forced[None, :, None, :], jnp.inf, jnp.where(future[None, :, None, :], -jnp.inf, imp))
    _, idx = lax.top_k(score, n_sel)
    ks, vs = sel_gather(idx)
    kpos = idx[..., None] * BLOCK + jnp.arange(BLOCK)
    smask = (kpos <= q_pos[None, :, None, None, None]).reshape(B, Tq, NSA_KV, 1, n_sel * BLOCK)
    s_s = jnp.einsum('btghd,btgnrd->btghnr', qf, ks).astype(jnp.float32) * scale
    p_s = masked_softmax(s_s.reshape(B, Tq, NSA_KV, NSA_HPG, n_sel * BLOCK), smask)
    o_s = jnp.einsum('btghm,btgmd->btghd', p_s, vs.reshape(B, Tq, NSA_KV, n_sel * BLOCK, HEAD_DIM))
    wmask = (kw_pos[None, :] <= q_pos[:, None]) & (kw_pos[None, :] >= q_pos[:, None] - WINDOW) & (kw_pos[None, :] >= 0)
    s_w = jnp.einsum('btghd,blgd->btghl', qf, kw).astype(jnp.float32) * scale
    p_w = masked_softmax(s_w, wmask[None, :, None, None, :])
    o_w = jnp.einsum('btghl,blgd->btghd', p_w, vw)
    g = gates.reshape(B, Tq, NSA_KV, NSA_HPG, 3)
    o = g[..., 0:1] * o_c + g[..., 1:2] * o_s + g[..., 2:3] * o_w
    return o.reshape(B, Tq, NSA_HEADS * HEAD_DIM).astype(q.dtype)


def gated_delta_chunked(q, k, v, g, beta, s0):
    B, T, H, _ = q.shape
    DV = v.shape[-1]
    C = GDN_CHUNK
    n = -(-T // C)
    pad = n * C - T

    def chunks(t):
        t = jnp.pad(t, ((0, 0), (0, pad)) + ((0, 0),) * (t.ndim - 2))
        t = t.reshape((B, n, C) + t.shape[2:])
        return jnp.moveaxis(t, 3, 1)

    q, k, v, g, beta = (chunks(t) for t in (q, k, v, g, beta))
    gc = jnp.cumsum(g, axis=-1)
    tri = jnp.tril(jnp.ones((C, C), bool))
    strict = jnp.tril(jnp.ones((C, C), bool), -1)
    decay = jnp.exp(jnp.where(tri, gc[..., :, None] - gc[..., None, :], -jnp.inf))
    kb = k * beta[..., None]
    L = jnp.where(strict, jnp.einsum('bhnid,bhnjd->bhnij', kb, k) * decay, 0.0)
    rhs = jnp.concatenate([v * beta[..., None], kb * jnp.exp(gc)[..., None]], axis=-1)
    sol = lax.linalg.triangular_solve(L + jnp.eye(C, dtype=L.dtype), rhs, left_side=True, lower=True, unit_diagonal=True)
    u, w = sol[..., :DV], sol[..., DV:]
    qk = jnp.where(tri, jnp.einsum('bhnid,bhnjd->bhnij', q, k) * decay, 0.0)

    def step(S, xs):
        q_c, k_c, u_c, w_c, g_c, qk_c = xs
        v_new = u_c - jnp.einsum('bhcd,bhde->bhce', w_c, S)
        o = jnp.einsum('bhcd,bhde->bhce', q_c * jnp.exp(g_c)[..., None], S) + jnp.einsum('bhij,bhje->bhie', qk_c, v_new)
        g_last = g_c[..., -1:]
        S = S * jnp.exp(g_last)[..., None] + jnp.einsum('bhcd,bhce->bhde', k_c * jnp.exp(g_last - g_c)[..., None], v_new)
        return S, o

    xs = tuple(jnp.moveaxis(t, 2, 0) for t in (q, k, u, w, gc, qk))
    S, o = lax.scan(step, s0, xs)
    o = o.transpose(1, 0, 3, 2, 4).reshape(B, n * C, H, DV)[:, :T]
    return o, S


def gdn_mixer(conv_in, a, b, z, conv_buf, s0, conv_w, a_log, dt_bias, norm_w):
    B, T, _ = conv_in.shape
    xc = jnp.concatenate([conv_buf.astype(conv_in.dtype), conv_in], axis=1)
    y = lax.conv_general_dilated(xc, conv_w.astype(xc.dtype)[:, None, :], window_strides=(1,), padding='VALID',
                                 dimension_numbers=('NWC', 'WIO', 'NWC'), feature_group_count=CONV_CH)
    y = jax.nn.silu(y)
    q, k, v = jnp.split(y, [GDN_QK_W, 2 * GDN_QK_W], axis=-1)
    q = l2norm(q.reshape(B, T, GDN_HEADS, GDN_DK)) * (GDN_DK ** -0.5)
    k = l2norm(k.reshape(B, T, GDN_HEADS, GDN_DK))
    v = v.reshape(B, T, GDN_HEADS, GDN_DV).astype(jnp.float32)
    beta = jax.nn.sigmoid(b.astype(jnp.float32))
    g = -jnp.exp(a_log.astype(jnp.float32)) * jax.nn.softplus(a.astype(jnp.float32) + dt_bias.astype(jnp.float32))
    o, S = gated_delta_chunked(q, k, v, g, beta, s0.astype(jnp.float32))
    o = rmsnorm(o, norm_w) * jax.nn.silu(z.reshape(B, T, GDN_HEADS, GDN_DV).astype(jnp.float32))
    return o.reshape(B, T, GDN_V_W).astype(conv_in.dtype), S.astype(conv_in.dtype), xc[:, -(CONV_W - 1):]


def run_trunk(x, c, pos, nsa_fn, gdn_fn, w_ada, b_ada, g_pre_mix, w_in, w_out, g_post_mix, g_pre_ffn, w_gate, w_up, w_down, g_post_ffn):
    B, T, _ = x.shape
    offs = np.cumsum(IN_SPLITS)[:-1].tolist()
    states = []
    for l in range(DEPTH):
        mod = jax.nn.silu(c) @ w_ada[l] + b_ada[l]
        sh1, sc1, ga1, sh2, sc2, ga2 = jnp.split(mod[:, None, :], 6, axis=-1)
        h = rmsnorm(x, g_pre_mix[l]) * (1 + sc1) + sh1
        q, kc, vc, ks, vs, kw, vw, gl, conv_in, a, bb, z = jnp.split(h @ w_in[l], offs, axis=-1)
        q = rope(q.reshape(B, T, NSA_HEADS, HEAD_DIM), pos)
        kc, ks, kw = (rope(t.reshape(B, T, NSA_KV, HEAD_DIM), pos) for t in (kc, ks, kw))
        vc, vs, vw = (t.reshape(B, T, NSA_KV, HEAD_DIM) for t in (vc, vs, vw))
        gates = jax.nn.sigmoid(gl.astype(jnp.float32)).reshape(B, T, NSA_HEADS, 3)
        o_nsa, nsa_state = nsa_fn(l, q, gates, kc, vc, ks, vs, kw, vw)
        o_gdn, gdn_state = gdn_fn(l, conv_in, a, bb, z)
        mix = jnp.concatenate([o_nsa, o_gdn], axis=-1) @ w_out[l]
        x = x + ga1 * rmsnorm(mix, g_post_mix[l])
        h = rmsnorm(x, g_pre_ffn[l]) * (1 + sc2) + sh2
        f = (jax.nn.silu(h @ w_gate[l]) * (h @ w_up[l])) @ w_down[l]
        x = x + ga2 * rmsnorm(f, g_post_ffn[l])
        states.append(nsa_state + gdn_state)
    stacked = [jnp.stack(s, axis=1) for s in zip(*states)]
    return x, stacked


def setup_inputs(seed: int = 0) -> dict:
    key = jax.random.key(seed)
    keys = iter(jax.random.split(key, 40))

    def nrm(shape, scale):
        return jax.random.normal(next(keys), shape, jnp.float32) * scale

    def gain(width=D_MODEL):
        return 1.0 + nrm((DEPTH, width), 0.05)

    n_pages = PAST_LEN // PAGE_SIZE
    n_pool = (5 * DEC_BATCH * n_pages + 3) // 4
    w_buf = min(WINDOW, PAST_LEN)
    perm = jax.random.permutation(next(keys), n_pool)
    page_table = perm[:DEC_BATCH * n_pages].reshape(DEC_BATCH, n_pages).astype(jnp.int32)
    dt = jnp.exp(jax.random.uniform(next(keys), (DEPTH, GDN_HEADS), jnp.float32, math.log(1e-3), math.log(1e-1)))
    return {
        'x_prompt': nrm((BATCH, SEQ, D_MODEL), 1.0),
        'x_sample': nrm((DEC_BATCH, DEC_SEQ, D_MODEL), 1.0),
        'cache_cmp_kv': nrm((n_pool, DEPTH, NSA_KV, PAGE_SIZE, 2, HEAD_DIM), 1.0),
        'cache_sel_kv': nrm((n_pool, DEPTH, NSA_KV, PAGE_SIZE, 2, HEAD_DIM), 1.0),
        'cache_win_kv': nrm((DEC_BATCH, DEPTH, NSA_KV, w_buf, 2, HEAD_DIM), 1.0),
        'state_gdn': nrm((DEC_BATCH, DEPTH, GDN_HEADS, GDN_DK, GDN_DV), GDN_DK ** -0.5),
        'state_conv': nrm((DEC_BATCH, DEPTH, CONV_W - 1, CONV_CH), 1.0),
        'page_table': page_table,
        'c_prompt': nrm((BATCH, D_MODEL), 1.0),
        'c_sample': nrm((DEC_BATCH, D_MODEL), 1.0),
        'w_ada': nrm((DEPTH, D_MODEL, 6 * D_MODEL), 0.5 * D_MODEL ** -0.5),
        'b_ada': nrm((DEPTH, 6 * D_MODEL), 0.02),
        'g_pre_mix': gain(),
        'w_in': nrm((DEPTH, D_MODEL, IN_W), D_MODEL ** -0.5),
        'cmp_pe': nrm((DEPTH, 2, BLOCK, HEAD_DIM), 0.1),
        'cmp_w1': nrm((DEPTH, 2, BLOCK * HEAD_DIM, CMP_HID), (BLOCK * HEAD_DIM) ** -0.5),
        'cmp_w2': nrm((DEPTH, 2, CMP_HID, HEAD_DIM), CMP_HID ** -0.5),
        'conv_w': nrm((DEPTH, CONV_W, CONV_CH), CONV_W ** -0.5),
        'gdn_a_log': jnp.log(jax.random.uniform(next(keys), (DEPTH, GDN_HEADS), jnp.float32, 1.0, 16.0)),
        'gdn_dt_bias': dt + jnp.log(-jnp.expm1(-dt)),
        'gdn_norm': gain(GDN_DV),
        'w_out': nrm((DEPTH, MIX_WIDTH, D_MODEL), MIX_WIDTH ** -0.5),
        'g_post_mix': gain(),
        'g_pre_ffn': gain(),
        'w_gate': nrm((DEPTH, D_MODEL, D_FF), D_MODEL ** -0.5),
        'w_up': nrm((DEPTH, D_MODEL, D_FF), D_MODEL ** -0.5),
        'w_down': nrm((DEPTH, D_FF, D_MODEL), D_FF ** -0.5),
        'g_post_ffn': gain(),
    }


def reference(x_prompt, x_sample, cache_cmp_kv, cache_sel_kv, cache_win_kv, state_gdn, state_conv, page_table,
              c_prompt, c_sample, w_ada, b_ada, g_pre_mix, w_in, cmp_pe, cmp_w1, cmp_w2, conv_w, gdn_a_log,
              gdn_dt_bias, gdn_norm, w_out, g_post_mix, g_pre_ffn, w_gate, w_up, w_down, g_post_ffn):
    bi_kv = jnp.arange(NSA_KV)[None, None, :, None]

    def comp(l, rows, i):
        return compress_blocks(rows, cmp_pe[l, i], cmp_w1[l, i], cmp_w2[l, i])

    def gdn_run(l, conv_in, a, b, z, buf0, s0):
        o, S, buf = gdn_mixer(conv_in, a, b, z, buf0, s0, conv_w[l], gdn_a_log[l], gdn_dt_bias[l], gdn_norm[l])
        return o, (S, buf)

    def nsa_prompt(l, q, gates, kc, vc, ks, vs, kw, vw):
        B, S = q.shape[:2]
        nb = S // BLOCK
        kcb, vcb = comp(l, kc, 0), comp(l, vc, 1)
        ks_store = ks.reshape(B, nb, BLOCK, NSA_KV, HEAD_DIM).transpose(0, 3, 1, 2, 4)
        vs_store = vs.reshape(B, nb, BLOCK, NSA_KV, HEAD_DIM).transpose(0, 3, 1, 2, 4)
        bi = jnp.arange(B)[:, None, None, None]

        def gather(idx):
            return ks_store[bi, bi_kv, idx], vs_store[bi, bi_kv, idx]

        kw_pad = jnp.pad(kw, ((0, 0), (WINDOW, 0), (0, 0), (0, 0)))
        vw_pad = jnp.pad(vw, ((0, 0), (WINDOW, 0), (0, 0), (0, 0)))
        n_sel = min(TOPN, nb)

        def step(i):
            q0 = i * NSA_QBLOCK
            qb = lax.dynamic_slice_in_dim(q, q0, NSA_QBLOCK, axis=1)
            gb = lax.dynamic_slice_in_dim(gates, q0, NSA_QBLOCK, axis=1)
            kwb = lax.dynamic_slice_in_dim(kw_pad, q0, WINDOW + NSA_QBLOCK, axis=1)
            vwb = lax.dynamic_slice_in_dim(vw_pad, q0, WINDOW + NSA_QBLOCK, axis=1)
            q_pos = q0 + jnp.arange(NSA_QBLOCK)
            kw_pos = q0 - WINDOW + jnp.arange(WINDOW + NSA_QBLOCK)
            return nsa_core(qb, q_pos, gb, kcb, vcb, gather, n_sel, kwb, vwb, kw_pos)

        o = lax.map(step, jnp.arange(S // NSA_QBLOCK))
        o = jnp.moveaxis(o, 0, 1).reshape(B, S, NSA_Q_W)
        wl = min(WINDOW, S)
        return o, (kv_rows(kc, vc), kv_rows(ks, vs), kv_rows(kw[:, S - wl:], vw[:, S - wl:]))

    def gdn_prompt(l, conv_in, a, b, z):
        B = conv_in.shape[0]
        buf0 = jnp.zeros((B, CONV_W - 1, CONV_CH), conv_in.dtype)
        s0 = jnp.zeros((B, GDN_HEADS, GDN_DK, GDN_DV), jnp.float32)
        return gdn_run(l, conv_in, a, b, z, buf0, s0)

    def nsa_sample(l, q, gates, kc, vc, ks, vs, kw, vw):
        B, T = q.shape[:2]
        npb = PAST_LEN // BLOCK
        nb_new = -(-T // BLOCK)
        pad = nb_new * BLOCK - T
        bpp = PAGE_SIZE // BLOCK
        bi = jnp.arange(B)[:, None, None, None]

        def pad_rows(t):
            return jnp.pad(t, ((0, 0), (0, pad), (0, 0), (0, 0)))

        pages = cache_cmp_kv.reshape(-1, NSA_KV, PAGE_SIZE, 2, HEAD_DIM)[page_table * DEPTH + l]
        past = pages.transpose(0, 1, 3, 4, 2, 5).reshape(B, PAST_LEN, 2, NSA_KV, HEAD_DIM).astype(kc.dtype)
        kcb = comp(l, jnp.concatenate([past[:, :, 0], pad_rows(kc)], axis=1), 0)
        vcb = comp(l, jnp.concatenate([past[:, :, 1], pad_rows(vc)], axis=1), 1)
        sel_flat = cache_sel_kv.reshape(-1, BLOCK, 2, HEAD_DIM)
        new_store = jnp.stack([pad_rows(ks), pad_rows(vs)], axis=3)
        new_store = new_store.reshape(B, nb_new, BLOCK, NSA_KV, 2, HEAD_DIM).transpose(0, 3, 1, 2, 4, 5)

        def gather(idx):
            in_past = idx < npb
            jp = jnp.minimum(idx, npb - 1)
            phys = page_table[bi, jp // bpp]
            lin = ((phys * DEPTH + l) * NSA_KV + bi_kv) * bpp + jp % bpp
            kv_past = sel_flat[lin].astype(new_store.dtype)
            kv_new = new_store[bi, bi_kv, jnp.clip(idx - npb, 0, nb_new - 1)]
            kv = jnp.where(in_past[..., None, None, None], kv_past, kv_new)
            return kv[..., 0, :], kv[..., 1, :]

        win = cache_win_kv[:, l]
        w_buf = win.shape[2]
        kw_all = jnp.concatenate([win[..., 0, :].transpose(0, 2, 1, 3).astype(kw.dtype), kw], axis=1)
        vw_all = jnp.concatenate([win[..., 1, :].transpose(0, 2, 1, 3).astype(vw.dtype), vw], axis=1)
        kw_pos = PAST_LEN - w_buf + jnp.arange(w_buf + T)
        q_pos = PAST_LEN + jnp.arange(T)
        o = nsa_core(q, q_pos, gates, kcb, vcb, gather, min(TOPN, npb + nb_new), kw_all, vw_all, kw_pos)
        return o, (kv_rows(kc, vc), kv_rows(ks, vs), kv_rows(kw_all[:, -w_buf:], vw_all[:, -w_buf:]))

    def gdn_sample(l, conv_in, a, b, z):
        return gdn_run(l, conv_in, a, b, z, state_conv[:, l], state_gdn[:, l])

    y_prompt, p_states = run_trunk(x_prompt, c_prompt, jnp.arange(x_prompt.shape[1]), nsa_prompt, gdn_prompt,
                                   w_ada, b_ada, g_pre_mix, w_in, w_out, g_post_mix, g_pre_ffn, w_gate, w_up, w_down, g_post_ffn)
    y_sample, s_states = run_trunk(x_sample, c_sample, PAST_LEN + jnp.arange(x_sample.shape[1]), nsa_sample, gdn_sample,
                                   w_ada, b_ada, g_pre_mix, w_in, w_out, g_post_mix, g_pre_ffn, w_gate, w_up, w_down, g_post_ffn)
    p_cmp, p_sel, p_win, p_gdn, p_conv = p_states
    s_cmp, s_sel, s_win, s_gdn, s_conv = s_states
    return (y_prompt, y_sample, p_cmp, p_sel, p_win, p_gdn, p_conv, s_cmp, s_sel, s_win, s_gdn, s_conv)
```

```cpp
#include <hip/hip_runtime.h>
#include <cstdio>
#include <cstdint>

#ifndef ONE_LAUNCH
#define ONE_LAUNCH 1
#endif

#define LAS __attribute__((address_space(3)))
typedef unsigned short bf16;
typedef unsigned u32x4 __attribute__((ext_vector_type(4)));
typedef unsigned u32x2 __attribute__((ext_vector_type(2)));
typedef float f32x4 __attribute__((ext_vector_type(4)));
typedef float f32x2 __attribute__((ext_vector_type(2)));
typedef short bf16x8 __attribute__((ext_vector_type(8)));

namespace pg8 {
#define PG8_LAS __attribute__((address_space(3)))
typedef unsigned short bf16_t;
constexpr int BM = 256, BK = 64, HALF = 128, HTB = HALF * BK * 2  , STAGE_BYTES = 8 * HTB, NXCD = 8, WGM = 8;

__host__ __device__ __forceinline__ int lds_byte(int r, int c) { const int st = (r >> 4) * 2 + (c >> 5), rr = r & 15, cc = c & 31, ob = rr * 64 + cc * 2; return st * 1024 + (ob ^ (((ob >> 9) & 1) << 5)); }
__host__ __device__ __forceinline__ void stage_rc(int b, int& R, int& C) { const int st = b / 1024, sb = b % 1024, swz = sb ^ (((sb >> 9) & 1) << 5); R = (st >> 1) * 16 + swz / 64; C = (st & 1) * 32 + (swz % 64) / 2; }
__host__ __device__ __forceinline__ int perm32(int rho) { const int n = rho >> 4, i = rho & 15; return 8 * (i >> 2) + 4 * n + (i & 3); }

struct Unit { int pm, pn, pk; };
struct Gemm { const bf16_t* A; const bf16_t* Bt; int K; int ld; };

struct StaticOrder {
    int nM, nN, nwg, G, c;
    __host__ __device__ void init(int M, int N, int G_, int c_) { nM = M / BM; nN = N / BM; nwg = nM * nN; G = G_; c = c_; }
    __host__ __device__ bool next(int i, Unit& u) const {
        const long L = (long)i * G + c; if (L >= nwg) return false;
        int wgid = (int)L; { const int q = nwg / NXCD, r = nwg % NXCD, xcd = wgid % NXCD, off = wgid / NXCD; wgid = (xcd < r ? xcd * (q + 1) : r * (q + 1) + (xcd - r) * q) + off; }
        const int nig = WGM * nN, gid = wgid / nig, fm = gid * WGM, gsz = (nM - fm) < WGM ? (nM - fm) : WGM;
        u.pm = fm + ((wgid % nig) % gsz); u.pn = (wgid % nig) / gsz; u.pk = 0; return true;
    }
    __device__ __forceinline__ void a_ready(const Unit&) const {}
    __device__ __forceinline__ void done(const Unit&) const {}
};
struct OneUnit {
    int L, nsplit, pn_div;
    __host__ __device__ bool next(int i, Unit& u) const { if (i != 0 || L < 0) return false; u.pk = L % nsplit; u.pm = L / nsplit; u.pn = u.pm / pn_div; return true; }
    __device__ __forceinline__ void a_ready(const Unit&) const {}
    __device__ __forceinline__ void done(const Unit&) const {}
};
struct SplitOrder {
    int nU, G, c, nsplit, pn_div;
    __host__ __device__ bool next(int i, Unit& u) const {
        const long L = (long)i * G + c; if (L >= nU) return false;
        u.pk = (int)(L % nsplit); u.pm = (int)(L / nsplit); u.pn = u.pm / pn_div; return true;
    }
    __device__ __forceinline__ void a_ready(const Unit&) const {}
    __device__ __forceinline__ void done(const Unit&) const {}
};

typedef __bf16 bf16x2_v __attribute__((ext_vector_type(2)));
__device__ __forceinline__ unsigned cvt_pk_bf16(float lo, float hi) { const f32x2 v = {lo, hi}; return __builtin_bit_cast(unsigned, __builtin_convertvector(v, bf16x2_v)); }

struct EpiF32 {
    static constexpr bool PERM = false, AFTER_DRAIN = false;
    float* C; int ldc;
    __device__ __forceinline__ void operator()(const f32x4 (&acc)[2][2][4][2], const Unit& u, int wr, int wc, int fr, int fq) const {
        const int row0 = u.pm * BM + wr * 64 + fr, col0 = u.pn * BM + wc * 32 + 4 * fq;
#pragma unroll
        for (int ai = 0; ai < 2; ++ai)
#pragma unroll
            for (int m = 0; m < 4; ++m) { float* rowp = C + (size_t)(row0 + ai * HALF + m * 16) * ldc + col0;
#pragma unroll
                for (int bj = 0; bj < 2; ++bj)
#pragma unroll
                    for (int n = 0; n < 2; ++n) *(f32x4*)(rowp + bj * HALF + n * 16) = acc[ai][bj][m][n]; }
    }
    __device__ __forceinline__ void fused(f32x4 (&)[2][2][4][2], const Unit&, int, int, int, int, PG8_LAS unsigned char*, int, int) const {}
};
struct EpiBf16 {
    static constexpr bool PERM = true, AFTER_DRAIN = false;
    bf16_t* O; int ldc;
    __device__ __forceinline__ void operator()(const f32x4 (&acc)[2][2][4][2], const Unit& u, int wr, int wc, int fr, int fq) const {
        const int row0 = u.pm * BM + wr * 64 + fr, col0 = u.pn * BM + wc * 32 + 8 * fq;
#pragma unroll
        for (int ai = 0; ai < 2; ++ai)
#pragma unroll
            for (int m = 0; m < 4; ++m) { bf16_t* rowp = O + (size_t)(row0 + ai * HALF + m * 16) * ldc + col0;
#pragma unroll
                for (int bj = 0; bj < 2; ++bj) { const f32x4 v0 = acc[ai][bj][m][0], v1 = acc[ai][bj][m][1];
                    u32x4 w; w.x = cvt_pk_bf16(v0[0], v0[1]); w.y = cvt_pk_bf16(v0[2], v0[3]); w.z = cvt_pk_bf16(v1[0], v1[1]); w.w = cvt_pk_bf16(v1[2], v1[3]);
                    *(u32x4*)(rowp + bj * HALF) = w; } }
    }
    __device__ __forceinline__ void fused(f32x4 (&)[2][2][4][2], const Unit&, int, int, int, int, PG8_LAS unsigned char*, int, int) const {}
};
struct EpiPart {
    static constexpr bool PERM = false, AFTER_DRAIN = false;
    float* C; size_t slab;
    __device__ __forceinline__ void operator()(const f32x4 (&acc)[2][2][4][2], const Unit& u, int wr, int wc, int fr, int fq) const {
        const int row0 = u.pm * BM + wr * 64 + fr, col0 = wc * 32 + 4 * fq;
        float* base = C + (size_t)u.pk * slab;
#pragma unroll
        for (int ai = 0; ai < 2; ++ai)
#pragma unroll
            for (int m = 0; m < 4; ++m) { float* rowp = base + (size_t)(row0 + ai * HALF + m * 16) * 256 + col0;
#pragma unroll
                for (int bj = 0; bj < 2; ++bj)
#pragma unroll
                    for (int n = 0; n < 2; ++n) *(f32x4*)(rowp + bj * HALF + n * 16) = acc[ai][bj][m][n]; }
    }
    __device__ __forceinline__ void fused(f32x4 (&)[2][2][4][2], const Unit&, int, int, int, int, PG8_LAS unsigned char*, int, int) const {}
};
struct EpiSwiGLU {
    static constexpr bool PERM = true, AFTER_DRAIN = false;
    bf16_t* O; int ldc;
    __device__ __forceinline__ void operator()(const f32x4 (&acc)[2][2][4][2], const Unit& u, int wr, int wc, int fr, int fq) const {
        const int row0 = u.pm * BM + wr * 64 + fr, col0 = u.pn * HALF + wc * 32 + 8 * fq;
#pragma unroll
        for (int ai = 0; ai < 2; ++ai)
#pragma unroll
            for (int m = 0; m < 4; ++m) { bf16_t* rowp = O + (size_t)(row0 + ai * HALF + m * 16) * ldc + col0;
                float o[8];
#pragma unroll
                for (int n = 0; n < 2; ++n)
#pragma unroll
                    for (int j = 0; j < 4; ++j) { const float g = acc[ai][0][m][n][j], up = acc[ai][1][m][n][j]; o[n * 4 + j] = g / (1.0f + __expf(-g)) * up; }
                u32x4 w; w.x = cvt_pk_bf16(o[0], o[1]); w.y = cvt_pk_bf16(o[2], o[3]); w.z = cvt_pk_bf16(o[4], o[5]); w.w = cvt_pk_bf16(o[6], o[7]);
                *(u32x4*)rowp = w; }
    }
    __device__ __forceinline__ void fused(f32x4 (&)[2][2][4][2], const Unit&, int, int, int, int, PG8_LAS unsigned char*, int, int) const {}
};

template <class Epi, class Sched, bool ALIGN_EPI = false, bool SP2 = false>
__device__ __forceinline__ void gemm_phase(PG8_LAS unsigned char* lds, const Gemm g, const Sched& S, const Epi& E) {
    const int tid = threadIdx.x, wid = __builtin_amdgcn_readfirstlane(tid >> 6), lane = tid & 63, wr = wid >> 2, wc = wid & 3, fr = lane & 15, fq = lane >> 4;
    int K = g.K, ld = g.ld; asm volatile("" : "+s"(K), "+s"(ld));
    const int nt = K / BK;
    unsigned voffA[2], voffB[2];
#pragma unroll
    for (int i = 0; i < 2; ++i) { int R, C; stage_rc(tid * 16 + i * 8192, R, C); const int Rb = Epi::PERM ? ((R & ~31) + perm32(R & 31)) : R;
        voffA[i] = (unsigned)(R * ld + C) * 2u; voffB[i] = (unsigned)(Rb * ld + C) * 2u; }
    const size_t kstep = (size_t)(BK * 2);
    const size_t hstep = (size_t)HALF * ld * 2;
    const size_t tstep = 2 * hstep;
    const size_t sstep = (size_t)K * 2;
    const unsigned ldsw = (unsigned)wid * 1024u;
    const int aoff = lds_byte(wr * 64 + fr, fq * 8), boff = lds_byte(wc * 32 + fr, fq * 8);
#define PG8_SA(b, h) (((b) * 2 + (h)) * HTB)
#define PG8_SB(b, h) ((4 + (b) * 2 + (h)) * HTB)
#define PG8_STAGE(bufoff, gbase, voff) do { _Pragma("unroll") for (int _i = 0; _i < 2; ++_i) \
        __builtin_amdgcn_global_load_lds((const unsigned*)((const char*)(gbase) + (voff)[_i]), (PG8_LAS unsigned*)(lds + (bufoff) + ldsw + _i * 8192), 16, 0, 0); } while (0)
#define PG8_LDA(dst, b, h) do { _Pragma("unroll") for (int m = 0; m < 4; ++m) _Pragma("unroll") for (int k = 0; k < 2; ++k) dst[m][k] = *(const PG8_LAS bf16x8*)(lds + PG8_SA(b, h) + aoff + m * 2048 + k * 1024); } while (0)
#define PG8_LDB(dst, b, h) do { _Pragma("unroll") for (int n = 0; n < 2; ++n) _Pragma("unroll") for (int k = 0; k < 2; ++k) dst[n][k] = *(const PG8_LAS bf16x8*)(lds + PG8_SB(b, h) + boff + n * 2048 + k * 1024); } while (0)
#define PG8_MMA(ai, bj, At, Bt) do { __builtin_amdgcn_s_setprio(1); _Pragma("unroll") for (int m = 0; m < 4; ++m) _Pragma("unroll") for (int n = 0; n < 2; ++n) _Pragma("unroll") for (int k = 0; k < 2; ++k) \
        acc[ai][bj][m][n] = __builtin_amdgcn_mfma_f32_16x16x32_bf16(Bt[n][k], At[m][k], acc[ai][bj][m][n], 0, 0, 0); __builtin_amdgcn_s_setprio(0); } while (0)
#define PG8_WAIT_V(n) asm volatile("s_waitcnt vmcnt(" #n ")" ::: "memory")
#define PG8_WAIT_L(n) asm volatile("s_waitcnt lgkmcnt(" #n ")" ::: "memory")
#define PG8_BAR __builtin_amdgcn_s_barrier()
#define PG8_SCHED __builtin_amdgcn_sched_barrier(0)
    Unit cur, nxt; int ui = 0;
    if (!S.next(0, cur)) return;
    f32x4 acc[2][2][4][2];
#pragma unroll
    for (int a = 0; a < 2; ++a)
#pragma unroll
        for (int b = 0; b < 2; ++b)
#pragma unroll
            for (int m = 0; m < 4; ++m)
#pragma unroll
                for (int n = 0; n < 2; ++n) acc[a][b][m][n] = (f32x4){0.f, 0.f, 0.f, 0.f};
    bf16x8 At[4][2], B0[2][2], B1[2][2];
    const char* cA = (const char*)g.A + (size_t)cur.pm * tstep + (size_t)cur.pk * sstep; const char* cB = (const char*)g.Bt + (size_t)cur.pn * tstep + (size_t)cur.pk * sstep;
    S.a_ready(cur);
    if constexpr (SP2) {
        PG8_STAGE(PG8_SB(0, 0), cB, voffB); PG8_STAGE(PG8_SB(0, 1), cB + hstep, voffB); PG8_STAGE(PG8_SA(0, 0), cA, voffA); PG8_STAGE(PG8_SA(0, 1), cA + hstep, voffA);
        if (wr == 1) PG8_BAR;
        PG8_WAIT_V(2); PG8_BAR;
        PG8_STAGE(PG8_SB(1, 0), cB + kstep, voffB); PG8_STAGE(PG8_SA(1, 0), cA + kstep, voffA); PG8_STAGE(PG8_SB(1, 1), cB + hstep + kstep, voffB);
        PG8_WAIT_V(6); PG8_BAR;
    } else {
        PG8_STAGE(PG8_SB(0, 0), cB, voffB); PG8_STAGE(PG8_SA(0, 0), cA, voffA); PG8_STAGE(PG8_SB(0, 1), cB + hstep, voffB); PG8_STAGE(PG8_SA(0, 1), cA + hstep, voffA);
        if (wr == 1) PG8_BAR;
        PG8_WAIT_V(4); PG8_BAR;
        PG8_STAGE(PG8_SB(1, 0), cB + kstep, voffB); PG8_STAGE(PG8_SA(1, 0), cA + kstep, voffA); PG8_STAGE(PG8_SB(1, 1), cB + hstep + kstep, voffB);
        PG8_WAIT_V(6); PG8_BAR;
    }
    for (;;) {
        const bool has_next = S.next(ui + 1, nxt);
        const char* nA = has_next ? (const char*)g.A + (size_t)nxt.pm * tstep + (size_t)nxt.pk * sstep : cA; const char* nB = has_next ? (const char*)g.Bt + (size_t)nxt.pn * tstep + (size_t)nxt.pk * sstep : cB;
        for (int t = 0; t < nt; t += 2) {
            const bool last = (t == nt - 2);
            const char* a1 = cA + (size_t)(t + 1) * kstep;
            const char* a2 = last ? nA : cA + (size_t)(t + 2) * kstep; const char* b2 = last ? nB : cB + (size_t)(t + 2) * kstep;
            const char* a3 = a2 + kstep; const char* b3 = b2 + kstep;
            if (last && has_next) S.a_ready(nxt);
            if constexpr (SP2) {
            PG8_LDB(B0, 0, 0); PG8_LDB(B1, 0, 1); PG8_SCHED; PG8_LDA(At, 0, 0); PG8_STAGE(PG8_SA(1, 1), a1 + hstep, voffA);
            PG8_WAIT_V(8); PG8_WAIT_L(0); PG8_BAR; PG8_MMA(0, 0, At, B0); PG8_MMA(0, 1, At, B1); PG8_BAR; PG8_SCHED;
            PG8_LDA(At, 0, 1); PG8_STAGE(PG8_SB(0, 0), b2, voffB); PG8_STAGE(PG8_SB(0, 1), b2 + hstep, voffB); PG8_STAGE(PG8_SA(0, 0), a2, voffA);
            PG8_WAIT_V(8); PG8_WAIT_L(0); PG8_BAR; PG8_MMA(1, 0, At, B0); PG8_MMA(1, 1, At, B1); PG8_BAR; PG8_SCHED;
            PG8_LDB(B0, 1, 0); PG8_LDB(B1, 1, 1); PG8_SCHED; PG8_LDA(At, 1, 0); PG8_STAGE(PG8_SA(0, 1), a2 + hstep, voffA);
            PG8_WAIT_V(8); PG8_WAIT_L(0); PG8_BAR; PG8_MMA(0, 0, At, B0); PG8_MMA(0, 1, At, B1); PG8_BAR; PG8_SCHED;
            PG8_LDA(At, 1, 1); PG8_STAGE(PG8_SB(1, 0), b3, voffB); PG8_STAGE(PG8_SB(1, 1), b3 + hstep, voffB); PG8_STAGE(PG8_SA(1, 0), a3, voffA);
            PG8_WAIT_V(8); PG8_WAIT_L(0); PG8_BAR; PG8_MMA(1, 0, At, B0); PG8_MMA(1, 1, At, B1); PG8_BAR; PG8_SCHED;
            } else {
            PG8_LDB(B0, 0, 0); PG8_SCHED; PG8_LDA(At, 0, 0); PG8_STAGE(PG8_SA(1, 1), a1 + hstep, voffA);
            PG8_WAIT_L(8); PG8_BAR; PG8_WAIT_L(0); PG8_MMA(0, 0, At, B0); PG8_BAR; PG8_SCHED;
            PG8_LDB(B1, 0, 1); PG8_STAGE(PG8_SB(0, 0), b2, voffB);
            PG8_BAR; PG8_WAIT_L(0); PG8_MMA(0, 1, At, B1); PG8_BAR;
            PG8_LDA(At, 0, 1); PG8_STAGE(PG8_SA(0, 0), a2, voffA);
            PG8_BAR; PG8_WAIT_L(0); PG8_MMA(1, 0, At, B0); PG8_BAR; PG8_SCHED;
            PG8_STAGE(PG8_SB(0, 1), b2 + hstep, voffB);
            PG8_WAIT_V(6); PG8_BAR; PG8_MMA(1, 1, At, B1); PG8_BAR;
            PG8_LDB(B0, 1, 0); PG8_SCHED; PG8_LDA(At, 1, 0); PG8_STAGE(PG8_SA(0, 1), a2 + hstep, voffA);
            PG8_WAIT_L(8); PG8_BAR; PG8_WAIT_L(0); PG8_MMA(0, 0, At, B0); PG8_BAR; PG8_SCHED;
            PG8_LDB(B1, 1, 1); PG8_STAGE(PG8_SB(1, 0), b3, voffB);
            PG8_BAR; PG8_WAIT_L(0); PG8_MMA(0, 1, At, B1); PG8_BAR;
            PG8_LDA(At, 1, 1); PG8_STAGE(PG8_SA(1, 0), a3, voffA);
            PG8_BAR; PG8_WAIT_L(0); PG8_MMA(1, 0, At, B0); PG8_BAR; PG8_SCHED;
            PG8_STAGE(PG8_SB(1, 1), b3 + hstep, voffB);
            PG8_WAIT_V(6); PG8_BAR; PG8_MMA(1, 1, At, B1); PG8_BAR;
            }
        }
        if constexpr (ALIGN_EPI) { if (wr == 0) PG8_BAR; }
        if constexpr (!Epi::AFTER_DRAIN) { E(acc, cur, wr, wc, fr, fq); S.done(cur); }
        if (!has_next) break;
#pragma unroll
        for (int a = 0; a < 2; ++a)
#pragma unroll
            for (int b = 0; b < 2; ++b)
#pragma unroll
                for (int m = 0; m < 4; ++m)
#pragma unroll
                    for (int n = 0; n < 2; ++n) acc[a][b][m][n] = (f32x4){0.f, 0.f, 0.f, 0.f};
        cur = nxt; cA = nA; cB = nB; ++ui;
        if constexpr (ALIGN_EPI) { if (wr == 1) PG8_BAR; }
    }
    PG8_WAIT_V(0);
    if constexpr (!ALIGN_EPI) { if (wr == 0) PG8_BAR; }
    PG8_BAR;
    if constexpr (Epi::AFTER_DRAIN) { E.fused(acc, cur, wr, wc, fr, fq, lds, wid, lane); S.done(cur); }
#undef PG8_SA
#undef PG8_SB
#undef PG8_STAGE
#undef PG8_LDA
#undef PG8_LDB
#undef PG8_MMA
#undef PG8_WAIT_V
#undef PG8_WAIT_L
#undef PG8_BAR
#undef PG8_SCHED
}
}

constexpr int DM = 2048, NB = 4, SEQ = 2048, NL = 2, DB = 8, PAST = 16384, PAGE = 128, HD = 128;
constexpr int NH = 8, NKV = 2, HPG = 4, GH = 8, WIN = 512, CONVCH = 3072, DFF = 5632, INW = 6696;
constexpr int MP = NB * SEQ, MS = DB, MT = MP + MS, MPAD = 8448, NIN = 6912, NGU = 2 * DFF, NPG = PAST / PAGE;
constexpr float EPS = 1e-6f;
constexpr int PQ = 0, PKV = 1024, PCONV = 2560, PZ = 5632, PGL = 6656, PA = 6680, PBB = 6688;

constexpr size_t O_YP = 0, O_YS = O_YP + (size_t)MP * DM, O_PCMP = O_YS + (size_t)MS * DM, O_PSEL = O_PCMP + (size_t)NB * NL * NKV * SEQ * 2 * HD,
    O_PWIN = O_PSEL + (size_t)NB * NL * NKV * SEQ * 2 * HD, O_PGDN = O_PWIN + (size_t)NB * NL * NKV * WIN * 2 * HD, O_PCONV = O_PGDN + (size_t)NB * NL * GH * HD * HD,
    O_SCMP = O_PCONV + (size_t)NB * NL * 3 * CONVCH, O_SSEL = O_SCMP + (size_t)DB * NL * NKV * 2 * HD, O_SWIN = O_SSEL + (size_t)DB * NL * NKV * 2 * HD,
    O_SGDN = O_SWIN + (size_t)DB * NL * NKV * WIN * 2 * HD, O_SCONV = O_SGDN + (size_t)DB * NL * GH * HD * HD, O_END = O_SCONV + (size_t)DB * NL * 3 * CONVCH;

constexpr size_t MiB = 1u << 20;
constexpr size_t al(size_t x) { return (x + MiB - 1) / MiB * MiB; }
constexpr size_t WS_CTL = 0, CTL_BYTES = 1 * MiB;
constexpr size_t WS_WIN = WS_CTL + CTL_BYTES;
constexpr size_t WS_WOUT = WS_WIN + al((size_t)NL * NIN * DM * 2);
constexpr size_t WS_WGU = WS_WOUT + al((size_t)NL * DM * DM * 2);
constexpr size_t WS_WDN = WS_WGU + al((size_t)NL * NGU * DM * 2);
constexpr size_t WS_W1 = WS_WDN + al((size_t)NL * DM * DFF * 2);
constexpr size_t WS_MODP = WS_W1 + al((size_t)4 * 256 * 8192 * 2);
constexpr size_t WS_MOD = WS_MODP + al((size_t)8 * 2 * 12 * 12288 * 4);
constexpr size_t WS_ROPE = WS_MOD + al((size_t)2 * 12 * 12288 * 4);
constexpr size_t WS_X = WS_ROPE + al((size_t)2049 * 32 * 4);
constexpr size_t WS_H = WS_X + al((size_t)MPAD * DM * 4);
constexpr size_t WS_PROJ = WS_H + al((size_t)MPAD * DM * 2);
constexpr size_t WS_QF = WS_PROJ + al((size_t)MPAD * NIN * 4);
constexpr size_t WS_KWF = WS_QF + al((size_t)MT * 1024 * 4);
constexpr size_t WS_GATES = WS_KWF + al((size_t)NB * NKV * SEQ * 256 * 4);
constexpr size_t WS_GQ = WS_GATES + al((size_t)MT * 24 * 4);
constexpr size_t WS_GK = WS_GQ + al((size_t)MT * 1024 * 4);
constexpr size_t WS_GV = WS_GK + al((size_t)MT * 1024 * 4);
constexpr size_t WS_GO = WS_GV + al((size_t)MT * 1024 * 4);
constexpr size_t WS_GG = WS_GO + al((size_t)MT * 1024 * 4);
constexpr size_t WS_GB = WS_GG + al((size_t)MT * 8 * 4);
constexpr size_t WS_AS = WS_GB + al((size_t)MT * 8 * 4);
constexpr size_t WS_AP = WS_AS + al((size_t)4 * 4096 * 8192 * 2);
constexpr size_t WS_HIDS = WS_AP + al((size_t)2 * 256 * 8192 * 2);
constexpr size_t WS_HIDP = WS_HIDS + al((size_t)4 * 16384 * 256 * 4);
constexpr size_t WS_CBS = WS_HIDP + al((size_t)32 * 512 * 256 * 4);
constexpr size_t WS_CBP = WS_CBS + al((size_t)16384 * 128 * 4);
constexpr size_t WS_OMIX = WS_CBP + al((size_t)512 * 128 * 4);
constexpr size_t WS_MIX = WS_OMIX + al((size_t)MPAD * DM * 2);
constexpr size_t WS_ACT = WS_MIX + al((size_t)MPAD * DM * 4);
constexpr size_t WS_KSB = WS_ACT + al((size_t)MPAD * DFF * 2);
constexpr size_t KVB_SZ = (size_t)NB * NKV * SEQ * HD * 2;
constexpr size_t WS_VSB = WS_KSB + al(KVB_SZ), WS_KWB = WS_VSB + al(KVB_SZ), WS_VWB = WS_KWB + al(KVB_SZ);
constexpr size_t WS_ATA = WS_VWB + al(KVB_SZ);
constexpr size_t WS_GFR = WS_ATA + al((size_t)256 * 8 * 16 * 64 * 16);
constexpr size_t FR_W = 0, FR_Q = 16384, FR_K = 32768, FR_QK = 49152, FR_U = 57344, FR_CH = 90112;
constexpr size_t WS_GDEC = WS_GFR + al((size_t)1024 * FR_CH);
constexpr size_t WS_PEC = WS_GDEC + al(1024 * 4);
constexpr size_t WS_W1B = WS_PEC + al(1024 * 4);
constexpr size_t WS_END = WS_W1B + al((size_t)4 * 256 * 8192 * 2);

constexpr int CW_BAR = 4096;

constexpr int RING_BYTES = 131072, LDS_BYTES = 163840, MISC_OFF = LDS_BYTES - 256;
constexpr int NWAVES = 8, NTHR = 512;

__device__ __forceinline__ unsigned f2bf(float f) { unsigned u = __float_as_uint(f); return (u + 0x7fffu + ((u >> 16) & 1u)) >> 16; }
__device__ __forceinline__ unsigned pk2(float lo, float hi) { return f2bf(lo) | (f2bf(hi) << 16); }
__device__ __forceinline__ float wave_sum(float v) {
#pragma unroll
    for (int o = 1; o < 64; o <<= 1) v += __shfl_xor(v, o);
    return v;
}
__device__ __forceinline__ float wave_max(float v) {
#pragma unroll
    for (int o = 1; o < 64; o <<= 1) v = fmaxf(v, __shfl_xor(v, o));
    return v;
}
__device__ __forceinline__ float sigm(float x) { return 1.0f / (1.0f + expf(-x)); }
__device__ __forceinline__ float siluf(float x) { return x / (1.0f + expf(-x)); }
__device__ __forceinline__ float softplusf(float x) { return fmaxf(x, 0.f) + log1pf(expf(-fabsf(x))); }
__device__ __forceinline__ float gelu_tanh(float x) { return 0.5f * x * (1.0f + tanhf(0.7978845608028654f * (x + 0.044715f * x * x * x))); }

__constant__ double ROPE_INV[16] = {1.0, 0.44036660267178046, 0.19392274474868576, 0.08539710028576561, 0.03760603093086393, 0.016560440080994446, 0.007292664737217109,
    0.003211445994752591, 0.001414213562373095, 0.000622772421914596, 0.0002742481756762073, 0.00012076973741146504, 5.318295896944988e-05, 2.341999896140934e-05,
    1.031338537721246e-05, 4.5416704806078695e-06};

__device__ __forceinline__ void sincos_d(double a, float& c, float& s) {
    const double k = rint(a * 0.6366197723675814);
    const double r = (a - k * 1.5707963267948966) - k * 6.123233995736766e-17;
    const int q = (int)((long long)k & 3);
    const double r2 = r * r;
    const double sp = r * (1.0 + r2 * (-1.0 / 6 + r2 * (1.0 / 120 + r2 * (-1.0 / 5040 + r2 * (1.0 / 362880 + r2 * (-1.0 / 39916800 + r2 * (1.0 / 6227020800.0)))))));
    const double cp = 1.0 + r2 * (-0.5 + r2 * (1.0 / 24 + r2 * (-1.0 / 720 + r2 * (1.0 / 40320 + r2 * (-1.0 / 3628800 + r2 * (1.0 / 479001600 + r2 * (-1.0 / 87178291200.0)))))));
    double ss, cc;
    if (q == 0) { ss = sp; cc = cp; } else if (q == 1) { ss = cp; cc = -sp; } else if (q == 2) { ss = -sp; cc = -cp; } else { ss = -cp; cc = sp; }
    c = (float)cc; s = (float)ss;
}

#define XB_TMO      128
#define XB_XCNT(j)  (256  + 64 * (j))
#define XB_XSUB(j)  (1280 + 64 * (j))
#define XB_XGEN(j)  (2304 + 64 * (j))
#define XB_TOP      3328
#define XB_TOPGEN   3392
#define XCD_BAR_WORDS 3456
#define XB_SPIN_CAP (1u << 22)
__device__ __forceinline__ unsigned xb_ld(unsigned* p)              { return __hip_atomic_load(p, __ATOMIC_RELAXED, __HIP_MEMORY_SCOPE_AGENT); }
__device__ __forceinline__ unsigned xb_add(unsigned* p, unsigned v) { return __hip_atomic_fetch_add(p, v, __ATOMIC_RELAXED, __HIP_MEMORY_SCOPE_AGENT); }
__device__ __forceinline__ unsigned xb_xcc_id() { return (unsigned)__builtin_amdgcn_s_getreg((3 << 11) | 20) & 0xFu; }
#define XB_SPIN(cond, bar) do { unsigned _sp = 0; while (cond) { __builtin_amdgcn_s_sleep(1); \
    if ((++_sp & 255u) == 0u) { if (xb_ld(&(bar)[XB_TMO])) break; if (_sp > XB_SPIN_CAP) { atomicAdd(&(bar)[XB_TMO], 1u); break; } } } } while (0)
struct XcdBarrier { unsigned* bar; unsigned x; volatile LAS unsigned* st; };
__device__ __forceinline__ XcdBarrier xcd_barrier_post(unsigned* bar, volatile LAS unsigned* st) {
    XcdBarrier b; b.bar = bar; b.x = xb_xcc_id(); b.st = st;
    if (threadIdx.x == 0) (void)xb_add(&bar[XB_XCNT(b.x)], 1u);
    return b;
}
__device__ __forceinline__ void xcd_barrier_complete(unsigned* bar, unsigned x, unsigned& nloc, unsigned& nx) {
    const unsigned G = gridDim.x * gridDim.y * gridDim.z;
    unsigned sum, cnt, mine, sp = 0u;
    for (;;) {
        sum = 0u; cnt = 0u; mine = 0u;
#pragma unroll
        for (unsigned j = 0; j < 16; ++j) { const unsigned c = xb_ld(&bar[XB_XCNT(j)]); sum += c; cnt += (c > 0u) ? 1u : 0u; mine = (j == x) ? c : mine; }
        if (sum == G) break;
        __builtin_amdgcn_s_sleep(1);
        if ((++sp & 255u) == 0u) { if (xb_ld(&bar[XB_TMO])) break; if (sp > XB_SPIN_CAP) { atomicAdd(&bar[XB_TMO], 1u); break; } }
    }
    nloc = mine > 0u ? mine : 1u; nx = cnt > 0u ? cnt : 1u;
}
__device__ __forceinline__ void xcd_barrier(const XcdBarrier& b) {
    asm volatile("s_waitcnt vmcnt(0)" ::: "memory");
    __syncthreads();
    if (threadIdx.x == 0) {
        unsigned* bar = b.bar;
        __builtin_amdgcn_s_waitcnt(0);
        unsigned nloc = b.st[0], nx = b.st[1];
        if (nloc == 0u) { xcd_barrier_complete(bar, b.x, nloc, nx); b.st[0] = nloc; b.st[1] = nx; }
        const unsigned old = xb_add(&bar[XB_XSUB(b.x)], 1u);
        const unsigned gen = old / nloc;
        if (old + 1u == (gen + 1u) * nloc) {
            __builtin_amdgcn_fence(__ATOMIC_RELEASE, "agent");
            asm volatile("s_waitcnt vmcnt(0)" ::: "memory");
            const unsigned og = xb_add(&bar[XB_TOP], 1u);
            const unsigned tg = og / nx;
            if (og + 1u == (tg + 1u) * nx) xb_add(&bar[XB_TOPGEN], 1u);
            else XB_SPIN(xb_ld(&bar[XB_TOPGEN]) == tg, bar);
            __builtin_amdgcn_fence(__ATOMIC_ACQUIRE, "agent");
            xb_add(&bar[XB_XGEN(b.x)], 1u);
            asm volatile("s_waitcnt vmcnt(0)" ::: "memory");
        } else {
            XB_SPIN(xb_ld(&bar[XB_XGEN(b.x)]) == gen, bar);
            __builtin_amdgcn_fence(__ATOMIC_ACQUIRE, "agent");
            asm volatile("s_waitcnt vmcnt(0)" ::: "memory");
        }
    }
    __syncthreads();
}

struct Args { const void* in[28]; float* out; unsigned char* ws; int ph_lo, ph_hi; };

struct Frame {
    LAS unsigned char* lds;
    int tid, lane, wave, G, bid;
    const void* const* in; float* out; unsigned char* ws;
};


template <class Map>
__device__ __forceinline__ void tr_item(const Map& mp, int K, int NNEW, bf16* WT, LAS float* scr, int item, int lane, bf16* WB = nullptr) {
    const int nblk = NNEW / 64, kb = item / nblk, nb = item % nblk, k0 = 64 * kb, n0 = 64 * nb;
    const float* colp; int stride; const bool ok = mp(n0 + lane, colp, stride);
#pragma unroll
    for (int h = 0; h < 2; ++h) { float tv[32];
#pragma unroll
        for (int i = 0; i < 32; ++i) tv[i] = ok ? colp[(size_t)(k0 + 32 * h + i) * stride] : 0.f;
#pragma unroll
        for (int i = 0; i < 32; ++i) scr[(32 * h + i) * 65 + lane] = tv[i]; }
    asm volatile("s_waitcnt lgkmcnt(0)" ::: "memory");
    const int c = lane & 7;
#pragma unroll
    for (int j = 0; j < 8; ++j) { const int n = (lane >> 3) + 8 * j; const LAS float* s = scr + (8 * c) * 65 + n;
        u32x4 o; o.x = pk2(s[0 * 65], s[1 * 65]); o.y = pk2(s[2 * 65], s[3 * 65]); o.z = pk2(s[4 * 65], s[5 * 65]); o.w = pk2(s[6 * 65], s[7 * 65]);
        *(u32x4*)(WT + (size_t)(n0 + n) * K + k0 + 8 * c) = o;
        if (WB) *(u32x4*)(WB + ((size_t)((k0 >> 5) + (c >> 2)) * NNEW + n0 + n) * 32 + (c & 3) * 8) = o; }
    asm volatile("s_waitcnt lgkmcnt(0)" ::: "memory");
}
struct MapIn { const float* W; __device__ __forceinline__ bool operator()(int n, const float*& p, int& st) const {
    int o; if (n < 2560) o = n; else if (n < 5632) o = n + 24; else if (n < 6656) o = n + 40; else if (n < 6680) o = n - 4096; else if (n < 6696) o = n - 1024; else o = -1;
    st = INW; p = W + (o < 0 ? 0 : o); return o >= 0; } };
struct MapPlain { const float* W; int N; __device__ __forceinline__ bool operator()(int n, const float*& p, int& st) const { st = N; p = W + n; return true; } };
struct MapBase { const float* base; int stride, n0; __device__ __forceinline__ bool operator()(int n, const float*& p, int& st) const { st = stride; p = base + (n - n0); return true; } };

__device__ __forceinline__ const float* xrow_in(const Frame& F, int l, int r) {
    if (l == 0) return r < MP ? ((const float*)F.in[0]) + (size_t)r * DM : ((const float*)F.in[1]) + (size_t)(r - MP) * DM;
    return ((float*)(F.ws + WS_X)) + (size_t)r * DM;
}
__device__ __forceinline__ int modrow(int r) { return r < MP ? (r >> 11) : 4 + (r - MP); }

__device__ __forceinline__ void norm_mod_store(const f32x4 (&v)[8], const float* gain, const float* sh, const float* sc, bf16* orow, int lane) {
    float ss = 0.f;
#pragma unroll
    for (int j = 0; j < 8; ++j) ss += (v[j].x * v[j].x + v[j].y * v[j].y) + (v[j].z * v[j].z + v[j].w * v[j].w);
    ss = wave_sum(ss);
    const float rs = 1.0f / sqrtf(ss * (1.0f / DM) + EPS);
#pragma unroll
    for (int j = 0; j < 8; ++j) { const int c = (lane + 64 * j) * 4;
        const f32x4 g = *(const f32x4*)(gain + c), a = *(const f32x4*)(sc + c), b = *(const f32x4*)(sh + c);
        const f32x4 h = v[j] * rs * g * (a + 1.0f) + b;
        u32x2 o; o.x = pk2(h.x, h.y); o.y = pk2(h.z, h.w); *(u32x2*)(orow + c) = o; }
}

constexpr int TR_I_IN = (DM / 64) * (NIN / 64), TR_I_OUT = (DM / 64) * (DM / 64), TR_I_GU = (DM / 64) * (NGU / 64), TR_I_DN = (DFF / 64) * (DM / 64), TR_I_W1 = (8192 / 64) * (256 / 64);
constexpr int TR_I_L = TR_I_IN + TR_I_OUT + TR_I_GU + TR_I_DN;
__device__ __forceinline__ void tr_range(Frame& F, int first, int count, int rank, int nw) {
    LAS float* scr = (LAS float*)(F.lds + F.wave * 16896);
    const int lane = F.lane;
#pragma unroll 1
    for (int it = first + rank; it < first + count; it += nw) {
        int r = it;
        if (r < 2 * TR_I_L) {
            const int l = r / TR_I_L; r -= l * TR_I_L;
            if (r < TR_I_IN) { MapIn mp{((const float*)F.in[13]) + (size_t)l * DM * INW}; tr_item(mp, DM, NIN, ((bf16*)(F.ws + WS_WIN)) + (size_t)l * NIN * DM, scr, r, lane); continue; } r -= TR_I_IN;
            if (r < TR_I_OUT) { MapPlain mp{((const float*)F.in[21]) + (size_t)l * DM * DM, DM}; tr_item(mp, DM, DM, ((bf16*)(F.ws + WS_WOUT)) + (size_t)l * DM * DM, scr, r, lane); continue; } r -= TR_I_OUT;
            if (r < TR_I_GU) { const int n0 = (r % (NGU / 64)) * 64, tt = n0 >> 8, rr = n0 & 255;
                if (rr < 128) { MapBase mp{((const float*)F.in[24]) + (size_t)l * DM * DFF + tt * 128 + rr, DFF, n0}; tr_item(mp, DM, NGU, ((bf16*)(F.ws + WS_WGU)) + (size_t)l * NGU * DM, scr, r, lane); }
                else { MapBase mp{((const float*)F.in[25]) + (size_t)l * DM * DFF + tt * 128 + rr - 128, DFF, n0}; tr_item(mp, DM, NGU, ((bf16*)(F.ws + WS_WGU)) + (size_t)l * NGU * DM, scr, r, lane); }
                continue; } r -= TR_I_GU;
            { MapPlain mp{((const float*)F.in[26]) + (size_t)l * DFF * DM, DM}; tr_item(mp, DFF, DM, ((bf16*)(F.ws + WS_WDN)) + (size_t)l * DM * DFF, scr, r, lane); continue; }
        }
        r -= 2 * TR_I_L;
        { const int m = r / TR_I_W1; r -= m * TR_I_W1; MapPlain mp{((const float*)F.in[15]) + (size_t)m * 8192 * 256, 256}; tr_item(mp, 8192, 256, ((bf16*)(F.ws + WS_W1)) + (size_t)m * 256 * 8192, scr, r, lane, ((bf16*)(F.ws + WS_W1B)) + (size_t)m * 256 * 8192); }
    }
}

__device__ __forceinline__ void phase_prologue(Frame& F) {
    const int tid = F.tid, lane = F.lane, G = F.G;
    {
        LAS float* sc = (LAS float*)F.lds;
        for (int it = F.bid; it < 2 * 24 * 8; it += G) {
            const int ks = it & 7, chunk = (it >> 3) % 24, l = it / 192;
            for (int i = tid; i < 12 * 256; i += NTHR) { const int row = i >> 8, k = i & 255;
                const float c = row < 4 ? ((const float*)F.in[8])[row * DM + ks * 256 + k] : ((const float*)F.in[9])[(row - 4) * DM + ks * 256 + k]; sc[i] = siluf(c); }
            __syncthreads();
            const int n = chunk * 512 + tid;
            float acc[12];
#pragma unroll
            for (int r = 0; r < 12; ++r) acc[r] = 0.f;
            const float* w = ((const float*)F.in[10]) + ((size_t)l * DM + ks * 256) * 12288 + n;
#pragma unroll 1
            for (int k0 = 0; k0 < 256; k0 += 16) { float wv[16];
#pragma unroll
                for (int u = 0; u < 16; ++u) wv[u] = w[(size_t)(k0 + u) * 12288];
#pragma unroll
                for (int u = 0; u < 16; ++u)
#pragma unroll
                    for (int r = 0; r < 12; ++r) acc[r] += sc[r * 256 + k0 + u] * wv[u]; }
#pragma unroll
            for (int r = 0; r < 12; ++r) ((float*)(F.ws + WS_MODP))[((size_t)(ks * 2 + l) * 12 + r) * 12288 + n] = acc[r];
            __syncthreads();
        }
    }
    for (int i = F.bid * NTHR + tid; i < 2049 * 16; i += G * NTHR) {
        const int p = i >> 4, k = i & 15; const double pos = p < 2048 ? (double)p : (double)PAST;
        float c, s; sincos_d(pos * ROPE_INV[k], c, s); ((float*)(F.ws + WS_ROPE))[2 * i] = c; ((float*)(F.ws + WS_ROPE))[2 * i + 1] = s;
    }
    for (int i = F.bid * NTHR + tid; i < (MPAD - MT) * DM / 2; i += G * NTHR) { ((unsigned*)(((bf16*)(F.ws + WS_H)) + (size_t)MT * DM))[i] = 0u; ((unsigned*)(((bf16*)(F.ws + WS_OMIX)) + (size_t)MT * DM))[i] = 0u; }
    __syncthreads();
    tr_range(F, 0, TR_I_L, F.bid * NWAVES + F.wave, G * NWAVES);
    tr_range(F, 2 * TR_I_L, 4 * TR_I_W1, F.bid * NWAVES + F.wave, G * NWAVES);
}

__device__ __forceinline__ void ada_reduce(Frame& F) {
    for (int i = F.bid * NTHR + F.tid; i < 2 * 12 * 12288; i += F.G * NTHR) {
        const int n = i % 12288, l = i / (12 * 12288);
        float s = ((const float*)F.in[11])[l * 12288 + n];
#pragma unroll
        for (int ks = 0; ks < 8; ++ks) s += ((float*)(F.ws + WS_MODP))[(size_t)ks * (2 * 12 * 12288) + i];
        ((float*)(F.ws + WS_MOD))[i] = s;
    }
}

__device__ __forceinline__ void pe_w1(Frame& F) {
    const int gw = F.bid * NWAVES + F.wave;
    if (gw >= 1024) return;
    const bf16* wr = ((const bf16*)(F.ws + WS_W1)) + (size_t)gw * 8192; const float* pe = ((const float*)F.in[14]) + (size_t)(gw >> 8) * 8192;
    float s = 0.f;
#pragma unroll 4
    for (int i = 0; i < 16; ++i) { const int k = i * 512 + F.lane * 8;
        const u32x4 w = *(const u32x4*)(wr + k); const f32x4 p0 = *(const f32x4*)(pe + k), p1 = *(const f32x4*)(pe + k + 4);
        s += __uint_as_float(w.x << 16) * p0.x + __uint_as_float(w.x & 0xffff0000u) * p0.y + __uint_as_float(w.y << 16) * p0.z + __uint_as_float(w.y & 0xffff0000u) * p0.w
           + __uint_as_float(w.z << 16) * p1.x + __uint_as_float(w.z & 0xffff0000u) * p1.y + __uint_as_float(w.w << 16) * p1.z + __uint_as_float(w.w & 0xffff0000u) * p1.w; }
    s = wave_sum(s);
    if (F.lane == 0) ((float*)(F.ws + WS_PEC))[gw] = s;
}

template <int NSPLIT>
__device__ __forceinline__ void cmp_finish(Frame& F, const float* hid, size_t slab, int rows, int rows_per_mat, const float* w2base, float* outp, int bid0 = 0, int row0 = 0, const float* cadd = nullptr) {
    LAS float* hs = (LAS float*)F.lds;
    if (F.bid < bid0) return;
    for (int it = F.bid - bid0; it < rows / 4; it += F.G - bid0) {
#pragma unroll
        for (int i0 = 0; i0 < 2; ++i0) { const int i = F.tid + i0 * NTHR; const int rr = i >> 8, n = i & 255; const size_t R = (size_t)row0 + (size_t)it * 4 + rr;
            float pv[NSPLIT];
#pragma unroll
            for (int ks = 0; ks < NSPLIT; ++ks) pv[ks] = hid[(size_t)ks * slab + R * 256 + n];
            float s = cadd ? cadd[(R / rows_per_mat) * 256 + n] : 0.f;
#pragma unroll
            for (int ks = 0; ks < NSPLIT; ++ks) s += pv[ks];
            hs[i] = gelu_tanh(s); }
        __syncthreads();
        const int rr = F.tid >> 7, c = F.tid & 127; const size_t R = (size_t)row0 + (size_t)it * 4 + rr;
        const float* w2 = w2base + (R / rows_per_mat) * 32768;
        float acc = 0.f;
#pragma unroll 1
        for (int n0 = 0; n0 < 256; n0 += 32) { float wv[32];
#pragma unroll
            for (int u = 0; u < 32; ++u) wv[u] = w2[(n0 + u) * 128 + c];
#pragma unroll
            for (int u = 0; u < 32; ++u) acc += hs[rr * 256 + n0 + u] * wv[u]; }
        outp[R * 128 + c] = acc;
        __syncthreads();
    }
}

template <int NSPLIT>
__device__ __forceinline__ void cmp_finish16(Frame& F, const float* hid, size_t slab, int rows, int rows_per_mat, const float* w2base, float* outp, int bid0 = 0, int row0 = 0, const float* cadd = nullptr) {
    LAS float* hs = (LAS float*)F.lds;
    if (F.bid < bid0) return;
    for (int it = F.bid - bid0; it < rows / 16; it += F.G - bid0) {
        const size_t R0 = (size_t)row0 + (size_t)it * 16; const int mat = (int)(R0 / rows_per_mat);
#pragma unroll
        for (int i0 = 0; i0 < 8; ++i0) { const int i = F.tid + i0 * NTHR; const int rr = i >> 8, n = i & 255; const size_t R = R0 + rr;
            float pv[NSPLIT];
#pragma unroll
            for (int ks = 0; ks < NSPLIT; ++ks) pv[ks] = hid[(size_t)ks * slab + R * 256 + n];
            float s = cadd ? cadd[mat * 256 + n] : 0.f;
#pragma unroll
            for (int ks = 0; ks < NSPLIT; ++ks) s += pv[ks];
            hs[i] = gelu_tanh(s); }
        __syncthreads();
        const int g = F.tid >> 7, c = F.tid & 127;
        const float* w2 = w2base + (size_t)mat * 32768;
        float acc[4] = {0.f, 0.f, 0.f, 0.f};
#pragma unroll 1
        for (int n0 = 0; n0 < 256; n0 += 32) { float wv[32];
#pragma unroll
            for (int u = 0; u < 32; ++u) wv[u] = w2[(n0 + u) * 128 + c];
#pragma unroll
            for (int u = 0; u < 32; ++u)
#pragma unroll
                for (int r = 0; r < 4; ++r) acc[r] += hs[(g * 4 + r) * 256 + n0 + u] * wv[u]; }
#pragma unroll
        for (int r = 0; r < 4; ++r) outp[(R0 + g * 4 + r) * 128 + c] = acc[r];
        __syncthreads();
    }
}

__device__ __forceinline__ void phase_norm1(Frame& F, int l) {
    const int gw = F.bid * NWAVES + F.wave, NGW = F.G * NWAVES;
    for (int r = gw; r < MT; r += NGW) {
        const f32x4* xr = (const f32x4*)xrow_in(F, l, r) + F.lane;
        f32x4 v[8];
#pragma unroll
        for (int j = 0; j < 8; ++j) v[j] = xr[64 * j];
        const float* md = ((float*)(F.ws + WS_MOD)) + ((size_t)l * 12 + modrow(r)) * 12288;
        norm_mod_store(v, ((const float*)F.in[12]) + l * DM, md, md + 2048, ((bf16*)(F.ws + WS_H)) + (size_t)r * DM, F.lane);
    }
}

__device__ __forceinline__ void phase_postproj(Frame& F, int l, int parts = 7) {
    const int lane = F.lane, gw = F.bid * NWAVES + F.wave, NGW = F.G * NWAVES;
    const int j = lane & 31, hs = lane >> 5;
    float* PROJp = (float*)(F.ws + WS_PROJ);
    if (parts & 1)
#pragma unroll 1
    for (int r = gw; r < MT; r += NGW) {
        const float* pr = PROJp + (size_t)r * NIN;
        const bool isP = r < MP; const int b = isP ? (r >> 11) : (r - MP), t = isP ? (r & 2047) : 0;
        const float* rp = ((float*)(F.ws + WS_ROPE)) + (size_t)(isP ? t : 2048) * 32;
        f32x4 cs, sn;
#pragma unroll
        for (int e = 0; e < 4; ++e) { const int i = (4 * j + e) & 15; cs[e] = rp[2 * i]; sn[e] = rp[2 * i + 1]; }
        f32x4 qv[4], kv[3], vv[3];
#pragma unroll
        for (int i = 0; i < 4; ++i) qv[i] = *(const f32x4*)(pr + PQ + i * 256 + lane * 4);
#pragma unroll
        for (int s = 0; s < 3; ++s) { kv[s] = *(const f32x4*)(pr + PKV + s * 512 + lane * 4); vv[s] = *(const f32x4*)(pr + PKV + s * 512 + 256 + lane * 4); }
#pragma unroll
        for (int i = 0; i < 4; ++i) { f32x4 x = qv[i], o;
#pragma unroll
            for (int e = 0; e < 4; ++e) o[e] = __shfl_xor(x[e], 4);
            if (j < 4) x = x * cs - o * sn; else if (j < 8) x = x * cs + o * sn;
            *(f32x4*)(((float*)(F.ws + WS_QF)) + ((size_t)r * 8 + 2 * i + hs) * 128 + 4 * j) = x; }
        const int g = hs;
#pragma unroll
        for (int s = 0; s < 3; ++s) { f32x4 x = kv[s], o; const f32x4 v = vv[s];
#pragma unroll
            for (int e = 0; e < 4; ++e) o[e] = __shfl_xor(x[e], 4);
            if (j < 4) x = x * cs - o * sn; else if (j < 8) x = x * cs + o * sn;
            float* dst;
            if (s < 2) {
                if (isP) dst = F.out + (s == 0 ? O_PCMP : O_PSEL) + ((((size_t)b * NL + l) * NKV + g) * SEQ + t) * 256;
                else dst = F.out + (s == 0 ? O_SCMP : O_SSEL) + (((size_t)b * NL + l) * NKV + g) * 256;
            } else {
                dst = isP ? nullptr : F.out + O_SWIN + ((((size_t)b * NL + l) * NKV + g) * WIN + (WIN - 1)) * 256;
            }
            if (dst) { *(f32x4*)(dst + 4 * j) = x; *(f32x4*)(dst + 128 + 4 * j) = v; }
            if (s >= 1 && isP) { const size_t o2 = (((size_t)b * NKV + g) * SEQ + t) * HD + 4 * j;
                u32x2 kk, v2; kk.x = pg8::cvt_pk_bf16(x.x, x.y); kk.y = pg8::cvt_pk_bf16(x.z, x.w); v2.x = pg8::cvt_pk_bf16(v.x, v.y); v2.y = pg8::cvt_pk_bf16(v.z, v.w);
                *(u32x2*)((bf16*)(F.ws + (s == 1 ? WS_KSB : WS_KWB)) + o2) = kk; *(u32x2*)((bf16*)(F.ws + (s == 1 ? WS_VSB : WS_VWB)) + o2) = v2; }
            if (s == 2 && isP && t >= SEQ - WIN) { float* d2 = F.out + O_PWIN + ((((size_t)b * NL + l) * NKV + g) * WIN + (t - (SEQ - WIN))) * 256;
                *(f32x4*)(d2 + 4 * j) = x; *(f32x4*)(d2 + 128 + 4 * j) = v; }
            if (s == 0 && isP) {
                const int tt = t & 63; const size_t arow = ((size_t)b * 32 + (t >> 6)) * 2 + g;
                const float* pek = ((const float*)F.in[14]) + (((size_t)l * 2 + 0) * 64 + tt) * 128 + 4 * j;
                const f32x4 pk = *(const f32x4*)pek, pv = *(const f32x4*)(pek + 64 * 128);
                const f32x4 xa = x + pk, va = v + pv;
                u32x2 kk, v2; kk.x = pg8::cvt_pk_bf16(xa.x, xa.y); kk.y = pg8::cvt_pk_bf16(xa.z, xa.w); v2.x = pg8::cvt_pk_bf16(va.x, va.y); v2.y = pg8::cvt_pk_bf16(va.z, va.w);
                bf16* ak = ((bf16*)(F.ws + WS_AP)) + arow * 8192 + tt * 128 + 4 * j;
                *(u32x2*)ak = kk; *(u32x2*)(ak + (size_t)256 * 8192) = v2;
            }
        }
        if (lane < 24) ((float*)(F.ws + WS_GATES))[(size_t)r * 24 + lane] = sigm(pr[PGL + lane]);
        if (lane < 8) { ((float*)(F.ws + WS_GG))[(size_t)r * 8 + lane] = -expf(((const float*)F.in[18])[l * 8 + lane]) * softplusf(pr[PA + lane] + ((const float*)F.in[19])[l * 8 + lane]); ((float*)(F.ws + WS_GB))[(size_t)r * 8 + lane] = sigm(pr[PBB + lane]); }
        const float* stc = ((const float*)F.in[6]) + ((size_t)(isP ? 0 : b) * NL + l) * 3 * CONVCH;
        if (isP) { if (t >= SEQ - 3) { float* d = F.out + O_PCONV + (((size_t)b * NL + l) * 3 + (t - (SEQ - 3))) * CONVCH;
#pragma unroll
                for (int i = 0; i < 12; ++i) *(f32x4*)(d + i * 256 + lane * 4) = *(const f32x4*)(pr + PCONV + i * 256 + lane * 4); } }
        else { float* d = F.out + O_SCONV + ((size_t)b * NL + l) * 3 * CONVCH;
#pragma unroll
            for (int i = 0; i < 12; ++i) { const int c = i * 256 + lane * 4; *(f32x4*)(d + c) = *(const f32x4*)(stc + CONVCH + c); *(f32x4*)(d + CONVCH + c) = *(const f32x4*)(stc + 2 * CONVCH + c);
                *(f32x4*)(d + 2 * CONVCH + c) = *(const f32x4*)(pr + PCONV + c); } }
    }
    if (parts & 2) {
        const float* cwp = ((const float*)F.in[17]) + (size_t)l * 4 * CONVCH;
        const int NITEM = 12 * (NB * 32 + MS);
#pragma unroll 1
        for (int it = NGW - 1 - gw; it < NITEM; it += NGW) {
            const int cg = it % 12, tb = it / 12; const int part = cg >> 2;
            const int c = cg * 256 + lane * 4, head = (cg & 3) * 2 + hs;
            const bool isP = tb < NB * 32; const int b = isP ? (tb >> 5) : (tb - NB * 32);
            const int row0 = isP ? b * SEQ + (tb & 31) * 64 : MP + b, t0 = isP ? (tb & 31) * 64 : 0, nt = isP ? 64 : 1;
            f32x4 w0 = *(const f32x4*)(cwp + c), w1 = *(const f32x4*)(cwp + CONVCH + c), w2 = *(const f32x4*)(cwp + 2 * CONVCH + c), w3 = *(const f32x4*)(cwp + 3 * CONVCH + c);
            f32x4 x0, x1, x2; const f32x4 z4 = (f32x4){0.f, 0.f, 0.f, 0.f};
            if (isP) { if (t0 > 0) { x0 = *(const f32x4*)(PROJp + (size_t)(row0 - 3) * NIN + PCONV + c); x1 = *(const f32x4*)(PROJp + (size_t)(row0 - 2) * NIN + PCONV + c); x2 = *(const f32x4*)(PROJp + (size_t)(row0 - 1) * NIN + PCONV + c); }
                       else { x0 = z4; x1 = z4; x2 = z4; } }
            else { const float* stc = ((const float*)F.in[6]) + ((size_t)b * NL + l) * 3 * CONVCH + c; x0 = *(const f32x4*)stc; x1 = *(const f32x4*)(stc + CONVCH); x2 = *(const f32x4*)(stc + 2 * CONVCH); }
            float* dstb = (part == 0 ? ((float*)(F.ws + WS_GQ)) : part == 1 ? ((float*)(F.ws + WS_GK)) : ((float*)(F.ws + WS_GV)));
            const float qs = part == 0 ? 0.08838834764831845f : 1.0f;
            f32x4 xq[8];
#pragma unroll
            for (int u = 0; u < 8; ++u) xq[u] = (u < nt) ? *(const f32x4*)(PROJp + (size_t)(row0 + u) * NIN + PCONV + c) : z4;
#pragma unroll 1
            for (int tt0 = 0; tt0 < nt; tt0 += 8) {
                f32x4 xn[8];
#pragma unroll
                for (int u = 0; u < 8; ++u) xn[u] = xq[u];
                if (tt0 + 8 < nt) {
#pragma unroll
                    for (int u = 0; u < 8; ++u) xq[u] = *(const f32x4*)(PROJp + (size_t)(row0 + tt0 + 8 + u) * NIN + PCONV + c); }
                f32x4 y[8]; float ss[8];
#pragma unroll
                for (int u = 0; u < 8; ++u) {
                    const f32x4 xm3 = u >= 3 ? xn[u - 3 < 0 ? 0 : u - 3] : (u == 0 ? x0 : u == 1 ? x1 : x2);
                    const f32x4 xm2 = u >= 2 ? xn[u - 2 < 0 ? 0 : u - 2] : (u == 0 ? x1 : x2);
                    const f32x4 xm1 = u >= 1 ? xn[u - 1 < 0 ? 0 : u - 1] : x2;
                    f32x4 v = xm3 * w0 + xm2 * w1 + xm1 * w2 + xn[u] * w3;
#pragma unroll
                    for (int e = 0; e < 4; ++e) v[e] = v[e] * __builtin_amdgcn_rcpf(1.0f + __expf(-v[e]));
                    y[u] = v; ss[u] = (v.x * v.x + v.y * v.y) + (v.z * v.z + v.w * v.w); }
                if (part < 2) {
#pragma unroll
                    for (int o = 1; o < 32; o <<= 1)
#pragma unroll
                        for (int u = 0; u < 8; ++u) ss[u] += __shfl_xor(ss[u], o);
#pragma unroll
                    for (int u = 0; u < 8; ++u) y[u] = y[u] * (__builtin_amdgcn_rsqf(ss[u] + EPS) * qs); }
#pragma unroll
                for (int u = 0; u < 8; ++u) if (tt0 + u < nt) *(f32x4*)(dstb + ((size_t)(row0 + tt0 + u) * 8 + head) * 128 + 4 * j) = y[u];
                x0 = xn[5]; x1 = xn[6]; x2 = xn[7];
            }
        }
    }
    if (parts & 4)
    for (size_t i = (size_t)F.bid * NTHR + F.tid; i < (size_t)DB * NKV * 511 * 64; i += (size_t)F.G * NTHR) {
        const int q4 = (int)(i & 63); const size_t rest = i >> 6; const int row = (int)(rest % 511); const int bg = (int)(rest / 511); const int b = bg >> 1, g = bg & 1;
        const size_t base = (((size_t)b * NL + l) * NKV + g) * WIN;
        *(f32x4*)(F.out + O_SWIN + (base + row) * 256 + q4 * 4) = *(const f32x4*)(((const float*)F.in[4]) + (base + row + 1) * 256 + q4 * 4);
    }
}

__device__ __forceinline__ void phase_gdn_scan_naive(Frame& F, int l) {
    const int vb = F.G - 1 - F.bid;
    if (vb >= 32) return;
    const int pi = __builtin_amdgcn_readfirstlane(32 + vb * 2 + (F.tid >> 8)), w = F.tid & 255, col = w >> 1, half = w & 1;
    const int seq = pi >> 3, h = pi & 7;
    const bool isP = seq < 4; const int T = isP ? SEQ : 1; const int row0 = isP ? seq * SEQ : MP + (seq - 4);
    float S[64];
    if (isP) {
#pragma unroll
        for (int d = 0; d < 64; ++d) S[d] = 0.f;
    } else { const float* s0 = ((const float*)F.in[5]) + (((size_t)(seq - 4) * NL + l) * GH + h) * 16384 + (size_t)half * 64 * 128 + col;
#pragma unroll
        for (int d = 0; d < 64; ++d) S[d] = s0[d * 128]; }
    const float* GKp = (const float*)(F.ws + WS_GK); const float* GQp = (const float*)(F.ws + WS_GQ); const float* GVp = (const float*)(F.ws + WS_GV);
    const float* GGp = (const float*)(F.ws + WS_GG); const float* GBp = (const float*)(F.ws + WS_GB); float* GOp = (float*)(F.ws + WS_GO);
#pragma unroll 1
    for (int t = 0; t < T; ++t) {
        const size_t rh = (size_t)(row0 + t) * 8 + h;
        const f32x4* kp = (const f32x4*)(GKp + rh * 128 + half * 64); const f32x4* qp = (const f32x4*)(GQp + rh * 128 + half * 64);
        const float v = GVp[rh * 128 + col], gg = GGp[rh], beta = GBp[rh];
        const float eg = expf(gg);
        f32x4 kk[16];
        float ks0 = 0.f, ks1 = 0.f;
#pragma unroll
        for (int i = 0; i < 16; ++i) { kk[i] = kp[i]; ks0 += kk[i].x * S[4 * i] + kk[i].z * S[4 * i + 2]; ks1 += kk[i].y * S[4 * i + 1] + kk[i].w * S[4 * i + 3]; }
        float kS = ks0 + ks1; kS += __shfl_xor(kS, 1);
        const float cc = beta * (v - eg * kS);
        float o0 = 0.f, o1 = 0.f;
#pragma unroll
        for (int i = 0; i < 16; ++i) { const f32x4 qq = qp[i];
            S[4 * i] = eg * S[4 * i] + kk[i].x * cc; S[4 * i + 1] = eg * S[4 * i + 1] + kk[i].y * cc; S[4 * i + 2] = eg * S[4 * i + 2] + kk[i].z * cc; S[4 * i + 3] = eg * S[4 * i + 3] + kk[i].w * cc;
            o0 += S[4 * i] * qq.x + S[4 * i + 2] * qq.z; o1 += S[4 * i + 1] * qq.y + S[4 * i + 3] * qq.w; }
        float o = o0 + o1; o += __shfl_xor(o, 1);
        if (half == 0) GOp[rh * 128 + col] = o;
    }
    float* so = F.out + (isP ? O_PGDN + (((size_t)seq * NL + l) * GH + h) * 16384 : O_SGDN + (((size_t)(seq - 4) * NL + l) * GH + h) * 16384) + (size_t)half * 64 * 128 + col;
#pragma unroll
    for (int d = 0; d < 64; ++d) so[d * 128] = S[d];
}


__device__ __forceinline__ bf16x8 pack8(f32x4 a, f32x4 b) {
    u32x4 u; u.x = pg8::cvt_pk_bf16(a.x, a.y); u.y = pg8::cvt_pk_bf16(a.z, a.w); u.z = pg8::cvt_pk_bf16(b.x, b.y); u.w = pg8::cvt_pk_bf16(b.z, b.w);
    return __builtin_bit_cast(bf16x8, u);
}
#define MFMA16(a, b, c) __builtin_amdgcn_mfma_f32_16x16x32_bf16((a), (b), (c), 0, 0, 0)


template <int MODE, int PER>
__device__ __forceinline__ void skinny_gemm(Frame& F, const bf16* A, int lda, const bf16* Bt, int K, int nitems, float* outF, bf16* outB, int ldc) {
    const int lane = F.lane, wid = F.wave, q = lane >> 4, r16 = lane & 15;
    LAS float* red = (LAS float*)F.lds;
#pragma unroll 1
    for (int it = F.G - 1 - F.bid; it < nitems; it += F.G) {
        const int n0 = MODE != 1 ? it * 16 : (it >> 3) * 256 + (it & 7) * 16;
        const bf16* ap = A + (size_t)(r16 & 7) * lda + q * 8 + (size_t)wid * PER * 32;
        const bf16* bp0 = Bt + (size_t)(n0 + r16) * K + q * 8 + (size_t)wid * PER * 32;
        f32x4 acc0 = (f32x4){0.f, 0.f, 0.f, 0.f}, acc1 = acc0;
        constexpr int U = (PER % 11 == 0) ? 11 : 8;
#pragma unroll 1
        for (int s0 = 0; s0 < PER; s0 += U) {
            bf16x8 af[U], w0[U], w1[U];
#pragma unroll
            for (int u = 0; u < U; ++u) { af[u] = *(const bf16x8*)(ap + (s0 + u) * 32); w0[u] = *(const bf16x8*)(bp0 + (s0 + u) * 32); if (MODE == 1) w1[u] = *(const bf16x8*)(bp0 + (size_t)128 * K + (s0 + u) * 32); }
#pragma unroll
            for (int u = 0; u < U; ++u) { acc0 = MFMA16(w0[u], af[u], acc0); if (MODE == 1) acc1 = MFMA16(w1[u], af[u], acc1); }
        }
        *(LAS f32x4*)(red + (wid * 2 + 0) * 256 + lane * 4) = acc0;
        if (MODE == 1) *(LAS f32x4*)(red + (wid * 2 + 1) * 256 + lane * 4) = acc1;
        __syncthreads();
        if (wid == 0 && r16 < 8) {
            f32x4 s0v = (f32x4){0.f, 0.f, 0.f, 0.f}, s1v = s0v;
#pragma unroll
            for (int w = 0; w < 8; ++w) { s0v = s0v + *(const LAS f32x4*)(red + (w * 2 + 0) * 256 + lane * 4); if (MODE == 1) s1v = s1v + *(const LAS f32x4*)(red + (w * 2 + 1) * 256 + lane * 4); }
            if (MODE == 0) *(f32x4*)(outF + (size_t)(MP + r16) * ldc + n0 + 4 * q) = s0v;
            else if (MODE == 2) { u32x2 w2; w2.x = pg8::cvt_pk_bf16(s0v[0], s0v[1]); w2.y = pg8::cvt_pk_bf16(s0v[2], s0v[3]); *(u32x2*)(outB + (size_t)(MP + r16) * ldc + n0 + 4 * q) = w2; }
            else { float o[4];
#pragma unroll
                for (int j = 0; j < 4; ++j) o[j] = s0v[j] / (1.0f + __expf(-s0v[j])) * s1v[j];
                u32x2 w2; w2.x = pg8::cvt_pk_bf16(o[0], o[1]); w2.y = pg8::cvt_pk_bf16(o[2], o[3]);
                *(u32x2*)(outB + (size_t)(MP + r16) * ldc + it * 16 + 4 * q) = w2; }
        }
        __syncthreads();
    }
}


template <int MODE, int KSTEPS>
__device__ __forceinline__ void skinny_wave(Frame& F, const bf16* A, int lda, const bf16* Bt, int K, int nitems, float* outF, bf16* outB, int ldc, int rank, int nw) {
    const int lane = F.lane, q = lane >> 4, r16 = lane & 15;
#pragma unroll 1
    for (int it = rank; it < nitems; it += nw) {
        const int n0 = MODE == 0 ? it * 16 : (it >> 3) * 256 + (it & 7) * 16;
        const bf16* ap = A + (size_t)(r16 & 7) * lda + q * 8;
        const bf16* bp = Bt + (size_t)(n0 + r16) * K + q * 8;
        f32x4 acc0 = (f32x4){0.f, 0.f, 0.f, 0.f}, acc1 = acc0;
        constexpr int U = MODE == 0 ? 16 : 8;
#pragma unroll 1
        for (int s0 = 0; s0 < KSTEPS; s0 += U) { bf16x8 af[U], w0[U], w1[U];
#pragma unroll
            for (int u = 0; u < U; ++u) { af[u] = *(const bf16x8*)(ap + (s0 + u) * 32); w0[u] = *(const bf16x8*)(bp + (s0 + u) * 32); if (MODE == 1) w1[u] = *(const bf16x8*)(bp + (size_t)128 * K + (s0 + u) * 32); }
#pragma unroll
            for (int u = 0; u < U; ++u) { if (MODE == 1) { acc0 = MFMA16(w0[u], af[u], acc0); acc1 = MFMA16(w1[u], af[u], acc1); }
                else { if (u & 1) acc1 = MFMA16(w0[u], af[u], acc1); else acc0 = MFMA16(w0[u], af[u], acc0); } } }
        if (r16 < 8) {
            if (MODE == 0) *(f32x4*)(outF + (size_t)(MP + r16) * ldc + n0 + 4 * q) = acc0 + acc1;
            else { float o[4];
#pragma unroll
                for (int j = 0; j < 4; ++j) o[j] = acc0[j] / (1.0f + __expf(-acc0[j])) * acc1[j];
                u32x2 w2; w2.x = pg8::cvt_pk_bf16(o[0], o[1]); w2.y = pg8::cvt_pk_bf16(o[2], o[3]);
                *(u32x2*)(outB + (size_t)(MP + r16) * ldc + it * 16 + 4 * q) = w2; }
        }
    }
}
__device__ __forceinline__ void phase_cmp_direct(Frame& F) {
    const int lane = F.lane, wid = F.wave, q = lane >> 4, r16 = lane & 15;
    LAS unsigned char* lb = F.lds;
    constexpr int BB = 16384;
    const float* cache = (const float*)F.in[2]; const int* page_table = (const int*)F.in[7];
    const bf16* W1B = (const bf16*)(F.ws + WS_W1B); float* HID = (float*)(F.ws + WS_HIDS);
#pragma unroll 1
    for (int u = F.bid; u < 256; u += F.G) {
        const int combo = (u & 7) | (((u >> 3) & 1) << 3), mat = combo >> 2, pk = combo & 3, rt = u >> 4, l = mat >> 1, kv = mat & 1;
        const int rot = rt * 4;
        const float* arow[2];
#pragma unroll
        for (int mt = 0; mt < 2; ++mt) { const int m = rt * 256 + wid * 32 + mt * 16 + r16; const int b = m >> 9, j = (m >> 1) & 255, g = m & 1;
            const int phys = page_table[b * NPG + (j >> 1)];
            arow[mt] = cache + ((((size_t)phys * NL + l) * NKV + g) * PAGE + (j & 1) * 64) * 256 + kv * 128 + (size_t)(16 * pk) * 256 + 8 * q; }
        const bf16* brow[2];
#pragma unroll
        for (int i = 0; i < 2; ++i) brow[i] = W1B + (size_t)mat * 256 * 8192 + ((size_t)(64 * pk) * 256 + wid * 32 + i * 16 + (lane >> 2)) * 32 + (((lane & 3) ^ ((0x78 >> (2 * (lane >> 4))) & 3)) * 8);
#define CMPD_B(t, slot) do { _Pragma("unroll") for (int i = 0; i < 2; ++i) \
            __builtin_amdgcn_global_load_lds((const unsigned*)(brow[i] + (((t) + rot) & 63) * 8192), (LAS unsigned*)(lb + (slot) * BB + (wid * 2 + i) * 1024), 16, 0, 0); } while (0)
#define CMPD_A(t, j) do { const int tt = ((t) + rot) & 63; _Pragma("unroll") for (int mt = 0; mt < 2; ++mt) { const float* ap = arow[mt] + (tt >> 2) * 256 + (tt & 3) * 32; \
            ar[j][2 * mt] = *(const f32x4*)ap; ar[j][2 * mt + 1] = *(const f32x4*)(ap + 4); } } while (0)
        f32x4 acc[2][16];
#pragma unroll
        for (int mt = 0; mt < 2; ++mt)
#pragma unroll
            for (int nt = 0; nt < 16; ++nt) acc[mt][nt] = (f32x4){0.f, 0.f, 0.f, 0.f};
        f32x4 ar[4][4];
        __syncthreads();
#pragma unroll
        for (int j = 0; j < 4; ++j) { CMPD_B(j, j); CMPD_A(j, j); }
        const int boff = r16 * 64 + ((q ^ ((0x78 >> (2 * ((r16 >> 2) & 3))) & 3)) << 4);
        int slot = 0;
#pragma unroll 1
        for (int t0 = 0; t0 < 64; t0 += 4) {
#pragma unroll
            for (int j = 0; j < 4; ++j) {
                const int t = t0 + j;
                if (t0 < 60) asm volatile("s_waitcnt vmcnt(18) lgkmcnt(0)" ::: "memory"); else asm volatile("s_waitcnt vmcnt(0) lgkmcnt(0)" ::: "memory");
                __builtin_amdgcn_s_barrier();
                const LAS unsigned char* bb = lb + slot * BB + boff;
                bf16x8 af[2];
#pragma unroll
                for (int mt = 0; mt < 2; ++mt) af[mt] = pack8(ar[j][2 * mt], ar[j][2 * mt + 1]);
                int ns = slot + 4; if (ns >= 5) ns -= 5;
                if (t0 < 60) { CMPD_B(t + 4, ns); CMPD_A(t + 4, j); }
#pragma unroll
                for (int g2 = 0; g2 < 8; ++g2) { bf16x8 bf[2];
#pragma unroll
                    for (int e = 0; e < 2; ++e) bf[e] = *(const LAS bf16x8*)(bb + (2 * g2 + e) * 1024);
                    __builtin_amdgcn_sched_barrier(0);
#pragma unroll
                    for (int e = 0; e < 2; ++e) { acc[0][2 * g2 + e] = MFMA16(bf[e], af[0], acc[0][2 * g2 + e]); acc[1][2 * g2 + e] = MFMA16(bf[e], af[1], acc[1][2 * g2 + e]); } }
                slot = slot + 1; if (slot >= 5) slot = 0;
            }
        }
#undef CMPD_A
#undef CMPD_B
        float* hp = HID + (size_t)pk * ((size_t)16384 * 256);
#pragma unroll
        for (int mt = 0; mt < 2; ++mt) { float* rp = hp + (size_t)(mat * 4096 + rt * 256 + wid * 32 + mt * 16 + r16) * 256 + 4 * q;
#pragma unroll
            for (int nt = 0; nt < 16; ++nt) *(f32x4*)(rp + 16 * nt) = acc[mt][nt]; }
    }
    __syncthreads();
}

#ifndef GP_W0
#define GP_W0 128
#define GP_NW 8
#endif
__device__ __forceinline__ void phase_gdn_pre(Frame& F, int l) {
    if (F.bid < GP_W0 || F.wave >= GP_NW) return;
    const int NGW = (F.G - GP_W0) * GP_NW, gw = (F.bid - GP_W0) * GP_NW + F.wave;
    const int lane0 = F.lane;
    LAS float* Af = (LAS float*)(F.lds + F.wave * 16896);
    LAS unsigned char* Tb = (LAS unsigned char*)Af;
    const float* GQp = (const float*)(F.ws + WS_GQ); const float* GKp = (const float*)(F.ws + WS_GK); const float* GVp = (const float*)(F.ws + WS_GV);
    const float* GGp = (const float*)(F.ws + WS_GG); const float* GBp = (const float*)(F.ws + WS_GB); float* GDECp = (float*)(F.ws + WS_GDEC);
#pragma unroll 1
    for (int it = gw; it < 1024; it += NGW) {
        int lane = lane0; asm volatile("" : "+v"(lane));
        const int q = lane >> 4, r16 = lane & 15;
        const int c = it & 31, p = it >> 5, h = p & 7, b = p >> 3;
        const int row0 = b * SEQ + c * 64;
        unsigned char* fr = F.ws + WS_GFR + (size_t)it * FR_CH;
        const float gg = GGp[(size_t)(row0 + lane) * 8 + h], bt = GBp[(size_t)(row0 + lane) * 8 + h];
        float gc = gg;
#pragma unroll
        for (int o = 1; o < 64; o <<= 1) { const float tt = __shfl_up(gc, o); if (lane >= o) gc += tt; }
        const float gl = __shfl(gc, 63);
        if (lane == 0) GDECp[it] = __expf(gl);
        bf16x8 kf[4][4];
#pragma unroll
        for (int mt = 0; mt < 4; ++mt)
#pragma unroll
            for (int s = 0; s < 4; ++s) { const float* kr = GKp + ((size_t)(row0 + 16 * mt + r16) * 8 + h) * 128 + 32 * s + 4 * q; kf[mt][s] = pack8(*(const f32x4*)kr, *(const f32x4*)(kr + 16)); }
        asm volatile("s_waitcnt lgkmcnt(0)" ::: "memory");
#pragma unroll
        for (int mt = 0; mt < 4; ++mt)
#pragma unroll
            for (int nt = 0; nt <= mt; ++nt) {
                f32x4 acc = (f32x4){0.f, 0.f, 0.f, 0.f};
#pragma unroll
                for (int s = 0; s < 4; ++s) acc = MFMA16(kf[mt][s], kf[nt][s], acc);
                const int j = 16 * nt + r16; const float gcj = __shfl(gc, j);
#pragma unroll
                for (int r = 0; r < 4; ++r) { const int i = 16 * mt + 4 * q + r; const float gi = __shfl(gc, i), bi = __shfl(bt, i);
                    Af[i * 64 + j] = (j < i) ? bi * acc[r] * __expf(gi - gcj) : 0.f; }
            }
        {
            bf16x8 qf[4][4];
#pragma unroll
            for (int mt = 0; mt < 4; ++mt) { const float egi = __expf(__shfl(gc, 16 * mt + r16));
#pragma unroll
                for (int s = 0; s < 4; ++s) { const float* qr = GQp + ((size_t)(row0 + 16 * mt + r16) * 8 + h) * 128 + 32 * s + 4 * q;
                    const f32x4 a = *(const f32x4*)qr, b2 = *(const f32x4*)(qr + 16); qf[mt][s] = pack8(a, b2);
                    *(bf16x8*)(fr + FR_Q + ((mt * 4 + s) * 64 + lane) * 16) = pack8(a * egi, b2 * egi); } }
#pragma unroll
            for (int nt = 0; nt < 4; ++nt) { const int i = 16 * nt + r16; const float gci = __shfl(gc, i);
#pragma unroll
                for (int sp = 0; sp < 2; ++sp) { f32x4 v0 = (f32x4){0.f, 0.f, 0.f, 0.f}, v1 = v0;
                    if (2 * sp <= nt) { f32x4 acc = (f32x4){0.f, 0.f, 0.f, 0.f};
#pragma unroll
                        for (int s = 0; s < 4; ++s) acc = MFMA16(kf[2 * sp][s], qf[nt][s], acc);
#pragma unroll
                        for (int r = 0; r < 4; ++r) { const int jp = 32 * sp + 4 * q + r; const float gj = __shfl(gc, jp); v0[r] = (jp <= i) ? acc[r] * __expf(gci - gj) : 0.f; } }
                    if (2 * sp + 1 <= nt) { f32x4 acc = (f32x4){0.f, 0.f, 0.f, 0.f};
#pragma unroll
                        for (int s = 0; s < 4; ++s) acc = MFMA16(kf[2 * sp + 1][s], qf[nt][s], acc);
#pragma unroll
                        for (int r = 0; r < 4; ++r) { const int jp = 32 * sp + 16 + 4 * q + r; const float gj = __shfl(gc, jp); v1[r] = (jp <= i) ? acc[r] * __expf(gci - gj) : 0.f; } }
                    *(bf16x8*)(fr + FR_QK + ((nt * 2 + sp) * 64 + lane) * 16) = pack8(v0, v1); } }
        }
        float t[64];
#pragma unroll
        for (int i = 0; i < 64; ++i) {
            float acc = (lane == i) ? 1.f : 0.f;
#pragma unroll
            for (int j4 = 0; j4 < (i + 3) / 4; ++j4) { const f32x4 a = *(const LAS f32x4*)(Af + i * 64 + j4 * 4);
                if (4 * j4 + 0 < i) acc -= a.x * t[4 * j4 + 0];
                if (4 * j4 + 1 < i) acc -= a.y * t[4 * j4 + 1];
                if (4 * j4 + 2 < i) acc -= a.z * t[4 * j4 + 2];
                if (4 * j4 + 3 < i) acc -= a.w * t[4 * j4 + 3]; }
            t[i] = acc;
            if ((i & 3) == 3) asm volatile("" ::: "memory");
        }
        asm volatile("s_waitcnt lgkmcnt(0)" ::: "memory");
        { const float sb = bt, sg = bt * __expf(gc);
#pragma unroll
          for (int i = 0; i < 64; ++i) { const int off = i * 128 + ((((lane >> 3) ^ (i & 7)) << 4) + (lane & 7) * 2);
              *(LAS unsigned short*)(Tb + off) = (unsigned short)f2bf(t[i] * sb); *(LAS unsigned short*)(Tb + 8192 + off) = (unsigned short)f2bf(t[i] * sg); } }
        asm volatile("s_waitcnt lgkmcnt(0)" ::: "memory");
        {
            bf16x8 ta[4][2];
#pragma unroll
            for (int mt = 0; mt < 4; ++mt)
#pragma unroll
                for (int sp = 0; sp < 2; ++sp) ta[mt][sp] = *(const LAS bf16x8*)(Tb + (16 * mt + r16) * 128 + (((4 * sp + q) ^ (r16 & 7)) << 4));
#pragma unroll 4
            for (int n8 = 0; n8 < 8; ++n8) { bf16x8 vb[2];
#pragma unroll
                for (int sp = 0; sp < 2; ++sp) { float x[8];
#pragma unroll
                    for (int jj = 0; jj < 8; ++jj) x[jj] = GVp[((size_t)(row0 + 32 * sp + 8 * q + jj) * 8 + h) * 128 + 16 * n8 + r16];
                    vb[sp] = pack8((f32x4){x[0], x[1], x[2], x[3]}, (f32x4){x[4], x[5], x[6], x[7]}); }
#pragma unroll
                for (int mt = 0; mt < 4; ++mt) { f32x4 acc = (f32x4){0.f, 0.f, 0.f, 0.f};
#pragma unroll
                    for (int sp = 0; sp < 2; ++sp) acc = MFMA16(ta[mt][sp], vb[sp], acc);
                    *(f32x4*)(fr + FR_U + ((n8 * 4 + mt) * 64 + lane) * 16) = acc; } }
        }
        {
            float fdec[2][8]; const float ed = __expf(gl - gc);
#pragma unroll
            for (int sp = 0; sp < 2; ++sp)
#pragma unroll
                for (int j = 0; j < 8; ++j) fdec[sp][j] = __shfl(ed, 32 * sp + (j < 4 ? 4 * q + j : 16 + 4 * q + j - 4));
            bf16x8 tb[4][2];
#pragma unroll
            for (int nt = 0; nt < 4; ++nt)
#pragma unroll
                for (int sp = 0; sp < 2; ++sp) { const int i = 16 * nt + r16;
                    const u32x2 lo = *(const LAS u32x2*)(Tb + 8192 + i * 128 + ((((4 * sp + (q >> 1)) ^ (i & 7)) << 4) + (q & 1) * 8));
                    const u32x2 hi = *(const LAS u32x2*)(Tb + 8192 + i * 128 + ((((4 * sp + 2 + (q >> 1)) ^ (i & 7)) << 4) + (q & 1) * 8));
                    u32x4 w4; w4.x = lo.x; w4.y = lo.y; w4.z = hi.x; w4.w = hi.y; tb[nt][sp] = __builtin_bit_cast(bf16x8, w4); }
#pragma unroll 2
            for (int s = 0; s < 4; ++s) {
                f32x4 acc[2][4];
#pragma unroll
                for (int e = 0; e < 2; ++e)
#pragma unroll
                    for (int nt = 0; nt < 4; ++nt) acc[e][nt] = (f32x4){0.f, 0.f, 0.f, 0.f};
#pragma unroll
                for (int e = 0; e < 2; ++e)
#pragma unroll
                    for (int sp = 0; sp < 2; ++sp) { float x[8];
#pragma unroll
                        for (int j = 0; j < 8; ++j) { const int tok = 32 * sp + (j < 4 ? 4 * q + j : 16 + 4 * q + j - 4);
                            x[j] = GKp[((size_t)(row0 + tok) * 8 + h) * 128 + 16 * (2 * s + e) + r16]; }
                        const bf16x8 ka = pack8((f32x4){x[0], x[1], x[2], x[3]}, (f32x4){x[4], x[5], x[6], x[7]});
#pragma unroll
                        for (int nt = 0; nt < 4; ++nt) acc[e][nt] = MFMA16(ka, tb[nt][sp], acc[e][nt]);
#pragma unroll
                        for (int j = 0; j < 8; ++j) x[j] *= fdec[sp][j];
                        *(bf16x8*)(fr + FR_K + (((2 * s + e) * 2 + sp) * 64 + lane) * 16) = pack8((f32x4){x[0], x[1], x[2], x[3]}, (f32x4){x[4], x[5], x[6], x[7]}); }
#pragma unroll
                for (int nt = 0; nt < 4; ++nt) *(bf16x8*)(fr + FR_W + ((nt * 4 + s) * 64 + lane) * 16) = pack8(-acc[0][nt], -acc[1][nt]);
            }
        }
        asm volatile("s_waitcnt lgkmcnt(0)" ::: "memory");
    }
}

__device__ __forceinline__ void phase_gdn_scan(Frame& F, int l) {
    if (F.bid >= 64) return;
    const int lane = F.lane, wid = F.wave, q = lane >> 4, r16 = lane & 15;
    const int hf = (F.bid >> 3) & 1, p = (F.bid >> 4) * 8 + (F.bid & 7), h = p & 7, b = p >> 3;
    const float* GDECp = (const float*)(F.ws + WS_GDEC); float* GOp = (float*)(F.ws + WS_GO);
    LAS unsigned char* lb = F.lds;
    constexpr int CB = 57344, UB = 16384, UOFF = 2 * CB, DOFF = 2 * CB + 2 * UB;
    __syncthreads();
    if (wid >= 4) {
        const int lw = wid - 4, sl = hf * 4 + lw;
        const unsigned char* fr = F.ws + WS_GFR + (size_t)(p * 32) * FR_CH;
#pragma unroll
        for (int f = 0; f < 14; ++f) __builtin_amdgcn_global_load_lds((const unsigned*)(fr + (lw + 4 * f) * 1024 + lane * 16), (LAS unsigned*)(lb + (lw + 4 * f) * 1024), 16, 0, 0);
        f32x4 u4[4];
#pragma unroll
        for (int mt = 0; mt < 4; ++mt) u4[mt] = *(const f32x4*)(fr + FR_U + ((sl * 4 + mt) * 64 + lane) * 16);
        const float d0 = GDECp[p * 32];
#pragma unroll
        for (int mt = 0; mt < 4; ++mt) *(LAS f32x4*)(lb + UOFF + (lw * 4 + mt) * 1024 + lane * 16) = u4[mt];
        if (wid == 4 && lane == 0) *(LAS float*)(lb + DOFF) = d0;
        asm volatile("s_waitcnt vmcnt(0) lgkmcnt(0)" ::: "memory");
    }
    __builtin_amdgcn_s_barrier();
    f32x4 S[8];
#pragma unroll
    for (int m = 0; m < 8; ++m) S[m] = (f32x4){0.f, 0.f, 0.f, 0.f};
    const int sl = hf * 4 + (wid & 3);
#pragma unroll 1
    for (int c = 0; c < 32; ++c) {
        if (wid >= 4) {
            if (c + 1 < 32) {
                const int lw = wid - 4, nbuf = (c + 1) & 1;
                const unsigned char* fr = F.ws + WS_GFR + (size_t)(p * 32 + c + 1) * FR_CH; LAS unsigned char* nb = lb + nbuf * CB;
#pragma unroll
                for (int f = 0; f < 14; ++f) __builtin_amdgcn_global_load_lds((const unsigned*)(fr + (lw + 4 * f) * 1024 + lane * 16), (LAS unsigned*)(nb + (lw + 4 * f) * 1024), 16, 0, 0);
                f32x4 u4[4];
#pragma unroll
                for (int mt = 0; mt < 4; ++mt) u4[mt] = *(const f32x4*)(fr + FR_U + ((sl * 4 + mt) * 64 + lane) * 16);
                const float dn = GDECp[p * 32 + c + 1];
#pragma unroll
                for (int mt = 0; mt < 4; ++mt) *(LAS f32x4*)(lb + UOFF + nbuf * UB + (lw * 4 + mt) * 1024 + lane * 16) = u4[mt];
                if (wid == 4 && lane == 0) *(LAS float*)(lb + DOFF + nbuf * 64) = dn;
                asm volatile("s_waitcnt vmcnt(0) lgkmcnt(0)" ::: "memory");
            }
        } else {
            const LAS unsigned char* cb = lb + (c & 1) * CB;
            const float dec = *(const LAS float*)(lb + DOFF + (c & 1) * 64);
            f32x4 vn[4], o[4];
#pragma unroll
            for (int mt = 0; mt < 4; ++mt) { vn[mt] = *(const LAS f32x4*)(lb + UOFF + (c & 1) * UB + (wid * 4 + mt) * 1024 + lane * 16); o[mt] = (f32x4){0.f, 0.f, 0.f, 0.f}; }
            bf16x8 Sb[4];
#pragma unroll
            for (int s = 0; s < 4; ++s) Sb[s] = pack8(S[2 * s], S[2 * s + 1]);
#pragma unroll
            for (int s = 0; s < 4; ++s) { bf16x8 wf[4], qf[4];
#pragma unroll
                for (int mt = 0; mt < 4; ++mt) { wf[mt] = *(const LAS bf16x8*)(cb + FR_W + ((mt * 4 + s) * 64 + lane) * 16); qf[mt] = *(const LAS bf16x8*)(cb + FR_Q + ((mt * 4 + s) * 64 + lane) * 16); }
#pragma unroll
                for (int mt = 0; mt < 4; ++mt) { vn[mt] = MFMA16(wf[mt], Sb[s], vn[mt]); o[mt] = MFMA16(qf[mt], Sb[s], o[mt]); } }
            bf16x8 Vb[2];
#pragma unroll
            for (int sp = 0; sp < 2; ++sp) Vb[sp] = pack8(vn[2 * sp], vn[2 * sp + 1]);
#pragma unroll
            for (int m2 = 0; m2 < 4; ++m2) { bf16x8 kf[4];
#pragma unroll
                for (int e = 0; e < 4; ++e) kf[e] = *(const LAS bf16x8*)(cb + FR_K + (((2 * m2 + (e >> 1)) * 2 + (e & 1)) * 64 + lane) * 16);
                S[2 * m2] = S[2 * m2] * dec; S[2 * m2 + 1] = S[2 * m2 + 1] * dec;
                S[2 * m2] = MFMA16(kf[0], Vb[0], S[2 * m2]); S[2 * m2 + 1] = MFMA16(kf[2], Vb[0], S[2 * m2 + 1]);
                S[2 * m2] = MFMA16(kf[1], Vb[1], S[2 * m2]); S[2 * m2 + 1] = MFMA16(kf[3], Vb[1], S[2 * m2 + 1]); }
            { bf16x8 gf[8];
#pragma unroll
              for (int e = 0; e < 8; ++e) gf[e] = *(const LAS bf16x8*)(cb + FR_QK + (e * 64 + lane) * 16);
#pragma unroll
              for (int mt = 0; mt < 4; ++mt) { o[mt] = MFMA16(gf[mt * 2], Vb[0], o[mt]); }
#pragma unroll
              for (int mt = 0; mt < 4; ++mt) { o[mt] = MFMA16(gf[mt * 2 + 1], Vb[1], o[mt]); } }
#pragma unroll
            for (int mt = 0; mt < 4; ++mt)
#pragma unroll
                for (int r = 0; r < 4; ++r) GOp[((size_t)(b * SEQ + c * 64 + 16 * mt + 4 * q + r) * 8 + h) * 128 + sl * 16 + r16] = o[mt][r];
            asm volatile("s_waitcnt lgkmcnt(0)" ::: "memory");
        }
        __builtin_amdgcn_s_barrier();
    }
    if (wid < 4) {
        float* so = F.out + O_PGDN + (((size_t)b * NL + l) * GH + h) * 16384 + sl * 16 + r16;
#pragma unroll
        for (int m = 0; m < 8; ++m)
#pragma unroll
            for (int r = 0; r < 4; ++r) so[(size_t)(16 * m + 4 * q + r) * 128] = S[m][r];
    }
    __syncthreads();
}

__device__ __forceinline__ void phase_gdn_out(Frame& F, int l) {
    if (F.bid < 16 || F.bid >= 160) return;
    const int lane = F.lane, qb = F.bid >> 3;
    int cum = (F.bid & 7) * (29 - qb);
    for (int qq = 2; qq < qb; ++qq) cum += 8 * (29 - qq);
    const int r_lo = (int)(((long)MT * cum) / 2664), r_hi = (int)(((long)MT * (cum + 29 - qb)) / 2664);
    const float* gn = ((const float*)F.in[20]) + l * 128;
    const float g0 = gn[lane], g1 = gn[64 + lane];
    for (int r = r_lo + F.wave; r < r_hi; r += NWAVES) {
        const float* go = ((const float*)(F.ws + WS_GO)) + (size_t)r * 1024; const float* z = ((const float*)(F.ws + WS_PROJ)) + (size_t)r * NIN + PZ;
        float o[16], zz[16], ss[8];
#pragma unroll
        for (int i = 0; i < 16; ++i) { o[i] = go[(i >> 1) * 128 + (i & 1) * 64 + lane]; zz[i] = z[(i >> 1) * 128 + (i & 1) * 64 + lane]; }
#pragma unroll
        for (int h = 0; h < 8; ++h) ss[h] = o[2 * h] * o[2 * h] + o[2 * h + 1] * o[2 * h + 1];
#pragma unroll
        for (int ofs = 1; ofs < 64; ofs <<= 1)
#pragma unroll
            for (int h = 0; h < 8; ++h) ss[h] += __shfl_xor(ss[h], ofs);
        bf16* dst = ((bf16*)(F.ws + WS_OMIX)) + (size_t)r * DM + 1024;
#pragma unroll
        for (int h = 0; h < 8; ++h) { const float rs = __builtin_amdgcn_rsqf(ss[h] * (1.0f / 128.0f) + EPS);
            dst[h * 128 + lane] = (bf16)f2bf(o[2 * h] * rs * g0 * (zz[2 * h] * __builtin_amdgcn_rcpf(1.0f + __expf(-zz[2 * h])))); dst[h * 128 + 64 + lane] = (bf16)f2bf(o[2 * h + 1] * rs * g1 * (zz[2 * h + 1] * __builtin_amdgcn_rcpf(1.0f + __expf(-zz[2 * h + 1])))); }
    }
}

struct Soft { float m[4], l[4], a0[4], a1[4]; };
__device__ __forceinline__ void soft_init(Soft& s) {
#pragma unroll
    for (int i = 0; i < 4; ++i) { s.m[i] = -INFINITY; s.l[i] = 0.f; s.a0[i] = 0.f; s.a1[i] = 0.f; }
}
__device__ __forceinline__ void attn_block(const LAS float* qs, const float* kptr, const float* vbase, int vstride, int k_lo, int k_hi, int lane, Soft& st, float (&sout)[4]) {
    const bool valid = lane >= k_lo && lane <= k_hi;
    float s[4] = {0.f, 0.f, 0.f, 0.f};
    if (valid) {
#pragma unroll 1
        for (int half = 0; half < 2; ++half) { f32x4 kk[16];
#pragma unroll
            for (int i = 0; i < 16; ++i) kk[i] = *(const f32x4*)(kptr + half * 64 + i * 4);
#pragma unroll
            for (int i = 0; i < 16; ++i)
#pragma unroll
                for (int hh = 0; hh < 4; ++hh) { const f32x4 qq = *(const LAS f32x4*)(qs + hh * 128 + half * 64 + i * 4); s[hh] += (kk[i].x * qq.x + kk[i].y * qq.y) + (kk[i].z * qq.z + kk[i].w * qq.w); } }
    }
    float p[4];
#pragma unroll
    for (int hh = 0; hh < 4; ++hh) {
        s[hh] = valid ? s[hh] * 0.08838834764831845f : -INFINITY; sout[hh] = s[hh];
        const float mn = fmaxf(st.m[hh], wave_max(s[hh]));
        const float corr = (st.m[hh] == -INFINITY) ? 0.f : expf(st.m[hh] - mn);
        p[hh] = valid ? expf(s[hh] - mn) : 0.f;
        st.l[hh] = st.l[hh] * corr + wave_sum(p[hh]); st.a0[hh] *= corr; st.a1[hh] *= corr; st.m[hh] = mn;
    }
    int k = k_lo;
#pragma unroll 1
    for (; k + 7 <= k_hi; k += 8) { float v0[8], v1[8];
#pragma unroll
        for (int e = 0; e < 8; ++e) { const float* vr = vbase + (size_t)(k + e) * vstride; v0[e] = vr[lane]; v1[e] = vr[64 + lane]; }
#pragma unroll
        for (int e = 0; e < 8; ++e)
#pragma unroll
            for (int hh = 0; hh < 4; ++hh) { const float pb = __shfl(p[hh], k + e); st.a0[hh] += pb * v0[e]; st.a1[hh] += pb * v1[e]; } }
#pragma unroll 1
    for (; k <= k_hi; ++k) { const float* vr = vbase + (size_t)k * vstride; const float v0 = vr[lane], v1 = vr[64 + lane];
#pragma unroll
        for (int hh = 0; hh < 4; ++hh) { const float pb = __shfl(p[hh], k); st.a0[hh] += pb * v0; st.a1[hh] += pb * v1; } }
}

__device__ __forceinline__ void phase_nsa_sample(Frame& F, int l) {
    if (F.bid >= MS * 2) return;
    const int tid = F.tid, lane = F.lane, wid = F.wave;
    const int s = F.bid >> 1, g = F.bid & 1, r = MP + s;
    LAS float* qs = (LAS float*)F.lds;
    LAS float* imps = qs + 512;
    LAS unsigned* selw = (LAS unsigned*)(imps + 256);
    LAS float* part = imps + 512;
    constexpr int PST = 520;
    const float* QFp = (const float*)(F.ws + WS_QF); const float* CBSp = (const float*)(F.ws + WS_CBS); const float* GATp = (const float*)(F.ws + WS_GATES);
    const float* cache_sel = (const float*)F.in[3]; const float* cache_win = (const float*)F.in[4]; const int* page_table = (const int*)F.in[7];
    __syncthreads();
    qs[tid] = QFp[((size_t)r * 8 + g * 4) * 128 + tid];
    __syncthreads();
    Soft sc, ss, sw; soft_init(sc); soft_init(ss); soft_init(sw);
    float sraw[4] = {0.f, 0.f, 0.f, 0.f}, sdum[4];
    const float* kcb = CBSp + (((size_t)(l * 2 + 0) * 4096) + ((size_t)s * 256) * 2 + g) * 128; const float* vcb = kcb + (size_t)4096 * 128;
    if (wid < 4) attn_block(qs, kcb + ((size_t)wid * 64 + lane) * 256, vcb + (size_t)wid * 64 * 256, 256, 0, 63, lane, sc, sraw);
    { LAS float* pp = part + (wid * 3 + 0) * PST;
#pragma unroll
      for (int hh = 0; hh < 4; ++hh) { if (lane == 0) { pp[hh] = sc.m[hh]; pp[4 + hh] = sc.l[hh]; } pp[8 + hh * 128 + lane] = sc.a0[hh]; pp[8 + hh * 128 + 64 + lane] = sc.a1[hh]; } }
    __syncthreads();
    if (wid < 4) {
        float imp = 0.f;
#pragma unroll
        for (int hh = 0; hh < 4; ++hh) { float M = -INFINITY;
#pragma unroll
            for (int w = 0; w < 4; ++w) M = fmaxf(M, part[(w * 3) * PST + hh]);
            float L = 0.f;
#pragma unroll
            for (int w = 0; w < 4; ++w) L += part[(w * 3) * PST + 4 + hh] * expf(part[(w * 3) * PST + hh] - M);
            imp += expf(sraw[hh] - M) / L; }
        imps[wid * 64 + lane] = imp;
    }
    __syncthreads();
    if (wid < 4) {
        const int j = tid; const float mine = imps[j]; int cnt = 0;
#pragma unroll 2
        for (int jj = 1; jj <= 254; ++jj) { const float o = imps[jj]; cnt += (o > mine || (o == mine && jj < j)) ? 1 : 0; }
        const bool sel = (j == 0) || (j == 255) || (j >= 1 && j <= 254 && cnt < 13);
        const unsigned long long bal = __ballot(sel);
        if (lane == 0) { selw[wid * 2] = (unsigned)bal; selw[wid * 2 + 1] = (unsigned)(bal >> 32); }
    }
    __syncthreads();
    if (wid < 4) {
        const int j = tid; const unsigned lo = selw[wid * 2], hi = selw[wid * 2 + 1];
        const unsigned long long bal = ((unsigned long long)hi << 32) | lo;
        if ((bal >> lane) & 1ull) { int pos = __popcll(bal & ((1ull << lane) - 1ull));
            for (int w = 0; w < wid; ++w) pos += __popc(selw[w * 2]) + __popc(selw[w * 2 + 1]);
            if (pos < 15) selw[8 + pos] = (unsigned)j; }
    }
    __syncthreads();
#pragma unroll 1
    for (int t = wid; t < 25; t += 8) {
        if (t < 15) { const int idx = (int)selw[8 + t];
            const int phys = page_table[s * NPG + (idx >> 1)];
            const float* blk = cache_sel + (((((size_t)phys * NL + l) * NKV + g) * 2 + (idx & 1)) * 64) * 256;
            attn_block(qs, blk + (size_t)lane * 256, blk + 128, 256, 0, 63, lane, ss, sdum);
        } else if (t == 15) { const float* nw = F.out + O_SSEL + (((size_t)s * NL + l) * NKV + g) * 256;
            attn_block(qs, nw, nw + 128, 256, 0, 0, lane, ss, sdum);
        } else if (t < 24) { const int c = t - 16; const float* wb = cache_win + ((((size_t)s * NL + l) * NKV + g) * WIN) * 256;
            attn_block(qs, wb + ((size_t)c * 64 + lane) * 256, wb + (size_t)c * 64 * 256 + 128, 256, 0, 63, lane, sw, sdum);
        } else { const float* nw = F.out + O_SWIN + ((((size_t)s * NL + l) * NKV + g) * WIN + (WIN - 1)) * 256;
            attn_block(qs, nw, nw + 128, 256, 0, 0, lane, sw, sdum); }
    }
    { LAS float* p1 = part + (wid * 3 + 1) * PST; LAS float* p2 = part + (wid * 3 + 2) * PST;
#pragma unroll
      for (int hh = 0; hh < 4; ++hh) { if (lane == 0) { p1[hh] = ss.m[hh]; p1[4 + hh] = ss.l[hh]; p2[hh] = sw.m[hh]; p2[4 + hh] = sw.l[hh]; }
          p1[8 + hh * 128 + lane] = ss.a0[hh]; p1[8 + hh * 128 + 64 + lane] = ss.a1[hh]; p2[8 + hh * 128 + lane] = sw.a0[hh]; p2[8 + hh * 128 + 64 + lane] = sw.a1[hh]; } }
    __syncthreads();
    { const int hh = tid >> 7, d = tid & 127; float res = 0.f;
#pragma unroll
      for (int br = 0; br < 3; ++br) { const int nw = br == 0 ? 4 : 8; float M = -INFINITY;
          for (int w = 0; w < nw; ++w) M = fmaxf(M, part[(w * 3 + br) * PST + hh]);
          float L = 0.f, A = 0.f;
          for (int w = 0; w < nw; ++w) { const float mw = part[(w * 3 + br) * PST + hh]; if (mw == -INFINITY) continue; const float e = expf(mw - M);
              L += part[(w * 3 + br) * PST + 4 + hh] * e; A += part[(w * 3 + br) * PST + 8 + hh * 128 + d] * e; }
          const float gt = GATp[(size_t)r * 24 + (g * 4 + hh) * 3 + br];
          res += L > 0.f ? gt * A / L : 0.f; }
      ((bf16*)(F.ws + WS_OMIX))[(size_t)r * DM + (g * 4 + hh) * 128 + d] = (bf16)f2bf(res); }
    __syncthreads();
}

namespace att {
typedef short s16x4 __attribute__((ext_vector_type(4)));
typedef float f32x16 __attribute__((ext_vector_type(16)));
constexpr int SHM = 16384;
constexpr float SCALE = 0.08838834764831845f, THR = 8.f, C2 = 1.4426950408889634f * SCALE;
#define ATT_KSWZ(row, colB) ((row) * 256 + ((colB) ^ (((row) & 7) << 4)))
#define ATT_SBAR() __builtin_amdgcn_sched_barrier(0)
__device__ __forceinline__ int v_st(int k, int c) { const int kk = (k & ~0xC) | ((k & 4) << 1) | ((k & 8) >> 1); return ((kk >> 3) * 4 + (c >> 5)) * 512 + ((kk & 7) * 32 + (c & 31)) * 2; }
__device__ __forceinline__ int v_rd_base(int lane) { return ((lane & 3) << 3) | (((lane >> 2) & 3) << 6) | (((lane >> 4) & 1) << 5) | (((lane >> 5) & 1) << 8); }
constexpr int v_rd_off(int d0, int ks, int half) { return d0 * 512 + ks * 4096 + half * 2048; }
__device__ __forceinline__ int crow(int r, int hi) { return (r & 3) + 8 * (r >> 2) + 4 * hi; }
__device__ __forceinline__ void partialSM(f32x16& p0, f32x16& p1, float& m_reg, float& mn, float& alpha) {
    float pmax = p0[0];
#pragma unroll
    for (int r = 1; r < 16; ++r) pmax = fmaxf(pmax, p0[r]);
#pragma unroll
    for (int r = 0; r < 16; ++r) pmax = fmaxf(pmax, p1[r]);
    { auto rr = __builtin_amdgcn_permlane32_swap(__float_as_uint(pmax), __float_as_uint(pmax), false, false);
      pmax = fmaxf(__uint_as_float(rr[0]), __uint_as_float(rr[1])); }
    if (__builtin_expect(__all((pmax - m_reg) * SCALE <= THR), 1)) { mn = m_reg; alpha = 1.f; }
    else { mn = fmaxf(m_reg, pmax); alpha = __builtin_amdgcn_exp2f((m_reg - mn) * C2); m_reg = mn; }
    const float mnL = -mn * C2;
#pragma unroll
    for (int r = 0; r < 16; ++r) p0[r] = fmaf(p0[r], C2, mnL);
#pragma unroll
    for (int r = 0; r < 16; ++r) p1[r] = fmaf(p1[r], C2, mnL);
#pragma unroll
    for (int r = 0; r < 16; ++r) p0[r] = __builtin_amdgcn_exp2f(p0[r]);
}
__device__ __forceinline__ void finishSM(f32x16& p0, f32x16& p1, float alpha, float& l_reg, bf16x8& pa0, bf16x8& pa1, bf16x8& pa2, bf16x8& pa3) {
#pragma unroll
    for (int r = 0; r < 16; ++r) p1[r] = __builtin_amdgcn_exp2f(p1[r]);
    float ps = 0;
#pragma unroll
    for (int r = 0; r < 16; ++r) ps += p0[r];
#pragma unroll
    for (int r = 0; r < 16; ++r) ps += p1[r];
    { auto rr = __builtin_amdgcn_permlane32_swap(__float_as_uint(ps), __float_as_uint(ps), false, false);
      ps = __uint_as_float(rr[0]) + __uint_as_float(rr[1]); }
    l_reg = l_reg * alpha + ps;
#define ATT_PK4(P, B_, OUT) do { unsigned a0 = pg8::cvt_pk_bf16(P[B_+0], P[B_+1]), a1 = pg8::cvt_pk_bf16(P[B_+2], P[B_+3]);                          \
        unsigned b0 = pg8::cvt_pk_bf16(P[B_+4], P[B_+5]), b1 = pg8::cvt_pk_bf16(P[B_+6], P[B_+7]);                                             \
        auto r0 = __builtin_amdgcn_permlane32_swap(a0, b0, false, false); auto r1 = __builtin_amdgcn_permlane32_swap(a1, b1, false, false); \
        u32x4 w = {r0[0], r1[0], r0[1], r1[1]}; OUT = __builtin_bit_cast(bf16x8, w); } while (0)
    ATT_PK4(p0, 0, pa0); ATT_PK4(p0, 8, pa1); ATT_PK4(p1, 0, pa2); ATT_PK4(p1, 8, pa3);
#undef ATT_PK4
}
template <bool ZERO>
__device__ __forceinline__ void qkt(f32x16& p0, f32x16& p1, const LAS char* Kb, int r32, int hi, const bf16x8* qr) {
    if (ZERO) { p0 = f32x16{}; p1 = f32x16{}; }
    const LAS char* kb[4];
#pragma unroll
    for (int dd = 0; dd < 4; ++dd) kb[dd] = Kb + ATT_KSWZ(r32, (dd * 16 + hi * 8) * 2);
#pragma unroll
    for (int d0 = 0; d0 < 8; ++d0) { const LAS char* a = kb[d0 & 3] + (d0 >> 2) * 128;
        const bf16x8 b0 = *(const LAS bf16x8*)a;
        const bf16x8 b1 = *(const LAS bf16x8*)(a + 32 * 256);
        p0 = __builtin_amdgcn_mfma_f32_32x32x16_bf16(b0, qr[d0], p0, 0, 0, 0);
        p1 = __builtin_amdgcn_mfma_f32_32x32x16_bf16(b1, qr[d0], p1, 0, 0, 0); }
}
__device__ __forceinline__ void pv_tile(f32x16* o, int vb0, bf16x8 pa0, bf16x8 pa1, bf16x8 pa2, bf16x8 pa3) {
#define ATT_TRRD(dst, off) asm volatile("ds_read_b64_tr_b16 %0, %1 offset:%2" : "=&v"(dst) : "v"(vb0), "i"(off) : "memory")
#define ATT_PV_D0(d0) do { s16x4 l0, l1, l2, l3, h0, h1, h2, h3; constexpr int b_ = v_rd_off(d0, 0, 0); \
        ATT_TRRD(l0, b_); ATT_TRRD(h0, b_ + 2048); ATT_TRRD(l1, b_ + 4096); ATT_TRRD(h1, b_ + 6144); ATT_TRRD(l2, b_ + 8192); ATT_TRRD(h2, b_ + 10240); ATT_TRRD(l3, b_ + 12288); ATT_TRRD(h3, b_ + 14336); \
        asm volatile("s_waitcnt lgkmcnt(0)" ::: "memory"); ATT_SBAR();   \
        o[d0] = __builtin_amdgcn_mfma_f32_32x32x16_bf16(pa0, (bf16x8){l0[0], l0[1], l0[2], l0[3], h0[0], h0[1], h0[2], h0[3]}, o[d0], 0, 0, 0);   \
        o[d0] = __builtin_amdgcn_mfma_f32_32x32x16_bf16(pa1, (bf16x8){l1[0], l1[1], l1[2], l1[3], h1[0], h1[1], h1[2], h1[3]}, o[d0], 0, 0, 0);   \
        o[d0] = __builtin_amdgcn_mfma_f32_32x32x16_bf16(pa2, (bf16x8){l2[0], l2[1], l2[2], l2[3], h2[0], h2[1], h2[2], h2[3]}, o[d0], 0, 0, 0);   \
        o[d0] = __builtin_amdgcn_mfma_f32_32x32x16_bf16(pa3, (bf16x8){l3[0], l3[1], l3[2], l3[3], h3[0], h3[1], h3[2], h3[3]}, o[d0], 0, 0, 0); } while (0)
    ATT_PV_D0(0); ATT_PV_D0(1); ATT_PV_D0(2); ATT_PV_D0(3);
#undef ATT_PV_D0
#undef ATT_TRRD
}
}

__device__ __forceinline__ void phase_nsa_mfma(Frame& F, int l) {
    using namespace att;
    const int tid0 = F.tid, wid = F.wave;
    LAS char* V_lds = (LAS char*)F.lds; LAS char* K_lds = V_lds + SHM; LAS char* K2_lds = V_lds + 3 * SHM;
    LAS float* tbl = (LAS float*)(V_lds + 4 * SHM) + wid * 256; LAS float* al_l = tbl; LAS float* sc_l = tbl + 32;
    LAS unsigned* uni = (LAS unsigned*)(V_lds + 4 * SHM + 8192);
    const float NEG = -__builtin_inff();
#pragma unroll 1
    for (int it = F.bid; it < 256; it += F.G) {
        unsigned char* wsl = F.ws; asm volatile("" : "+s"(wsl));
        const float* QFp = (const float*)(wsl + WS_QF); const float* GATp = (const float*)(wsl + WS_GATES); const float* CBPp = (const float*)(wsl + WS_CBP);
        int tid = tid0; asm volatile("" : "+v"(tid));
        const int lane = tid & 63, r32 = lane & 31, hi = lane >> 5;
        const int sr = tid >> 4, sc = (tid & 15) * 8, vst0 = v_st(sr, sc), vst1 = v_st(32 + sr, sc), kws = ATT_KSWZ(sr, sc * 2);
        const int vb0 = (int)(unsigned)(size_t)V_lds + v_rd_base(lane);
        const int xc = it & 7, b = xc >> 1, g = xc & 1, qb = it >> 3;
        const int q0 = qb * 64;
        const int rho = wid * 32 + r32, qi = rho >> 2, hh = rho & 3, trow = b * SEQ + q0 + qi, tq = q0 + qi;
        const unsigned kvoff = (unsigned)((b * NKV + g) * SEQ * HD);
        __syncthreads();
        if (tid == 0) uni[0] = 0u;
        bf16x8 qr[8];
        f32x16 o[4];
        f32x4* ata = (f32x4*)(wsl + WS_ATA) + ((size_t)(it * 8 + wid) * 16) * 64 + lane;
        float m_reg = -1e30f, l_reg = 0.f, mn, alpha;
        f32x16 p0, p1; bf16x8 pa0, pa1, pa2, pa3;
        unsigned selmask;
        {
            bf16x8 ql[8];
            const float* qp = QFp + ((size_t)trow * 8 + g * 4 + hh) * 128 + hi * 8;
#pragma unroll
            for (int d0 = 0; d0 < 8; ++d0) { const f32x4 a = *(const f32x4*)(qp + d0 * 16), c = *(const f32x4*)(qp + d0 * 16 + 4);
                qr[d0] = pack8(a, c); const u32x4 u = __builtin_bit_cast(u32x4, qr[d0]);
                f32x4 ra, rc; ra.x = a.x - __uint_as_float(u.x << 16); ra.y = a.y - __uint_as_float(u.x & 0xffff0000u); ra.z = a.z - __uint_as_float(u.y << 16); ra.w = a.w - __uint_as_float(u.y & 0xffff0000u);
                rc.x = c.x - __uint_as_float(u.z << 16); rc.y = c.y - __uint_as_float(u.z & 0xffff0000u); rc.z = c.z - __uint_as_float(u.w << 16); rc.w = c.w - __uint_as_float(u.w & 0xffff0000u);
                ql[d0] = pack8(ra, rc); }
            { const float* kr = CBPp + ((size_t)(b * 32 + sr) * 2 + g) * 128 + sc; const float* vr = kr + (size_t)256 * 128;
              const f32x4 a = *(const f32x4*)kr, c = *(const f32x4*)(kr + 4); const bf16x8 kh = pack8(a, c); const u32x4 u = __builtin_bit_cast(u32x4, kh);
              f32x4 ra, rc; ra.x = a.x - __uint_as_float(u.x << 16); ra.y = a.y - __uint_as_float(u.x & 0xffff0000u); ra.z = a.z - __uint_as_float(u.y << 16); ra.w = a.w - __uint_as_float(u.y & 0xffff0000u);
              rc.x = c.x - __uint_as_float(u.z << 16); rc.y = c.y - __uint_as_float(u.z & 0xffff0000u); rc.z = c.z - __uint_as_float(u.w << 16); rc.w = c.w - __uint_as_float(u.w & 0xffff0000u);
              unsigned zr; asm volatile("v_mov_b32 %0, 0" : "=v"(zr)); u32x4 z4u; z4u.x = zr; z4u.y = zr; z4u.z = zr; z4u.w = zr;
              const bf16x8 z8 = __builtin_bit_cast(bf16x8, z4u);
              *(LAS bf16x8*)(K_lds + kws) = kh; *(LAS bf16x8*)(K_lds + kws + 32 * 256) = z8;
              *(LAS bf16x8*)(K2_lds + kws) = pack8(ra, rc); *(LAS bf16x8*)(K2_lds + kws + 32 * 256) = z8;
              *(LAS bf16x8*)(V_lds + vst0) = pack8(*(const f32x4*)vr, *(const f32x4*)(vr + 4)); *(LAS bf16x8*)(V_lds + vst1) = z8; }
            __syncthreads();
            qkt<true>(p0, p1, K_lds, r32, hi, qr); qkt<false>(p0, p1, K_lds, r32, hi, ql); qkt<false>(p0, p1, K2_lds, r32, hi, qr);
            const int nvis = (tq + 1) >> 6;
#pragma unroll
            for (int r = 0; r < 16; ++r) { if (crow(r, hi) >= nvis) p0[r] = NEG; p1[r] = NEG; }
            partialSM(p0, p1, m_reg, mn, alpha); finishSM(p0, p1, alpha, l_reg, pa0, pa1, pa2, pa3);
            const int cur = qb;
            if (cur < 16) selmask = (2u << cur) - 1u;
            else {
                const float inv = l_reg > 0.f ? 1.0f / l_reg : 0.f;
                float il[16], ih[16];
#pragma unroll
                for (int r = 0; r < 16; ++r) { float v = p0[r] * inv; v += __shfl_xor(v, 1); v += __shfl_xor(v, 2);
                    const int kj = crow(r, hi); if (kj < 1 || kj > cur - 2) v = -1.f;
                    auto rr = __builtin_amdgcn_permlane32_swap(__float_as_uint(v), __float_as_uint(v), false, false); il[r] = __uint_as_float(rr[0]); ih[r] = __uint_as_float(rr[1]); }
                unsigned part = 0u;
#pragma unroll
                for (int r = 0; r < 16; ++r) { const int kj = crow(r, hi); const float mine = hi ? ih[r] : il[r]; int cnt = 0;
#pragma unroll
                    for (int r2 = 0; r2 < 16; ++r2) { const int j0 = crow(r2, 0), j1 = crow(r2, 1);
                        cnt += (il[r2] > mine || (il[r2] == mine && j0 < kj)) ? 1 : 0; cnt += (ih[r2] > mine || (ih[r2] == mine && j1 < kj)) ? 1 : 0; }
                    const bool sel = (kj == 0) || (kj == cur) || (kj == cur - 1) || (mine >= 0.f && cnt < 13);
                    part |= sel ? (1u << kj) : 0u; }
                auto rr = __builtin_amdgcn_permlane32_swap(part, part, false, false); selmask = rr[0] | rr[1];
            }
            unsigned wu = selmask;
#pragma unroll
            for (int ofs = 1; ofs < 32; ofs <<= 1) wu |= (unsigned)__shfl_xor((int)wu, ofs);
            if (lane == 0) atomicOr((unsigned*)uni, wu);
            asm volatile("" ::: "memory");
#pragma unroll
            for (int d = 0; d < 4; ++d) o[d] = f32x16{};
            pv_tile(o, vb0, pa0, pa1, pa2, pa3);
            if (hi == 0) sc_l[r32] = l_reg > 0.f ? GATp[(size_t)trow * 24 + (g * 4 + hh) * 3 + 0] / l_reg : 0.f;
            asm volatile("s_waitcnt lgkmcnt(0)" ::: "memory");
#pragma unroll
            for (int d = 0; d < 4; ++d)
#pragma unroll
                for (int r4 = 0; r4 < 4; ++r4) { f32x4 v;
#pragma unroll
                    for (int e = 0; e < 4; ++e) { v[e] = o[d][r4 * 4 + e] * sc_l[crow(r4 * 4 + e, hi)]; o[d][r4 * 4 + e] = 0.f; }
                    ata[(d * 4 + r4) * 64] = v; }
            m_reg = -1e30f; l_reg = 0.f;
        }
        __syncthreads();
        const unsigned un = uni[0];
        const unsigned wun = (unsigned)__builtin_amdgcn_readfirstlane((int)({ unsigned w_ = selmask;
#pragma unroll
            for (int ofs = 1; ofs < 32; ofs <<= 1) w_ |= (unsigned)__shfl_xor((int)w_, ofs); w_; }));
#pragma unroll 1
        for (int br = 1; br <= 2; ++br) {
            const bf16* Kp = (const bf16*)(wsl + (br == 1 ? WS_KSB : WS_KWB)) + kvoff; const bf16* Vp = (const bf16*)(wsl + (br == 1 ? WS_VSB : WS_VWB)) + kvoff;
            unsigned tiles = br == 1 ? (un & ((2u << qb) - 1u)) : ((2u << qb) - 1u) & ~((qb >= 9) ? ((1u << (qb - 8)) - 1u) : 0u);
            bf16x8 st_k0, st_k1, st_v0, st_v1;
#define ATT_LOAD(jt) do { const size_t ro = (size_t)((jt) * 64 + sr) * HD + sc; st_k0 = *(const bf16x8*)(Kp + ro); st_k1 = *(const bf16x8*)(Kp + ro + 32 * HD); st_v0 = *(const bf16x8*)(Vp + ro); st_v1 = *(const bf16x8*)(Vp + ro + 32 * HD); } while (0)
#define ATT_WRITE(bo) do { *(LAS bf16x8*)(K_lds + (bo) + kws) = st_k0; *(LAS bf16x8*)(K_lds + (bo) + kws + 32 * 256) = st_k1; *(LAS bf16x8*)(V_lds + (bo) + vst0) = st_v0; *(LAS bf16x8*)(V_lds + (bo) + vst1) = st_v1; } while (0)
            int j = __builtin_ctz(tiles); tiles &= tiles - 1u;
            ATT_LOAD(j);
            __syncthreads();
            ATT_WRITE(0);
            int jn = tiles ? __builtin_ctz(tiles) : -1;
            if (jn >= 0) ATT_LOAD(jn);
            __syncthreads();
            int cur = 0;
#pragma unroll 1
            while (true) {
                const bool act = br == 2 || ((wun >> j) & 1u);
                if (act) {
                    qkt<true>(p0, p1, K_lds + cur, r32, hi, qr);
                    if (br == 1) {
                        if (!((selmask >> j) & 1u)) {
#pragma unroll
                            for (int r = 0; r < 16; ++r) { p0[r] = NEG; p1[r] = NEG; } }
                        if (j == qb) {
#pragma unroll
                            for (int r = 0; r < 16; ++r) { if (crow(r, hi) > qi) p0[r] = NEG; if (crow(r, hi) + 32 > qi) p1[r] = NEG; } }
                    } else if (j == qb || j == qb - 8) {
                        const int dq = tq - j * 64;
#pragma unroll
                        for (int r = 0; r < 16; ++r) { if ((unsigned)(dq - crow(r, hi)) > 512u) p0[r] = NEG; if ((unsigned)(dq - crow(r, hi) - 32) > 512u) p1[r] = NEG; }
                    }
                    partialSM(p0, p1, m_reg, mn, alpha); finishSM(p0, p1, alpha, l_reg, pa0, pa1, pa2, pa3);
                    if (__any(alpha < 1.f)) { if (hi == 0) al_l[r32] = alpha; asm volatile("s_waitcnt lgkmcnt(0)" ::: "memory");
#pragma unroll
                        for (int d = 0; d < 4; ++d)
#pragma unroll
                            for (int r = 0; r < 16; ++r) o[d][r] *= al_l[crow(r, hi)]; }
                    pv_tile(o, vb0 + cur, pa0, pa1, pa2, pa3);
                }
                if (jn < 0) break;
                ATT_WRITE(cur ^ 32768);
                j = jn; tiles &= tiles - 1u; jn = tiles ? __builtin_ctz(tiles) : -1;
                if (jn >= 0) ATT_LOAD(jn);
                __syncthreads();
                cur ^= 32768;
            }
#undef ATT_LOAD
#undef ATT_WRITE
            if (hi == 0) sc_l[r32] = l_reg > 0.f ? GATp[(size_t)trow * 24 + (g * 4 + hh) * 3 + br] / l_reg : 0.f;
            asm volatile("s_waitcnt lgkmcnt(0)" ::: "memory");
#pragma unroll
            for (int d = 0; d < 4; ++d)
#pragma unroll
                for (int r4 = 0; r4 < 4; ++r4) { f32x4 v = ata[(d * 4 + r4) * 64];
#pragma unroll
                    for (int e = 0; e < 4; ++e) { v[e] += o[d][r4 * 4 + e] * sc_l[crow(r4 * 4 + e, hi)]; o[d][r4 * 4 + e] = v[e]; }
                    if (br == 1) { ata[(d * 4 + r4) * 64] = v;
#pragma unroll
                        for (int e = 0; e < 4; ++e) o[d][r4 * 4 + e] = 0.f; } }
            m_reg = -1e30f; l_reg = 0.f;
        }
        bf16* OM = (bf16*)(wsl + WS_OMIX);
#pragma unroll
        for (int r = 0; r < 16; ++r) { const int rw = wid * 32 + crow(r, hi); bf16* op = OM + (size_t)(b * SEQ + q0 + (rw >> 2)) * DM + (g * 4 + (rw & 3)) * 128;
#pragma unroll
            for (int d = 0; d < 4; ++d) { const float v = o[d][r]; const float vn = __shfl_xor(v, 1);
                if ((r32 & 1) == 0) *(unsigned*)(op + d * 32 + r32) = pg8::cvt_pk_bf16(v, vn); } }
    }
    __syncthreads();
}

__device__ __forceinline__ void phase_resid(Frame& F, int l, int which  ) {
    const int lane = F.lane, gw = F.bid * NWAVES + F.wave, NGW = F.G * NWAVES;
    const float* gpost = (which == 0 ? ((const float*)F.in[22]) : ((const float*)F.in[27])) + l * DM;
    for (int r = gw; r < MT; r += NGW) {
        const float* md = ((float*)(F.ws + WS_MOD)) + ((size_t)l * 12 + modrow(r)) * 12288;
        const float* ga = md + (which == 0 ? 4096 : 10240);
        const f32x4* xr = (const f32x4*)((which == 0) ? xrow_in(F, l, r) : ((float*)(F.ws + WS_X)) + (size_t)r * DM) + lane;
        const u32x2* mr = (const u32x2*)(((const bf16*)(F.ws + WS_MIX)) + (size_t)r * DM) + lane;
        f32x4 v[8], m[8]; float ss = 0.f;
#pragma unroll
        for (int j = 0; j < 8; ++j) { v[j] = xr[64 * j]; const u32x2 mb = mr[64 * j]; m[j] = (f32x4){__uint_as_float(mb.x << 16), __uint_as_float(mb.x & 0xffff0000u), __uint_as_float(mb.y << 16), __uint_as_float(mb.y & 0xffff0000u)}; ss += (m[j].x * m[j].x + m[j].y * m[j].y) + (m[j].z * m[j].z + m[j].w * m[j].w); }
        ss = wave_sum(ss);
        const float rs = 1.0f / sqrtf(ss * (1.0f / DM) + EPS);
#pragma unroll
        for (int j = 0; j < 8; ++j) { const int c = (lane + 64 * j) * 4; v[j] = v[j] + *(const f32x4*)(ga + c) * (m[j] * rs * *(const f32x4*)(gpost + c)); }
        if (which == 1 && l == NL - 1) {
            f32x4* o = (f32x4*)(r < MP ? F.out + O_YP + (size_t)r * DM : F.out + O_YS + (size_t)(r - MP) * DM) + lane;
#pragma unroll
            for (int j = 0; j < 8; ++j) o[64 * j] = v[j];
        } else {
            f32x4* xo = (f32x4*)(((float*)(F.ws + WS_X)) + (size_t)r * DM) + lane;
#pragma unroll
            for (int j = 0; j < 8; ++j) xo[64 * j] = v[j];
            if (which == 0) norm_mod_store(v, ((const float*)F.in[23]) + l * DM, md + 6144, md + 8192, ((bf16*)(F.ws + WS_H)) + (size_t)r * DM, lane);
            else { const float* md2 = ((float*)(F.ws + WS_MOD)) + ((size_t)(l + 1) * 12 + modrow(r)) * 12288; norm_mod_store(v, ((const float*)F.in[12]) + (l + 1) * DM, md2, md2 + 2048, ((bf16*)(F.ws + WS_H)) + (size_t)r * DM, lane); }
        }
    }
}

constexpr int PH_LAYER0 = 3, PH_PER_LAYER = 10, NPHASE = PH_LAYER0 + NL * PH_PER_LAYER;
#ifndef PHMASK
#define PHMASK 0xFFFFFFFFu
#endif
#define EN(b) (((PHMASK) >> (b)) & 1u)
#ifndef REP_MASK
#define REP_MASK 0u
#endif
#ifndef REP_N
#define REP_N 3
#endif
#define REPS(b, on) (((((REP_MASK) >> (b)) & 1u) && (on)) ? 1 + (REP_N) : 1)
#define IN(k) (lo <= (k) && (k) < hi)
#define SEAM(k) do { if (IN(k) && IN((k) + 1)) xcd_barrier(bar); } while (0)
template <int l>
__device__ __forceinline__ void layer_phases(Frame& F, const int lo, const int hi, const XcdBarrier& bar) {

        const int p0 = PH_LAYER0 + l * PH_PER_LAYER;
        if (EN(3) && IN(p0 + 0)) for (int rep = 0; rep < REPS(3, l == 0); ++rep, ((REP_MASK) ? __syncthreads() : (void)0)) {
            if constexpr (l == 0) { if (F.bid & 1) phase_cmp_direct(F); }
            pg8::Gemm g{((bf16*)(F.ws + WS_H)), ((bf16*)(F.ws + WS_WIN)) + (size_t)l * NIN * DM, DM, DM}; pg8::StaticOrder S; S.init(MP, NIN, F.G, F.bid); pg8::EpiF32 E{((float*)(F.ws + WS_PROJ)), NIN};
            pg8::gemm_phase<pg8::EpiF32, pg8::StaticOrder, true, true>(F.lds, g, S, E);
            if (F.bid >= 96)
                skinny_wave<0, 64>(F, ((bf16*)(F.ws + WS_H)) + (size_t)MP * DM, DM, ((bf16*)(F.ws + WS_WIN)) + (size_t)l * NIN * DM, DM, NIN / 16, ((float*)(F.ws + WS_PROJ)), nullptr, NIN, (F.bid - 96) * NWAVES + F.wave, 160 * NWAVES);
            __syncthreads();
            if (l == 0) { if (F.bid >= 224) tr_range(F, TR_I_L + TR_I_IN, TR_I_OUT, (F.bid - 224) * NWAVES + F.wave, 32 * NWAVES);
                          else if (F.bid >= 96) tr_range(F, TR_I_L, TR_I_IN, (F.bid - 96) * NWAVES + F.wave, 128 * NWAVES); }
            else { if (F.bid >= 96) tr_range(F, TR_I_L + TR_I_IN + TR_I_OUT + TR_I_GU, TR_I_DN, (F.bid - 96) * NWAVES + F.wave, 160 * NWAVES); }
            if constexpr (l == 0) { if (!(F.bid & 1)) phase_cmp_direct(F); }
        }
        SEAM(p0 + 0);
        if (EN(4) && IN(p0 + 1)) for (int rep = 0; rep < REPS(4, l == 0); ++rep, ((REP_MASK) ? __syncthreads() : (void)0)) { phase_postproj(F, l); }
        SEAM(p0 + 1);
        if (EN(5) && IN(p0 + 2)) for (int rep = 0; rep < REPS(5, l == 0); ++rep, ((REP_MASK) ? __syncthreads() : (void)0)) {
            pg8::Gemm g{((bf16*)(F.ws + WS_AP)), ((bf16*)(F.ws + WS_W1)) + (size_t)l * 2 * 256 * 8192, 256, 8192}; pg8::SplitOrder S{64, F.G, F.bid, 32, 1}; pg8::EpiPart E{((float*)(F.ws + WS_HIDP)), (size_t)512 * 256};
            pg8::gemm_phase<pg8::EpiPart, pg8::SplitOrder, true, true>(F.lds, g, S, E);
#ifndef NO_SCAN
            phase_gdn_scan_naive(F, l);
#endif
            phase_gdn_pre(F, l);
        }
        SEAM(p0 + 2);
        if (EN(6) && IN(p0 + 3)) for (int rep = 0; rep < REPS(6, l == 0); ++rep, ((REP_MASK) ? __syncthreads() : (void)0)) { cmp_finish<32>(F, ((float*)(F.ws + WS_HIDP)), (size_t)512 * 256, 512, 256, ((const float*)F.in[16]) + (size_t)l * 2 * 32768, ((float*)(F.ws + WS_CBP)), 64);
            cmp_finish16<4>(F, ((float*)(F.ws + WS_HIDS)), (size_t)16384 * 256, 8192, 4096, ((const float*)F.in[16]), ((float*)(F.ws + WS_CBS)), 64, l * 8192, ((const float*)(F.ws + WS_PEC)));
            phase_gdn_scan(F, l); }
        SEAM(p0 + 3);
        if (EN(7) && IN(p0 + 4)) for (int rep = 0; rep < REPS(7, l == 0); ++rep, ((REP_MASK) ? __syncthreads() : (void)0)) { phase_nsa_mfma(F, l); phase_nsa_sample(F, l); phase_gdn_out(F, l); }
        SEAM(p0 + 4);
        if (EN(8) && IN(p0 + 5)) for (int rep = 0; rep < REPS(8, l == 0); ++rep, ((REP_MASK) ? __syncthreads() : (void)0)) {
            pg8::Gemm g{((bf16*)(F.ws + WS_OMIX)), ((bf16*)(F.ws + WS_WOUT)) + (size_t)l * DM * DM, DM, DM}; pg8::StaticOrder S; S.init(MP, DM, F.G, F.bid); pg8::EpiBf16 E{((bf16*)(F.ws + WS_MIX)), DM};
            pg8::gemm_phase<pg8::EpiBf16, pg8::StaticOrder, true, true>(F.lds, g, S, E);
            skinny_gemm<2, 8>(F, ((bf16*)(F.ws + WS_OMIX)) + (size_t)MP * DM, DM, ((bf16*)(F.ws + WS_WOUT)) + (size_t)l * DM * DM, DM, DM / 16, nullptr, ((bf16*)(F.ws + WS_MIX)), DM);
        }
        SEAM(p0 + 5);
        if (EN(9) && IN(p0 + 6)) for (int rep = 0; rep < REPS(9, l == 0); ++rep, ((REP_MASK) ? __syncthreads() : (void)0)) { phase_resid(F, l, 0); }
        SEAM(p0 + 6);
        if (EN(10) && IN(p0 + 7)) for (int rep = 0; rep < REPS(10, l == 0); ++rep, ((REP_MASK) ? __syncthreads() : (void)0)) {
            pg8::Gemm g{((bf16*)(F.ws + WS_H)), ((bf16*)(F.ws + WS_WGU)) + (size_t)l * NGU * DM, DM, DM}; pg8::StaticOrder S; S.init(MP, NGU, F.G, F.bid); pg8::EpiSwiGLU E{((bf16*)(F.ws + WS_ACT)), DFF};
            pg8::gemm_phase<pg8::EpiSwiGLU, pg8::StaticOrder, true, true>(F.lds, g, S, E);
            if (F.bid >= 128)
                skinny_wave<1, 64>(F, ((bf16*)(F.ws + WS_H)) + (size_t)MP * DM, DM, ((bf16*)(F.ws + WS_WGU)) + (size_t)l * NGU * DM, DM, DFF / 16, nullptr, ((bf16*)(F.ws + WS_ACT)), DFF, (F.bid - 128) * NWAVES + F.wave, 128 * NWAVES);
            __syncthreads();
            if (l == 0 && F.bid >= 128) tr_range(F, TR_I_L + TR_I_IN + TR_I_OUT, TR_I_GU, (F.bid - 128) * NWAVES + F.wave, 128 * NWAVES);
        }
        SEAM(p0 + 7);
        if (EN(11) && IN(p0 + 8)) for (int rep = 0; rep < REPS(11, l == 0); ++rep, ((REP_MASK) ? __syncthreads() : (void)0)) {
            pg8::Gemm g{((bf16*)(F.ws + WS_ACT)), ((bf16*)(F.ws + WS_WDN)) + (size_t)l * DM * DFF, DFF, DFF}; pg8::StaticOrder S; S.init(MP, DM, F.G, F.bid); pg8::EpiBf16 E{((bf16*)(F.ws + WS_MIX)), DM};
            pg8::gemm_phase<pg8::EpiBf16, pg8::StaticOrder, true, true>(F.lds, g, S, E);
            skinny_gemm<2, 22>(F, ((bf16*)(F.ws + WS_ACT)) + (size_t)MP * DFF, DFF, ((bf16*)(F.ws + WS_WDN)) + (size_t)l * DM * DFF, DFF, DM / 16, nullptr, ((bf16*)(F.ws + WS_MIX)), DM);
        }
        SEAM(p0 + 8);
        if (EN(12) && IN(p0 + 9)) for (int rep = 0; rep < REPS(12, l == 0); ++rep, ((REP_MASK) ? __syncthreads() : (void)0)) { phase_resid(F, l, 1); }
        SEAM(p0 + 9);
    }

__global__ void __launch_bounds__(NTHR, 2) mega(Args args) {
    extern __shared__ __attribute__((aligned(16))) unsigned char lds_raw[];
    Frame F;
    F.lds = (LAS unsigned char*)lds_raw;
    F.tid = threadIdx.x; F.lane = F.tid & 63; F.wave = __builtin_amdgcn_readfirstlane(F.tid >> 6); F.G = gridDim.x; F.bid = blockIdx.x;
    F.in = args.in; F.out = args.out; F.ws = args.ws;
    unsigned char* ws = args.ws;
    volatile LAS unsigned* MISC = (volatile LAS unsigned*)(F.lds + MISC_OFF);
    if (F.tid < 16) MISC[F.tid] = 0u;
    __syncthreads();
    const int lo = args.ph_lo, hi = args.ph_hi;
    unsigned* barw = (unsigned*)(ws + WS_CTL) + CW_BAR;
    XcdBarrier bar; bar.bar = barw; bar.x = 0; bar.st = MISC + 8;
    if (hi - lo > 1) bar = xcd_barrier_post(barw, MISC + 8);

    if (EN(0) && IN(0)) for (int rep = 0; rep < REPS(0, true); ++rep, ((REP_MASK) ? __syncthreads() : (void)0)) { phase_prologue(F); }
    SEAM(0);
    if (EN(1) && IN(1)) for (int rep = 0; rep < REPS(1, true); ++rep, ((REP_MASK) ? __syncthreads() : (void)0)) {
        ada_reduce(F);
    }
    SEAM(1);
    if (EN(2) && IN(2)) for (int rep = 0; rep < REPS(2, true); ++rep, ((REP_MASK) ? __syncthreads() : (void)0)) { phase_norm1(F, 0); pe_w1(F); }
    SEAM(2);
    layer_phases<0>(F, lo, hi, bar);
    layer_phases<1>(F, lo, hi, bar);
#undef IN
#undef SEAM
}

extern "C" void kernel_launch(void* const* d_in, const int* in_sizes, int n_in, void* d_out, int out_size, void* d_ws, size_t ws_size, hipStream_t stream) {
    static int grid = 0;
    if (grid == 0) {
        if (n_in != 28 || (size_t)out_size != O_END || ws_size < WS_END) { fprintf(stderr, "kernel_launch: unexpected shapes: n_in %d out %d (want %zu) ws %zu (want %zu)\n", n_in, out_size, (size_t)O_END, ws_size, (size_t)WS_END); grid = -1; return; }
        int dev = 0, cus = 0, per_cu = 0;
        if (hipGetDevice(&dev) != hipSuccess || hipDeviceGetAttribute(&cus, hipDeviceAttributeMultiprocessorCount, dev) != hipSuccess) { grid = -1; return; }
        if (hipFuncSetAttribute((const void*)mega, hipFuncAttributeMaxDynamicSharedMemorySize, LDS_BYTES) != hipSuccess) { fprintf(stderr, "kernel_launch: hipFuncSetAttribute failed\n"); grid = -1; return; }
        if (hipOccupancyMaxActiveBlocksPerMultiprocessor(&per_cu, (const void*)mega, NTHR, LDS_BYTES) != hipSuccess || per_cu < 1) fprintf(stderr, "kernel_launch: occupancy query reports %d\n", per_cu);
        (void)hipGetLastError();
        grid = cus;
    }
    if (grid < 0) return;
    if (hipMemsetAsync((char*)d_ws + WS_CTL, 0, CTL_BYTES, stream) != hipSuccess) return;
    Args a{};
    for (int i = 0; i < 28; ++i) a.in[i] = d_in[i];
    a.out = (float*)d_out; a.ws = (unsigned char*)d_ws;
#if ONE_LAUNCH
    a.ph_lo = 0; a.ph_hi = NPHASE;
    hipLaunchKernelGGL(mega, dim3(grid), dim3(NTHR), LDS_BYTES, stream, a);
#else
    for (int p = 0; p < NPHASE; ++p) { a.ph_lo = p; a.ph_hi = p + 1; hipLaunchKernelGGL(mega, dim3(grid), dim3(NTHR), LDS_BYTES, stream, a); }
#endif
}
```

```cpp
#include <hip/hip_runtime.h>
#include <cstdio>
#include <cstdint>

#ifndef ONE_LAUNCH
#define ONE_LAUNCH 1
#endif

#define LAS __attribute__((address_space(3)))
typedef unsigned short bf16;
typedef unsigned u32x4 __attribute__((ext_vector_type(4)));
typedef unsigned u32x2 __attribute__((ext_vector_type(2)));
typedef float f32x4 __attribute__((ext_vector_type(4)));
typedef float f32x2 __attribute__((ext_vector_type(2)));
typedef short bf16x8 __attribute__((ext_vector_type(8)));

namespace pg8 {
#define PG8_LAS __attribute__((address_space(3)))
typedef unsigned short bf16_t;
constexpr int BM = 256, BK = 64, HALF = 128, HTB = HALF * BK * 2  , STAGE_BYTES = 8 * HTB, NXCD = 8, WGM = 8;

__host__ __device__ __forceinline__ int lds_byte(int r, int c) { const int st = (r >> 4) * 2 + (c >> 5), rr = r & 15, cc = c & 31, ob = rr * 64 + cc * 2; return st * 1024 + (ob ^ (((ob >> 9) & 1) << 5)); }
__host__ __device__ __forceinline__ void stage_rc(int b, int& R, int& C) { const int st = b / 1024, sb = b % 1024, swz = sb ^ (((sb >> 9) & 1) << 5); R = (st >> 1) * 16 + swz / 64; C = (st & 1) * 32 + (swz % 64) / 2; }
__host__ __device__ __forceinline__ int perm32(int rho) { const int n = rho >> 4, i = rho & 15; return 8 * (i >> 2) + 4 * n + (i & 3); }

struct Unit { int pm, pn, pk; };
struct Gemm { const bf16_t* A; const bf16_t* Bt; int K; int ld; };

struct StaticOrder {
    int nM, nN, nwg, G, c;
    __host__ __device__ void init(int M, int N, int G_, int c_) { nM = M / BM; nN = N / BM; nwg = nM * nN; G = G_; c = c_; }
    __host__ __device__ bool next(int i, Unit& u) const {
        const long L = (long)i * G + c; if (L >= nwg) return false;
        int wgid = (int)L; { const int q = nwg / NXCD, r = nwg % NXCD, xcd = wgid % NXCD, off = wgid / NXCD; wgid = (xcd < r ? xcd * (q + 1) : r * (q + 1) + (xcd - r) * q) + off; }
        const int nig = WGM * nN, gid = wgid / nig, fm = gid * WGM, gsz = (nM - fm) < WGM ? (nM - fm) : WGM;
        u.pm = fm + ((wgid % nig) % gsz); u.pn = (wgid % nig) / gsz; u.pk = 0; return true;
    }
    __device__ __forceinline__ void a_ready(const Unit&) const {}
    __device__ __forceinline__ void done(const Unit&) const {}
};
struct OneUnit {
    int L, nsplit, pn_div;
    __host__ __device__ bool next(int i, Unit& u) const { if (i != 0 || L < 0) return false; u.pk = L % nsplit; u.pm = L / nsplit; u.pn = u.pm / pn_div; return true; }
    __device__ __forceinline__ void a_ready(const Unit&) const {}
    __device__ __forceinline__ void done(const Unit&) const {}
};
struct SplitOrder {
    int nU, G, c, nsplit, pn_div;
    __host__ __device__ bool next(int i, Unit& u) const {
        const long L = (long)i * G + c; if (L >= nU) return false;
        u.pk = (int)(L % nsplit); u.pm = (int)(L / nsplit); u.pn = u.pm / pn_div; return true;
    }
    __device__ __forceinline__ void a_ready(const Unit&) const {}
    __device__ __forceinline__ void done(const Unit&) const {}
};

typedef __bf16 bf16x2_v __attribute__((ext_vector_type(2)));
__device__ __forceinline__ unsigned cvt_pk_bf16(float lo, float hi) { const f32x2 v = {lo, hi}; return __builtin_bit_cast(unsigned, __builtin_convertvector(v, bf16x2_v)); }

struct EpiF32 {
    static constexpr bool PERM = false, AFTER_DRAIN = false;
    float* C; int ldc;
    __device__ __forceinline__ void operator()(const f32x4 (&acc)[2][2][4][2], const Unit& u, int wr, int wc, int fr, int fq) const {
        const int row0 = u.pm * BM + wr * 64 + fr, col0 = u.pn * BM + wc * 32 + 4 * fq;
#pragma unroll
        for (int ai = 0; ai < 2; ++ai)
#pragma unroll
            for (int m = 0; m < 4; ++m) { float* rowp = C + (size_t)(row0 + ai * HALF + m * 16) * ldc + col0;
#pragma unroll
                for (int bj = 0; bj < 2; ++bj)
#pragma unroll
                    for (int n = 0; n < 2; ++n) *(f32x4*)(rowp + bj * HALF + n * 16) = acc[ai][bj][m][n]; }
    }
    __device__ __forceinline__ void fused(f32x4 (&)[2][2][4][2], const Unit&, int, int, int, int, PG8_LAS unsigned char*, int, int) const {}
};
struct EpiBf16 {
    static constexpr bool PERM = true, AFTER_DRAIN = false;
    bf16_t* O; int ldc;
    __device__ __forceinline__ void operator()(const f32x4 (&acc)[2][2][4][2], const Unit& u, int wr, int wc, int fr, int fq) const {
        const int row0 = u.pm * BM + wr * 64 + fr, col0 = u.pn * BM + wc * 32 + 8 * fq;
#pragma unroll
        for (int ai = 0; ai < 2; ++ai)
#pragma unroll
            for (int m = 0; m < 4; ++m) { bf16_t* rowp = O + (size_t)(row0 + ai * HALF + m * 16) * ldc + col0;
#pragma unroll
                for (int bj = 0; bj < 2; ++bj) { const f32x4 v0 = acc[ai][bj][m][0], v1 = acc[ai][bj][m][1];
                    u32x4 w; w.x = cvt_pk_bf16(v0[0], v0[1]); w.y = cvt_pk_bf16(v0[2], v0[3]); w.z = cvt_pk_bf16(v1[0], v1[1]); w.w = cvt_pk_bf16(v1[2], v1[3]);
                    *(u32x4*)(rowp + bj * HALF) = w; } }
    }
    __device__ __forceinline__ void fused(f32x4 (&)[2][2][4][2], const Unit&, int, int, int, int, PG8_LAS unsigned char*, int, int) const {}
};
struct EpiPart {
    static constexpr bool PERM = false, AFTER_DRAIN = false;
    float* C; size_t slab;
    __device__ __forceinline__ void operator()(const f32x4 (&acc)[2][2][4][2], const Unit& u, int wr, int wc, int fr, int fq) const {
        const int row0 = u.pm * BM + wr * 64 + fr, col0 = wc * 32 + 4 * fq;
        float* base = C + (size_t)u.pk * slab;
#pragma unroll
        for (int ai = 0; ai < 2; ++ai)
#pragma unroll
            for (int m = 0; m < 4; ++m) { float* rowp = base + (size_t)(row0 + ai * HALF + m * 16) * 256 + col0;
#pragma unroll
                for (int bj = 0; bj < 2; ++bj)
#pragma unroll
                    for (int n = 0; n < 2; ++n) *(f32x4*)(rowp + bj * HALF + n * 16) = acc[ai][bj][m][n]; }
    }
    __device__ __forceinline__ void fused(f32x4 (&)[2][2][4][2], const Unit&, int, int, int, int, PG8_LAS unsigned char*, int, int) const {}
};
struct EpiSwiGLU {
    static constexpr bool PERM = true, AFTER_DRAIN = false;
    bf16_t* O; int ldc;
    __device__ __forceinline__ void operator()(const f32x4 (&acc)[2][2][4][2], const Unit& u, int wr, int wc, int fr, int fq) const {
        const int row0 = u.pm * BM + wr * 64 + fr, col0 = u.pn * HALF + wc * 32 + 8 * fq;
#pragma unroll
        for (int ai = 0; ai < 2; ++ai)
#pragma unroll
            for (int m = 0; m < 4; ++m) { bf16_t* rowp = O + (size_t)(row0 + ai * HALF + m * 16) * ldc + col0;
                float o[8];
#pragma unroll
                for (int n = 0; n < 2; ++n)
#pragma unroll
                    for (int j = 0; j < 4; ++j) { const float g = acc[ai][0][m][n][j], up = acc[ai][1][m][n][j]; o[n * 4 + j] = g / (1.0f + __expf(-g)) * up; }
                u32x4 w; w.x = cvt_pk_bf16(o[0], o[1]); w.y = cvt_pk_bf16(o[2], o[3]); w.z = cvt_pk_bf16(o[4], o[5]); w.w = cvt_pk_bf16(o[6], o[7]);
                *(u32x4*)rowp = w; }
    }
    __device__ __forceinline__ void fused(f32x4 (&)[2][2][4][2], const Unit&, int, int, int, int, PG8_LAS unsigned char*, int, int) const {}
};

template <class Epi, class Sched, bool ALIGN_EPI = false, bool SP2 = false>
__device__ __forceinline__ void gemm_phase(PG8_LAS unsigned char* lds, const Gemm g, const Sched& S, const Epi& E) {
    const int tid = threadIdx.x, wid = __builtin_amdgcn_readfirstlane(tid >> 6), lane = tid & 63, wr = wid >> 2, wc = wid & 3, fr = lane & 15, fq = lane >> 4;
    int K = g.K, ld = g.ld; asm volatile("" : "+s"(K), "+s"(ld));
    const int nt = K / BK;
    unsigned voffA[2], voffB[2];
#pragma unroll
    for (int i = 0; i < 2; ++i) { int R, C; stage_rc(tid * 16 + i * 8192, R, C); const int Rb = Epi::PERM ? ((R & ~31) + perm32(R & 31)) : R;
        voffA[i] = (unsigned)(R * ld + C) * 2u; voffB[i] = (unsigned)(Rb * ld + C) * 2u; }
    const size_t kstep = (size_t)(BK * 2);
    const size_t hstep = (size_t)HALF * ld * 2;
    const size_t tstep = 2 * hstep;
    const size_t sstep = (size_t)K * 2;
    const unsigned ldsw = (unsigned)wid * 1024u;
    const int aoff = lds_byte(wr * 64 + fr, fq * 8), boff = lds_byte(wc * 32 + fr, fq * 8);
#define PG8_SA(b, h) (((b) * 2 + (h)) * HTB)
#define PG8_SB(b, h) ((4 + (b) * 2 + (h)) * HTB)
#define PG8_STAGE(bufoff, gbase, voff) do { _Pragma("unroll") for (int _i = 0; _i < 2; ++_i) \
        __builtin_amdgcn_global_load_lds((const unsigned*)((const char*)(gbase) + (voff)[_i]), (PG8_LAS unsigned*)(lds + (bufoff) + ldsw + _i * 8192), 16, 0, 0); } while (0)
#define PG8_LDA(dst, b, h) do { _Pragma("unroll") for (int m = 0; m < 4; ++m) _Pragma("unroll") for (int k = 0; k < 2; ++k) dst[m][k] = *(const PG8_LAS bf16x8*)(lds + PG8_SA(b, h) + aoff + m * 2048 + k * 1024); } while (0)
#define PG8_LDB(dst, b, h) do { _Pragma("unroll") for (int n = 0; n < 2; ++n) _Pragma("unroll") for (int k = 0; k < 2; ++k) dst[n][k] = *(const PG8_LAS bf16x8*)(lds + PG8_SB(b, h) + boff + n * 2048 + k * 1024); } while (0)
#define PG8_MMA(ai, bj, At, Bt) do { __builtin_amdgcn_s_setprio(1); _Pragma("unroll") for (int m = 0; m < 4; ++m) _Pragma("unroll") for (int n = 0; n < 2; ++n) _Pragma("unroll") for (int k = 0; k < 2; ++k) \
        acc[ai][bj][m][n] = __builtin_amdgcn_mfma_f32_16x16x32_bf16(Bt[n][k], At[m][k], acc[ai][bj][m][n], 0, 0, 0); __builtin_amdgcn_s_setprio(0); } while (0)
#define PG8_WAIT_V(n) asm volatile("s_waitcnt vmcnt(" #n ")" ::: "memory")
#define PG8_WAIT_L(n) asm volatile("s_waitcnt lgkmcnt(" #n ")" ::: "memory")
#define PG8_BAR __builtin_amdgcn_s_barrier()
#define PG8_SCHED __builtin_amdgcn_sched_barrier(0)
    Unit cur, nxt; int ui = 0;
    if (!S.next(0, cur)) return;
    f32x4 acc[2][2][4][2];
#pragma unroll
    for (int a = 0; a < 2; ++a)
#pragma unroll
        for (int b = 0; b < 2; ++b)
#pragma unroll
            for (int m = 0; m < 4; ++m)
#pragma unroll
                for (int n = 0; n < 2; ++n) acc[a][b][m][n] = (f32x4){0.f, 0.f, 0.f, 0.f};
    bf16x8 At[4][2], B0[2][2], B1[2][2];
    const char* cA = (const char*)g.A + (size_t)cur.pm * tstep + (size_t)cur.pk * sstep; const char* cB = (const char*)g.Bt + (size_t)cur.pn * tstep + (size_t)cur.pk * sstep;
    S.a_ready(cur);
    if constexpr (SP2) {
        PG8_STAGE(PG8_SB(0, 0), cB, voffB); PG8_STAGE(PG8_SB(0, 1), cB + hstep, voffB); PG8_STAGE(PG8_SA(0, 0), cA, voffA); PG8_STAGE(PG8_SA(0, 1), cA + hstep, voffA);
        if (wr == 1) PG8_BAR;
        PG8_WAIT_V(2); PG8_BAR;
        PG8_STAGE(PG8_SB(1, 0), cB + kstep, voffB); PG8_STAGE(PG8_SA(1, 0), cA + kstep, voffA); PG8_STAGE(PG8_SB(1, 1), cB + hstep + kstep, voffB);
        PG8_WAIT_V(6); PG8_BAR;
    } else {
        PG8_STAGE(PG8_SB(0, 0), cB, voffB); PG8_STAGE(PG8_SA(0, 0), cA, voffA); PG8_STAGE(PG8_SB(0, 1), cB + hstep, voffB); PG8_STAGE(PG8_SA(0, 1), cA + hstep, voffA);
        if (wr == 1) PG8_BAR;
        PG8_WAIT_V(4); PG8_BAR;
        PG8_STAGE(PG8_SB(1, 0), cB + kstep, voffB); PG8_STAGE(PG8_SA(1, 0), cA + kstep, voffA); PG8_STAGE(PG8_SB(1, 1), cB + hstep + kstep, voffB);
        PG8_WAIT_V(6); PG8_BAR;
    }
    for (;;) {
        const bool has_next = S.next(ui + 1, nxt);
        const char* nA = has_next ? (const char*)g.A + (size_t)nxt.pm * tstep + (size_t)nxt.pk * sstep : cA; const char* nB = has_next ? (const char*)g.Bt + (size_t)nxt.pn * tstep + (size_t)nxt.pk * sstep : cB;
        for (int t = 0; t < nt; t += 2) {
            const bool last = (t == nt - 2);
            const char* a1 = cA + (size_t)(t + 1) * kstep;
            const char* a2 = last ? nA : cA + (size_t)(t + 2) * kstep; const char* b2 = last ? nB : cB + (size_t)(t + 2) * kstep;
            const char* a3 = a2 + kstep; const char* b3 = b2 + kstep;
            if (last && has_next) S.a_ready(nxt);
            if constexpr (SP2) {
            PG8_LDB(B0, 0, 0); PG8_LDB(B1, 0, 1); PG8_SCHED; PG8_LDA(At, 0, 0); PG8_STAGE(PG8_SA(1, 1), a1 + hstep, voffA);
            PG8_WAIT_V(8); PG8_WAIT_L(0); PG8_BAR; PG8_MMA(0, 0, At, B0); PG8_MMA(0, 1, At, B1); PG8_BAR; PG8_SCHED;
            PG8_LDA(At, 0, 1); PG8_STAGE(PG8_SB(0, 0), b2, voffB); PG8_STAGE(PG8_SB(0, 1), b2 + hstep, voffB); PG8_STAGE(PG8_SA(0, 0), a2, voffA);
            PG8_WAIT_V(8); PG8_WAIT_L(0); PG8_BAR; PG8_MMA(1, 0, At, B0); PG8_MMA(1, 1, At, B1); PG8_BAR; PG8_SCHED;
            PG8_LDB(B0, 1, 0); PG8_LDB(B1, 1, 1); PG8_SCHED; PG8_LDA(At, 1, 0); PG8_STAGE(PG8_SA(0, 1), a2 + hstep, voffA);
            PG8_WAIT_V(8); PG8_WAIT_L(0); PG8_BAR; PG8_MMA(0, 0, At, B0); PG8_MMA(0, 1, At, B1); PG8_BAR; PG8_SCHED;
            PG8_LDA(At, 1, 1); PG8_STAGE(PG8_SB(1, 0), b3, voffB); PG8_STAGE(PG8_SB(1, 1), b3 + hstep, voffB); PG8_STAGE(PG8_SA(1, 0), a3, voffA);
            PG8_WAIT_V(8); PG8_WAIT_L(0); PG8_BAR; PG8_MMA(1, 0, At, B0); PG8_MMA(1, 1, At, B1); PG8_BAR; PG8_SCHED;
            } else {
            PG8_LDB(B0, 0, 0); PG8_SCHED; PG8_LDA(At, 0, 0); PG8_STAGE(PG8_SA(1, 1), a1 + hstep, voffA);
            PG8_WAIT_L(8); PG8_BAR; PG8_WAIT_L(0); PG8_MMA(0, 0, At, B0); PG8_BAR; PG8_SCHED;
            PG8_LDB(B1, 0, 1); PG8_STAGE(PG8_SB(0, 0), b2, voffB);
            PG8_BAR; PG8_WAIT_L(0); PG8_MMA(0, 1, At, B1); PG8_BAR;
            PG8_LDA(At, 0, 1); PG8_STAGE(PG8_SA(0, 0), a2, voffA);
            PG8_BAR; PG8_WAIT_L(0); PG8_MMA(1, 0, At, B0); PG8_BAR; PG8_SCHED;
            PG8_STAGE(PG8_SB(0, 1), b2 + hstep, voffB);
            PG8_WAIT_V(6); PG8_BAR; PG8_MMA(1, 1, At, B1); PG8_BAR;
            PG8_LDB(B0, 1, 0); PG8_SCHED; PG8_LDA(At, 1, 0); PG8_STAGE(PG8_SA(0, 1), a2 + hstep, voffA);
            PG8_WAIT_L(8); PG8_BAR; PG8_WAIT_L(0); PG8_MMA(0, 0, At, B0); PG8_BAR; PG8_SCHED;
            PG8_LDB(B1, 1, 1); PG8_STAGE(PG8_SB(1, 0), b3, voffB);
            PG8_BAR; PG8_WAIT_L(0); PG8_MMA(0, 1, At, B1); PG8_BAR;
            PG8_LDA(At, 1, 1); PG8_STAGE(PG8_SA(1, 0), a3, voffA);
            PG8_BAR; PG8_WAIT_L(0); PG8_MMA(1, 0, At, B0); PG8_BAR; PG8_SCHED;
            PG8_STAGE(PG8_SB(1, 1), b3 + hstep, voffB);
            PG8_WAIT_V(6); PG8_BAR; PG8_MMA(1, 1, At, B1); PG8_BAR;
            }
        }
        if constexpr (ALIGN_EPI) { if (wr == 0) PG8_BAR; }
        if constexpr (!Epi::AFTER_DRAIN) { E(acc, cur, wr, wc, fr, fq); S.done(cur); }
        if (!has_next) break;
#pragma unroll
        for (int a = 0; a < 2; ++a)
#pragma unroll
            for (int b = 0; b < 2; ++b)
#pragma unroll
                for (int m = 0; m < 4; ++m)
#pragma unroll
                    for (int n = 0; n < 2; ++n) acc[a][b][m][n] = (f32x4){0.f, 0.f, 0.f, 0.f};
        cur = nxt; cA = nA; cB = nB; ++ui;
        if constexpr (ALIGN_EPI) { if (wr == 1) PG8_BAR; }
    }
    PG8_WAIT_V(0);
    if constexpr (!ALIGN_EPI) { if (wr == 0) PG8_BAR; }
    PG8_BAR;
    if constexpr (Epi::AFTER_DRAIN) { E.fused(acc, cur, wr, wc, fr, fq, lds, wid, lane); S.done(cur); }
#undef PG8_SA
#undef PG8_SB
#undef PG8_STAGE
#undef PG8_LDA
#undef PG8_LDB
#undef PG8_MMA
#undef PG8_WAIT_V
#undef PG8_WAIT_L
#undef PG8_BAR
#undef PG8_SCHED
}
}

constexpr int DM = 2048, NB = 4, SEQ = 2048, NL = 2, DB = 8, PAST = 16384, PAGE = 128, HD = 128;
constexpr int NH = 8, NKV = 2, HPG = 4, GH = 8, WIN = 512, CONVCH = 3072, DFF = 5632, INW = 6696;
constexpr int MP = NB * SEQ, MS = DB, MT = MP + MS, MPAD = 8448, NIN = 6912, NGU = 2 * DFF, NPG = PAST / PAGE;
constexpr float EPS = 1e-6f;
constexpr int PQ = 0, PKV = 1024, PCONV = 2560, PZ = 5632, PGL = 6656, PA = 6680, PBB = 6688;

constexpr size_t O_YP = 0, O_YS = O_YP + (size_t)MP * DM, O_PCMP = O_YS + (size_t)MS * DM, O_PSEL = O_PCMP + (size_t)NB * NL * NKV * SEQ * 2 * HD,
    O_PWIN = O_PSEL + (size_t)NB * NL * NKV * SEQ * 2 * HD, O_PGDN = O_PWIN + (size_t)NB * NL * NKV * WIN * 2 * HD, O_PCONV = O_PGDN + (size_t)NB * NL * GH * HD * HD,
    O_SCMP = O_PCONV + (size_t)NB * NL * 3 * CONVCH, O_SSEL = O_SCMP + (size_t)DB * NL * NKV * 2 * HD, O_SWIN = O_SSEL + (size_t)DB * NL * NKV * 2 * HD,
    O_SGDN = O_SWIN + (size_t)DB * NL * NKV * WIN * 2 * HD, O_SCONV = O_SGDN + (size_t)DB * NL * GH * HD * HD, O_END = O_SCONV + (size_t)DB * NL * 3 * CONVCH;

constexpr size_t MiB = 1u << 20;
constexpr size_t al(size_t x) { return (x + MiB - 1) / MiB * MiB; }
constexpr size_t WS_CTL = 0, CTL_BYTES = 1 * MiB;
constexpr size_t WS_WIN = WS_CTL + CTL_BYTES;
constexpr size_t WS_WOUT = WS_WIN + al((size_t)NL * NIN * DM * 2);
constexpr size_t WS_WGU = WS_WOUT + al((size_t)NL * DM * DM * 2);
constexpr size_t WS_WDN = WS_WGU + al((size_t)NL * NGU * DM * 2);
constexpr size_t WS_W1 = WS_WDN + al((size_t)NL * DM * DFF * 2);
constexpr size_t WS_MODP = WS_W1 + al((size_t)4 * 256 * 8192 * 2);
constexpr size_t WS_MOD = WS_MODP + al((size_t)16 * 2 * 12 * 12288 * 4);
constexpr size_t WS_ROPE = WS_MOD + al((size_t)2 * 12 * 12288 * 4);
constexpr size_t WS_X = WS_ROPE + al((size_t)2049 * 32 * 4);
constexpr size_t WS_H = WS_X + al((size_t)MPAD * DM * 4);
constexpr size_t WS_PROJ = WS_H + al((size_t)MPAD * DM * 2);
constexpr size_t WS_QF = WS_PROJ + al((size_t)MPAD * NIN * 4);
constexpr size_t WS_KWF = WS_QF + al((size_t)MT * 1024 * 4);
constexpr size_t WS_GATES = WS_KWF + al((size_t)NB * NKV * SEQ * 256 * 4);
constexpr size_t WS_GQ = WS_GATES + al((size_t)MT * 24 * 4);
constexpr size_t WS_GK = WS_GQ + al((size_t)MT * 1024 * 4);
constexpr size_t WS_GV = WS_GK + al((size_t)MT * 1024 * 4);
constexpr size_t WS_GO = WS_GV + al((size_t)MT * 1024 * 4);
constexpr size_t WS_GG = WS_GO + al((size_t)MT * 1024 * 4);
constexpr size_t WS_GB = WS_GG + al((size_t)MT * 8 * 4);
constexpr size_t WS_AS = WS_GB + al((size_t)MT * 8 * 4);
constexpr size_t WS_AP = WS_AS + al((size_t)4 * 4096 * 8192 * 2);
constexpr size_t WS_HIDS = WS_AP + al((size_t)2 * 256 * 8192 * 2);
constexpr size_t WS_HIDP = WS_HIDS + al((size_t)4 * 16384 * 256 * 4);
constexpr size_t WS_CBS = WS_HIDP + al((size_t)32 * 512 * 256 * 4);
constexpr size_t WS_CBP = WS_CBS + al((size_t)16384 * 128 * 4);
constexpr size_t WS_OMIX = WS_CBP + al((size_t)512 * 128 * 4);
constexpr size_t WS_MIX = WS_OMIX + al((size_t)MPAD * DM * 2);
constexpr size_t WS_ACT = WS_MIX + al((size_t)MPAD * DM * 4);
constexpr size_t WS_KSB = WS_ACT + al((size_t)MPAD * DFF * 2);
constexpr size_t KVB_SZ = (size_t)NB * NKV * SEQ * HD * 2;
constexpr size_t WS_VSB = WS_KSB + al(KVB_SZ), WS_KWB = WS_VSB + al(KVB_SZ), WS_VWB = WS_KWB + al(KVB_SZ);
constexpr size_t WS_ATA = WS_VWB + al(KVB_SZ);
constexpr size_t WS_GFR = WS_ATA + al((size_t)256 * 8 * 16 * 64 * 16);
constexpr size_t FR_W = 0, FR_Q = 16384, FR_K = 32768, FR_QK = 49152, FR_U = 57344, FR_CH = 90112;
constexpr size_t WS_GDEC = WS_GFR + al((size_t)1024 * FR_CH);
constexpr size_t WS_PEC = WS_GDEC + al(1024 * 4);
constexpr size_t WS_W1B = WS_PEC + al(1024 * 4);
constexpr size_t WS_END = WS_W1B + al((size_t)4 * 256 * 8192 * 2);

constexpr int CW_BAR = 4096;

constexpr int RING_BYTES = 131072, LDS_BYTES = 163840, MISC_OFF = LDS_BYTES - 256;
constexpr int NWAVES = 8, NTHR = 512;

__device__ __forceinline__ unsigned f2bf(float f) { unsigned u = __float_as_uint(f); return (u + 0x7fffu + ((u >> 16) & 1u)) >> 16; }
__device__ __forceinline__ unsigned pk2(float lo, float hi) { return f2bf(lo) | (f2bf(hi) << 16); }
__device__ __forceinline__ float wave_sum(float v) {
#pragma unroll
    for (int o = 1; o < 64; o <<= 1) v += __shfl_xor(v, o);
    return v;
}
__device__ __forceinline__ float wave_max(float v) {
#pragma unroll
    for (int o = 1; o < 64; o <<= 1) v = fmaxf(v, __shfl_xor(v, o));
    return v;
}
__device__ __forceinline__ float sigm(float x) { return 1.0f / (1.0f + expf(-x)); }
__device__ __forceinline__ float siluf(float x) { return x / (1.0f + expf(-x)); }
__device__ __forceinline__ float softplusf(float x) { return fmaxf(x, 0.f) + log1pf(expf(-fabsf(x))); }
__device__ __forceinline__ float gelu_tanh(float x) { return 0.5f * x * (1.0f + tanhf(0.7978845608028654f * (x + 0.044715f * x * x * x))); }

__constant__ double ROPE_INV[16] = {1.0, 0.44036660267178046, 0.19392274474868576, 0.08539710028576561, 0.03760603093086393, 0.016560440080994446, 0.007292664737217109,
    0.003211445994752591, 0.001414213562373095, 0.000622772421914596, 0.0002742481756762073, 0.00012076973741146504, 5.318295896944988e-05, 2.341999896140934e-05,
    1.031338537721246e-05, 4.5416704806078695e-06};

__device__ __forceinline__ void sincos_d(double a, float& c, float& s) {
    const double k = rint(a * 0.6366197723675814);
    const double r = (a - k * 1.5707963267948966) - k * 6.123233995736766e-17;
    const int q = (int)((long long)k & 3);
    const double r2 = r * r;
    const double sp = r * (1.0 + r2 * (-1.0 / 6 + r2 * (1.0 / 120 + r2 * (-1.0 / 5040 + r2 * (1.0 / 362880 + r2 * (-1.0 / 39916800 + r2 * (1.0 / 6227020800.0)))))));
    const double cp = 1.0 + r2 * (-0.5 + r2 * (1.0 / 24 + r2 * (-1.0 / 720 + r2 * (1.0 / 40320 + r2 * (-1.0 / 3628800 + r2 * (1.0 / 479001600 + r2 * (-1.0 / 87178291200.0)))))));
    double ss, cc;
    if (q == 0) { ss = sp; cc = cp; } else if (q == 1) { ss = cp; cc = -sp; } else if (q == 2) { ss = -sp; cc = -cp; } else { ss = -cp; cc = sp; }
    c = (float)cc; s = (float)ss;
}

#define XB_TMO      128
#define XB_XCNT(j)  (256  + 64 * (j))
#define XB_XSUB(j)  (1280 + 64 * (j))
#define XB_XGEN(j)  (2304 + 64 * (j))
#define XB_TOP      3328
#define XB_TOPGEN   3392
#define XCD_BAR_WORDS 3456
#define XB_SPIN_CAP (1u << 22)
__device__ __forceinline__ unsigned xb_ld(unsigned* p)              { return __hip_atomic_load(p, __ATOMIC_RELAXED, __HIP_MEMORY_SCOPE_AGENT); }
__device__ __forceinline__ unsigned xb_add(unsigned* p, unsigned v) { return __hip_atomic_fetch_add(p, v, __ATOMIC_RELAXED, __HIP_MEMORY_SCOPE_AGENT); }
__device__ __forceinline__ unsigned xb_xcc_id() { return (unsigned)__builtin_amdgcn_s_getreg((3 << 11) | 20) & 0xFu; }
#define XB_SPIN(cond, bar) do { unsigned _sp = 0; while (cond) { __builtin_amdgcn_s_sleep(1); \
    if ((++_sp & 255u) == 0u) { if (xb_ld(&(bar)[XB_TMO])) break; if (_sp > XB_SPIN_CAP) { atomicAdd(&(bar)[XB_TMO], 1u); break; } } } } while (0)
struct XcdBarrier { unsigned* bar; unsigned x; volatile LAS unsigned* st; };
__device__ __forceinline__ XcdBarrier xcd_barrier_post(unsigned* bar, volatile LAS unsigned* st) {
    XcdBarrier b; b.bar = bar; b.x = xb_xcc_id(); b.st = st;
    if (threadIdx.x == 0) (void)xb_add(&bar[XB_XCNT(b.x)], 1u);
    return b;
}
__device__ __forceinline__ void xcd_barrier_complete(unsigned* bar, unsigned x, unsigned& nloc, unsigned& nx) {
    const unsigned G = gridDim.x * gridDim.y * gridDim.z;
    unsigned sum, cnt, mine, sp = 0u;
    for (;;) {
        sum = 0u; cnt = 0u; mine = 0u;
#pragma unroll
        for (unsigned j = 0; j < 16; ++j) { const unsigned c = xb_ld(&bar[XB_XCNT(j)]); sum += c; cnt += (c > 0u) ? 1u : 0u; mine = (j == x) ? c : mine; }
        if (sum == G) break;
        __builtin_amdgcn_s_sleep(1);
        if ((++sp & 255u) == 0u) { if (xb_ld(&bar[XB_TMO])) break; if (sp > XB_SPIN_CAP) { atomicAdd(&bar[XB_TMO], 1u); break; } }
    }
    nloc = mine > 0u ? mine : 1u; nx = cnt > 0u ? cnt : 1u;
}
__device__ __forceinline__ void xcd_barrier(const XcdBarrier& b) {
    asm volatile("s_waitcnt vmcnt(0)" ::: "memory");
    __syncthreads();
    if (threadIdx.x == 0) {
        unsigned* bar = b.bar;
        __builtin_amdgcn_s_waitcnt(0);
        unsigned nloc = b.st[0], nx = b.st[1];
        if (nloc == 0u) { xcd_barrier_complete(bar, b.x, nloc, nx); b.st[0] = nloc; b.st[1] = nx; }
        const unsigned old = xb_add(&bar[XB_XSUB(b.x)], 1u);
        const unsigned gen = old / nloc;
        if (old + 1u == (gen + 1u) * nloc) {
            __builtin_amdgcn_fence(__ATOMIC_RELEASE, "agent");
            asm volatile("s_waitcnt vmcnt(0)" ::: "memory");
            const unsigned og = xb_add(&bar[XB_TOP], 1u);
            const unsigned tg = og / nx;
            if (og + 1u == (tg + 1u) * nx) xb_add(&bar[XB_TOPGEN], 1u);
            else XB_SPIN(xb_ld(&bar[XB_TOPGEN]) == tg, bar);
            __builtin_amdgcn_fence(__ATOMIC_ACQUIRE, "agent");
            xb_add(&bar[XB_XGEN(b.x)], 1u);
            asm volatile("s_waitcnt vmcnt(0)" ::: "memory");
        } else {
            XB_SPIN(xb_ld(&bar[XB_XGEN(b.x)]) == gen, bar);
            __builtin_amdgcn_fence(__ATOMIC_ACQUIRE, "agent");
            asm volatile("s_waitcnt vmcnt(0)" ::: "memory");
        }
    }
    __syncthreads();
}

struct Args { const void* in[28]; float* out; unsigned char* ws; int ph_lo, ph_hi; };

struct Frame {
    LAS unsigned char* lds;
    int tid, lane, wave, G, bid;
    const void* const* in; float* out; unsigned char* ws;
};


template <class Map>
__device__ __forceinline__ void tr_item(const Map& mp, int K, int NNEW, bf16* WT, LAS float* scr, int item, int lane, bf16* WB = nullptr) {
    const int nblk = NNEW / 64, kb = item / nblk, nb = item % nblk, k0 = 64 * kb, n0 = 64 * nb;
    const float* colp; int stride; const bool ok = mp(n0 + lane, colp, stride);
#pragma unroll
    for (int h = 0; h < 2; ++h) { float tv[32];
#pragma unroll
        for (int i = 0; i < 32; ++i) tv[i] = ok ? colp[(size_t)(k0 + 32 * h + i) * stride] : 0.f;
#pragma unroll
        for (int i = 0; i < 32; ++i) scr[(32 * h + i) * 65 + lane] = tv[i]; }
    asm volatile("s_waitcnt lgkmcnt(0)" ::: "memory");
    const int c = lane & 7;
#pragma unroll
    for (int j = 0; j < 8; ++j) { const int n = (lane >> 3) + 8 * j; const LAS float* s = scr + (8 * c) * 65 + n;
        u32x4 o; o.x = pk2(s[0 * 65], s[1 * 65]); o.y = pk2(s[2 * 65], s[3 * 65]); o.z = pk2(s[4 * 65], s[5 * 65]); o.w = pk2(s[6 * 65], s[7 * 65]);
        *(u32x4*)(WT + (size_t)(n0 + n) * K + k0 + 8 * c) = o;
        if (WB) *(u32x4*)(WB + ((size_t)((k0 >> 5) + (c >> 2)) * NNEW + n0 + n) * 32 + (c & 3) * 8) = o; }
    asm volatile("s_waitcnt lgkmcnt(0)" ::: "memory");
}
struct MapIn { const float* W; __device__ __forceinline__ bool operator()(int n, const float*& p, int& st) const {
    int o; if (n < 2560) o = n; else if (n < 5632) o = n + 24; else if (n < 6656) o = n + 40; else if (n < 6680) o = n - 4096; else if (n < 6696) o = n - 1024; else o = -1;
    st = INW; p = W + (o < 0 ? 0 : o); return o >= 0; } };
struct MapPlain { const float* W; int N; __device__ __forceinline__ bool operator()(int n, const float*& p, int& st) const { st = N; p = W + n; return true; } };
struct MapBase { const float* base; int stride, n0; __device__ __forceinline__ bool operator()(int n, const float*& p, int& st) const { st = stride; p = base + (n - n0); return true; } };

__device__ __forceinline__ const float* xrow_in(const Frame& F, int l, int r) {
    if (l == 0) return r < MP ? ((const float*)F.in[0]) + (size_t)r * DM : ((const float*)F.in[1]) + (size_t)(r - MP) * DM;
    return ((float*)(F.ws + WS_X)) + (size_t)r * DM;
}
__device__ __forceinline__ int modrow(int r) { return r < MP ? (r >> 11) : 4 + (r - MP); }

__device__ __forceinline__ void norm_mod_store(const f32x4 (&v)[8], const float* gain, const float* sh, const float* sc, bf16* orow, int lane) {
    float ss = 0.f;
#pragma unroll
    for (int j = 0; j < 8; ++j) ss += (v[j].x * v[j].x + v[j].y * v[j].y) + (v[j].z * v[j].z + v[j].w * v[j].w);
    ss = wave_sum(ss);
    const float rs = 1.0f / sqrtf(ss * (1.0f / DM) + EPS);
#pragma unroll
    for (int j = 0; j < 8; ++j) { const int c = (lane + 64 * j) * 4;
        const f32x4 g = *(const f32x4*)(gain + c), a = *(const f32x4*)(sc + c), b = *(const f32x4*)(sh + c);
        const f32x4 h = v[j] * rs * g * (a + 1.0f) + b;
        u32x2 o; o.x = pk2(h.x, h.y); o.y = pk2(h.z, h.w); *(u32x2*)(orow + c) = o; }
}

constexpr int TR_I_IN = (DM / 64) * (NIN / 64), TR_I_OUT = (DM / 64) * (DM / 64), TR_I_GU = (DM / 64) * (NGU / 64), TR_I_DN = (DFF / 64) * (DM / 64), TR_I_W1 = (8192 / 64) * (256 / 64);
constexpr int TR_I_L = TR_I_IN + TR_I_OUT + TR_I_GU + TR_I_DN;
__device__ __forceinline__ void tr_range(Frame& F, int first, int count, int rank, int nw) {
    LAS float* scr = (LAS float*)(F.lds + F.wave * 16896);
    const int lane = F.lane;
#pragma unroll 1
    for (int it = first + rank; it < first + count; it += nw) {
        int r = it;
        if (r < 2 * TR_I_L) {
            const int l = r / TR_I_L; r -= l * TR_I_L;
            if (r < TR_I_IN) { MapIn mp{((const float*)F.in[13]) + (size_t)l * DM * INW}; tr_item(mp, DM, NIN, ((bf16*)(F.ws + WS_WIN)) + (size_t)l * NIN * DM, scr, r, lane); continue; } r -= TR_I_IN;
            if (r < TR_I_OUT) { MapPlain mp{((const float*)F.in[21]) + (size_t)l * DM * DM, DM}; tr_item(mp, DM, DM, ((bf16*)(F.ws + WS_WOUT)) + (size_t)l * DM * DM, scr, r, lane); continue; } r -= TR_I_OUT;
            if (r < TR_I_GU) { const int n0 = (r % (NGU / 64)) * 64, tt = n0 >> 8, rr = n0 & 255;
                if (rr < 128) { MapBase mp{((const float*)F.in[24]) + (size_t)l * DM * DFF + tt * 128 + rr, DFF, n0}; tr_item(mp, DM, NGU, ((bf16*)(F.ws + WS_WGU)) + (size_t)l * NGU * DM, scr, r, lane); }
                else { MapBase mp{((const float*)F.in[25]) + (size_t)l * DM * DFF + tt * 128 + rr - 128, DFF, n0}; tr_item(mp, DM, NGU, ((bf16*)(F.ws + WS_WGU)) + (size_t)l * NGU * DM, scr, r, lane); }
                continue; } r -= TR_I_GU;
            { MapPlain mp{((const float*)F.in[26]) + (size_t)l * DFF * DM, DM}; tr_item(mp, DFF, DM, ((bf16*)(F.ws + WS_WDN)) + (size_t)l * DM * DFF, scr, r, lane); continue; }
        }
        r -= 2 * TR_I_L;
        { const int m = r / TR_I_W1; r -= m * TR_I_W1; MapPlain mp{((const float*)F.in[15]) + (size_t)m * 8192 * 256, 256}; tr_item(mp, 8192, 256, ((bf16*)(F.ws + WS_W1)) + (size_t)m * 256 * 8192, scr, r, lane, ((bf16*)(F.ws + WS_W1B)) + (size_t)m * 256 * 8192); }
    }
}

__device__ __forceinline__ void phase_prologue(Frame& F) {
    const int tid = F.tid, lane = F.lane, G = F.G;
    {
        LAS float* sc = (LAS float*)F.lds;
        for (int it = F.bid; it < 2 * 24 * 16; it += G) {
            const int ks = it & 15, chunk = (it >> 4) % 24, l = it / 384;
            for (int i = tid; i < 12 * 128; i += NTHR) { const int row = i >> 7, k = i & 127;
                const float c = row < 4 ? ((const float*)F.in[8])[row * DM + ks * 128 + k] : ((const float*)F.in[9])[(row - 4) * DM + ks * 128 + k]; sc[i] = siluf(c); }
            __syncthreads();
            const int n = chunk * 512 + tid;
            float acc[12];
#pragma unroll
            for (int r = 0; r < 12; ++r) acc[r] = 0.f;
            const float* w = ((const float*)F.in[10]) + ((size_t)l * DM + ks * 128) * 12288 + n;
#pragma unroll 1
            for (int k0 = 0; k0 < 128; k0 += 16) { float wv[16];
#pragma unroll
                for (int u = 0; u < 16; ++u) wv[u] = w[(size_t)(k0 + u) * 12288];
#pragma unroll
                for (int u = 0; u < 16; ++u)
#pragma unroll
                    for (int r = 0; r < 12; ++r) acc[r] += sc[r * 128 + k0 + u] * wv[u]; }
#pragma unroll
            for (int r = 0; r < 12; ++r) ((float*)(F.ws + WS_MODP))[((size_t)(ks * 2 + l) * 12 + r) * 12288 + n] = acc[r];
            __syncthreads();
        }
    }
    for (int i = F.bid * NTHR + tid; i < 2049 * 16; i += G * NTHR) {
        const int p = i >> 4, k = i & 15; const double pos = p < 2048 ? (double)p : (double)PAST;
        float c, s; sincos_d(pos * ROPE_INV[k], c, s); ((float*)(F.ws + WS_ROPE))[2 * i] = c; ((float*)(F.ws + WS_ROPE))[2 * i + 1] = s;
    }
    for (int i = F.bid * NTHR + tid; i < (MPAD - MT) * DM / 2; i += G * NTHR) { ((unsigned*)(((bf16*)(F.ws + WS_H)) + (size_t)MT * DM))[i] = 0u; ((unsigned*)(((bf16*)(F.ws + WS_OMIX)) + (size_t)MT * DM))[i] = 0u; }
    __syncthreads();
    tr_range(F, 0, TR_I_L, F.bid * NWAVES + F.wave, G * NWAVES);
    tr_range(F, 2 * TR_I_L, 4 * TR_I_W1, F.bid * NWAVES + F.wave, G * NWAVES);
}

__device__ __forceinline__ void ada_reduce(Frame& F) {
    for (int i = F.bid * NTHR + F.tid; i < 2 * 12 * 12288; i += F.G * NTHR) {
        const int n = i % 12288, l = i / (12 * 12288);
        float s = ((const float*)F.in[11])[l * 12288 + n];
#pragma unroll
        for (int ks = 0; ks < 16; ++ks) s += ((float*)(F.ws + WS_MODP))[(size_t)ks * (2 * 12 * 12288) + i];
        ((float*)(F.ws + WS_MOD))[i] = s;
    }
}

__device__ __forceinline__ void pe_w1(Frame& F) {
    const int gw = F.bid * NWAVES + F.wave;
    if (gw >= 1024) return;
    const bf16* wr = ((const bf16*)(F.ws + WS_W1)) + (size_t)gw * 8192; const float* pe = ((const float*)F.in[14]) + (size_t)(gw >> 8) * 8192;
    float s = 0.f;
#pragma unroll 4
    for (int i = 0; i < 16; ++i) { const int k = i * 512 + F.lane * 8;
        const u32x4 w = *(const u32x4*)(wr + k); const f32x4 p0 = *(const f32x4*)(pe + k), p1 = *(const f32x4*)(pe + k + 4);
        s += __uint_as_float(w.x << 16) * p0.x + __uint_as_float(w.x & 0xffff0000u) * p0.y + __uint_as_float(w.y << 16) * p0.z + __uint_as_float(w.y & 0xffff0000u) * p0.w
           + __uint_as_float(w.z << 16) * p1.x + __uint_as_float(w.z & 0xffff0000u) * p1.y + __uint_as_float(w.w << 16) * p1.z + __uint_as_float(w.w & 0xffff0000u) * p1.w; }
    s = wave_sum(s);
    if (F.lane == 0) ((float*)(F.ws + WS_PEC))[gw] = s;
}

template <int NSPLIT>
__device__ __forceinline__ void cmp_finish(Frame& F, const float* hid, size_t slab, int rows, int rows_per_mat, const float* w2base, float* outp, int bid0 = 0, int row0 = 0, const float* cadd = nullptr) {
    LAS float* hs = (LAS float*)F.lds;
    if (F.bid < bid0) return;
    for (int it = F.bid - bid0; it < rows / 4; it += F.G - bid0) {
#pragma unroll
        for (int i0 = 0; i0 < 2; ++i0) { const int i = F.tid + i0 * NTHR; const int rr = i >> 8, n = i & 255; const size_t R = (size_t)row0 + (size_t)it * 4 + rr;
            float pv[NSPLIT];
#pragma unroll
            for (int ks = 0; ks < NSPLIT; ++ks) pv[ks] = hid[(size_t)ks * slab + R * 256 + n];
            float s = cadd ? cadd[(R / rows_per_mat) * 256 + n] : 0.f;
#pragma unroll
            for (int ks = 0; ks < NSPLIT; ++ks) s += pv[ks];
            hs[i] = gelu_tanh(s); }
        __syncthreads();
        const int rr = F.tid >> 7, c = F.tid & 127; const size_t R = (size_t)row0 + (size_t)it * 4 + rr;
        const float* w2 = w2base + (R / rows_per_mat) * 32768;
        float acc = 0.f;
#pragma unroll 1
        for (int n0 = 0; n0 < 256; n0 += 32) { float wv[32];
#pragma unroll
            for (int u = 0; u < 32; ++u) wv[u] = w2[(n0 + u) * 128 + c];
#pragma unroll
            for (int u = 0; u < 32; ++u) acc += hs[rr * 256 + n0 + u] * wv[u]; }
        outp[R * 128 + c] = acc;
        __syncthreads();
    }
}

template <int NSPLIT>
__device__ __forceinline__ void cmp_finish16(Frame& F, const float* hid, size_t slab, int rows, int rows_per_mat, const float* w2base, float* outp, int bid0 = 0, int row0 = 0, const float* cadd = nullptr) {
    LAS float* hs = (LAS float*)F.lds;
    if (F.bid < bid0) return;
    for (int it = F.bid - bid0; it < rows / 16; it += F.G - bid0) {
        const size_t R0 = (size_t)row0 + (size_t)it * 16; const int mat = (int)(R0 / rows_per_mat);
#pragma unroll
        for (int i0 = 0; i0 < 8; ++i0) { const int i = F.tid + i0 * NTHR; const int rr = i >> 8, n = i & 255; const size_t R = R0 + rr;
            float pv[NSPLIT];
#pragma unroll
            for (int ks = 0; ks < NSPLIT; ++ks) pv[ks] = hid[(size_t)ks * slab + R * 256 + n];
            float s = cadd ? cadd[mat * 256 + n] : 0.f;
#pragma unroll
            for (int ks = 0; ks < NSPLIT; ++ks) s += pv[ks];
            hs[i] = gelu_tanh(s); }
        __syncthreads();
        const int g = F.tid >> 7, c = F.tid & 127;
        const float* w2 = w2base + (size_t)mat * 32768;
        float acc[4] = {0.f, 0.f, 0.f, 0.f};
#pragma unroll 1
        for (int n0 = 0; n0 < 256; n0 += 32) { float wv[32];
#pragma unroll
            for (int u = 0; u < 32; ++u) wv[u] = w2[(n0 + u) * 128 + c];
#pragma unroll
            for (int u = 0; u < 32; ++u)
#pragma unroll
                for (int r = 0; r < 4; ++r) acc[r] += hs[(g * 4 + r) * 256 + n0 + u] * wv[u]; }
#pragma unroll
        for (int r = 0; r < 4; ++r) outp[(R0 + g * 4 + r) * 128 + c] = acc[r];
        __syncthreads();
    }
}

__device__ __forceinline__ void phase_norm1(Frame& F, int l) {
    const int gw = F.bid * NWAVES + F.wave, NGW = F.G * NWAVES;
    for (int r = gw; r < MT; r += NGW) {
        const f32x4* xr = (const f32x4*)xrow_in(F, l, r) + F.lane;
        f32x4 v[8];
#pragma unroll
        for (int j = 0; j < 8; ++j) v[j] = xr[64 * j];
        const float* md = ((float*)(F.ws + WS_MOD)) + ((size_t)l * 12 + modrow(r)) * 12288;
        norm_mod_store(v, ((const float*)F.in[12]) + l * DM, md, md + 2048, ((bf16*)(F.ws + WS_H)) + (size_t)r * DM, F.lane);
    }
}

__device__ __forceinline__ void phase_postproj(Frame& F, int l, int parts = 7) {
    const int lane = F.lane, gw = F.bid * NWAVES + F.wave, NGW = F.G * NWAVES;
    const int j = lane & 31, hs = lane >> 5;
    float* PROJp = (float*)(F.ws + WS_PROJ);
    if (parts & 1)
#pragma unroll 1
    for (int r = gw; r < MT; r += NGW) {
        const float* pr = PROJp + (size_t)r * NIN;
        const bool isP = r < MP; const int b = isP ? (r >> 11) : (r - MP), t = isP ? (r & 2047) : 0;
        const float* rp = ((float*)(F.ws + WS_ROPE)) + (size_t)(isP ? t : 2048) * 32;
        f32x4 cs, sn;
#pragma unroll
        for (int e = 0; e < 4; ++e) { const int i = (4 * j + e) & 15; cs[e] = rp[2 * i]; sn[e] = rp[2 * i + 1]; }
        f32x4 qv[4], kv[3], vv[3];
#pragma unroll
        for (int i = 0; i < 4; ++i) qv[i] = *(const f32x4*)(pr + PQ + i * 256 + lane * 4);
#pragma unroll
        for (int s = 0; s < 3; ++s) { kv[s] = *(const f32x4*)(pr + PKV + s * 512 + lane * 4); vv[s] = *(const f32x4*)(pr + PKV + s * 512 + 256 + lane * 4); }
#pragma unroll
        for (int i = 0; i < 4; ++i) { f32x4 x = qv[i], o;
#pragma unroll
            for (int e = 0; e < 4; ++e) o[e] = __shfl_xor(x[e], 4);
            if (j < 4) x = x * cs - o * sn; else if (j < 8) x = x * cs + o * sn;
            *(f32x4*)(((float*)(F.ws + WS_QF)) + ((size_t)r * 8 + 2 * i + hs) * 128 + 4 * j) = x; }
        const int g = hs;
#pragma unroll
        for (int s = 0; s < 3; ++s) { f32x4 x = kv[s], o; const f32x4 v = vv[s];
#pragma unroll
            for (int e = 0; e < 4; ++e) o[e] = __shfl_xor(x[e], 4);
            if (j < 4) x = x * cs - o * sn; else if (j < 8) x = x * cs + o * sn;
            float* dst;
            if (s < 2) {
                if (isP) dst = F.out + (s == 0 ? O_PCMP : O_PSEL) + ((((size_t)b * NL + l) * NKV + g) * SEQ + t) * 256;
                else dst = F.out + (s == 0 ? O_SCMP : O_SSEL) + (((size_t)b * NL + l) * NKV + g) * 256;
            } else {
                dst = isP ? nullptr : F.out + O_SWIN + ((((size_t)b * NL + l) * NKV + g) * WIN + (WIN - 1)) * 256;
            }
            if (dst) { *(f32x4*)(dst + 4 * j) = x; *(f32x4*)(dst + 128 + 4 * j) = v; }
            if (s >= 1 && isP) { const size_t o2 = (((size_t)b * NKV + g) * SEQ + t) * HD + 4 * j;
                u32x2 kk, v2; kk.x = pg8::cvt_pk_bf16(x.x, x.y); kk.y = pg8::cvt_pk_bf16(x.z, x.w); v2.x = pg8::cvt_pk_bf16(v.x, v.y); v2.y = pg8::cvt_pk_bf16(v.z, v.w);
                *(u32x2*)((bf16*)(F.ws + (s == 1 ? WS_KSB : WS_KWB)) + o2) = kk; *(u32x2*)((bf16*)(F.ws + (s == 1 ? WS_VSB : WS_VWB)) + o2) = v2; }
            if (s == 2 && isP && t >= SEQ - WIN) { float* d2 = F.out + O_PWIN + ((((size_t)b * NL + l) * NKV + g) * WIN + (t - (SEQ - WIN))) * 256;
                *(f32x4*)(d2 + 4 * j) = x; *(f32x4*)(d2 + 128 + 4 * j) = v; }
            if (s == 0 && isP) {
                const int tt = t & 63; const size_t arow = ((size_t)b * 32 + (t >> 6)) * 2 + g;
                const float* pek = ((const float*)F.in[14]) + (((size_t)l * 2 + 0) * 64 + tt) * 128 + 4 * j;
                const f32x4 pk = *(const f32x4*)pek, pv = *(const f32x4*)(pek + 64 * 128);
                const f32x4 xa = x + pk, va = v + pv;
                u32x2 kk, v2; kk.x = pg8::cvt_pk_bf16(xa.x, xa.y); kk.y = pg8::cvt_pk_bf16(xa.z, xa.w); v2.x = pg8::cvt_pk_bf16(va.x, va.y); v2.y = pg8::cvt_pk_bf16(va.z, va.w);
                bf16* ak = ((bf16*)(F.ws + WS_AP)) + arow * 8192 + tt * 128 + 4 * j;
                *(u32x2*)ak = kk; *(u32x2*)(ak + (size_t)256 * 8192) = v2;
            }
        }
        if (lane < 24) ((float*)(F.ws + WS_GATES))[(size_t)r * 24 + lane] = sigm(pr[PGL + lane]);
        if (lane < 8) { ((float*)(F.ws + WS_GG))[(size_t)r * 8 + lane] = -expf(((const float*)F.in[18])[l * 8 + lane]) * softplusf(pr[PA + lane] + ((const float*)F.in[19])[l * 8 + lane]); ((float*)(F.ws + WS_GB))[(size_t)r * 8 + lane] = sigm(pr[PBB + lane]); }
        const float* stc = ((const float*)F.in[6]) + ((size_t)(isP ? 0 : b) * NL + l) * 3 * CONVCH;
        if (isP) { if (t >= SEQ - 3) { float* d = F.out + O_PCONV + (((size_t)b * NL + l) * 3 + (t - (SEQ - 3))) * CONVCH;
#pragma unroll
                for (int i = 0; i < 12; ++i) *(f32x4*)(d + i * 256 + lane * 4) = *(const f32x4*)(pr + PCONV + i * 256 + lane * 4); } }
        else { float* d = F.out + O_SCONV + ((size_t)b * NL + l) * 3 * CONVCH;
#pragma unroll
            for (int i = 0; i < 12; ++i) { const int c = i * 256 + lane * 4; *(f32x4*)(d + c) = *(const f32x4*)(stc + CONVCH + c); *(f32x4*)(d + CONVCH + c) = *(const f32x4*)(stc + 2 * CONVCH + c);
                *(f32x4*)(d + 2 * CONVCH + c) = *(const f32x4*)(pr + PCONV + c); } }
    }
    if (parts & 2) {
        const float* cwp = ((const float*)F.in[17]) + (size_t)l * 4 * CONVCH;
        const int NITEM = 12 * (NB * 32 + MS);
#pragma unroll 1
        for (int it = NGW - 1 - gw; it < NITEM; it += NGW) {
            const int cg = it % 12, tb = it / 12; const int part = cg >> 2;
            const int c = cg * 256 + lane * 4, head = (cg & 3) * 2 + hs;
            const bool isP = tb < NB * 32; const int b = isP ? (tb >> 5) : (tb - NB * 32);
            const int row0 = isP ? b * SEQ + (tb & 31) * 64 : MP + b, t0 = isP ? (tb & 31) * 64 : 0, nt = isP ? 64 : 1;
            f32x4 w0 = *(const f32x4*)(cwp + c), w1 = *(const f32x4*)(cwp + CONVCH + c), w2 = *(const f32x4*)(cwp + 2 * CONVCH + c), w3 = *(const f32x4*)(cwp + 3 * CONVCH + c);
            f32x4 x0, x1, x2; const f32x4 z4 = (f32x4){0.f, 0.f, 0.f, 0.f};
            if (isP) { if (t0 > 0) { x0 = *(const f32x4*)(PROJp + (size_t)(row0 - 3) * NIN + PCONV + c); x1 = *(const f32x4*)(PROJp + (size_t)(row0 - 2) * NIN + PCONV + c); x2 = *(const f32x4*)(PROJp + (size_t)(row0 - 1) * NIN + PCONV + c); }
                       else { x0 = z4; x1 = z4; x2 = z4; } }
            else { const float* stc = ((const float*)F.in[6]) + ((size_t)b * NL + l) * 3 * CONVCH + c; x0 = *(const f32x4*)stc; x1 = *(const f32x4*)(stc + CONVCH); x2 = *(const f32x4*)(stc + 2 * CONVCH); }
            float* dstb = (part == 0 ? ((float*)(F.ws + WS_GQ)) : part == 1 ? ((float*)(F.ws + WS_GK)) : ((float*)(F.ws + WS_GV)));
            const float qs = part == 0 ? 0.08838834764831845f : 1.0f;
            f32x4 xq[8];
#pragma unroll
            for (int u = 0; u < 8; ++u) xq[u] = (u < nt) ? *(const f32x4*)(PROJp + (size_t)(row0 + u) * NIN + PCONV + c) : z4;
#pragma unroll 1
            for (int tt0 = 0; tt0 < nt; tt0 += 8) {
                f32x4 xn[8];
#pragma unroll
                for (int u = 0; u < 8; ++u) xn[u] = xq[u];
                if (tt0 + 8 < nt) {
#pragma unroll
                    for (int u = 0; u < 8; ++u) xq[u] = *(const f32x4*)(PROJp + (size_t)(row0 + tt0 + 8 + u) * NIN + PCONV + c); }
                f32x4 y[8]; float ss[8];
#pragma unroll
                for (int u = 0; u < 8; ++u) {
                    const f32x4 xm3 = u >= 3 ? xn[u - 3 < 0 ? 0 : u - 3] : (u == 0 ? x0 : u == 1 ? x1 : x2);
                    const f32x4 xm2 = u >= 2 ? xn[u - 2 < 0 ? 0 : u - 2] : (u == 0 ? x1 : x2);
                    const f32x4 xm1 = u >= 1 ? xn[u - 1 < 0 ? 0 : u - 1] : x2;
                    f32x4 v = xm3 * w0 + xm2 * w1 + xm1 * w2 + xn[u] * w3;
#pragma unroll
                    for (int e = 0; e < 4; ++e) v[e] = v[e] * __builtin_amdgcn_rcpf(1.0f + __expf(-v[e]));
                    y[u] = v; ss[u] = (v.x * v.x + v.y * v.y) + (v.z * v.z + v.w * v.w); }
                if (part < 2) {
#pragma unroll
                    for (int o = 1; o < 32; o <<= 1)
#pragma unroll
                        for (int u = 0; u < 8; ++u) ss[u] += __shfl_xor(ss[u], o);
#pragma unroll
                    for (int u = 0; u < 8; ++u) y[u] = y[u] * (__builtin_amdgcn_rsqf(ss[u] + EPS) * qs); }
#pragma unroll
                for (int u = 0; u < 8; ++u) if (tt0 + u < nt) *(f32x4*)(dstb + ((size_t)(row0 + tt0 + u) * 8 + head) * 128 + 4 * j) = y[u];
                x0 = xn[5]; x1 = xn[6]; x2 = xn[7];
            }
        }
    }
    if (parts & 4)
    for (size_t i = (size_t)F.bid * NTHR + F.tid; i < (size_t)DB * NKV * 511 * 64; i += (size_t)F.G * NTHR) {
        const int q4 = (int)(i & 63); const size_t rest = i >> 6; const int row = (int)(rest % 511); const int bg = (int)(rest / 511); const int b = bg >> 1, g = bg & 1;
        const size_t base = (((size_t)b * NL + l) * NKV + g) * WIN;
        *(f32x4*)(F.out + O_SWIN + (base + row) * 256 + q4 * 4) = *(const f32x4*)(((const float*)F.in[4]) + (base + row + 1) * 256 + q4 * 4);
    }
}

__device__ __forceinline__ void phase_gdn_scan_naive(Frame& F, int l) {
    const int vb = F.G - 1 - F.bid;
    if (vb >= 32) return;
    const int pi = __builtin_amdgcn_readfirstlane(32 + vb * 2 + (F.tid >> 8)), w = F.tid & 255, col = w >> 1, half = w & 1;
    const int seq = pi >> 3, h = pi & 7;
    const bool isP = seq < 4; const int T = isP ? SEQ : 1; const int row0 = isP ? seq * SEQ : MP + (seq - 4);
    float S[64];
    if (isP) {
#pragma unroll
        for (int d = 0; d < 64; ++d) S[d] = 0.f;
    } else { const float* s0 = ((const float*)F.in[5]) + (((size_t)(seq - 4) * NL + l) * GH + h) * 16384 + (size_t)half * 64 * 128 + col;
#pragma unroll
        for (int d = 0; d < 64; ++d) S[d] = s0[d * 128]; }
    const float* GKp = (const float*)(F.ws + WS_GK); const float* GQp = (const float*)(F.ws + WS_GQ); const float* GVp = (const float*)(F.ws + WS_GV);
    const float* GGp = (const float*)(F.ws + WS_GG); const float* GBp = (const float*)(F.ws + WS_GB); float* GOp = (float*)(F.ws + WS_GO);
#pragma unroll 1
    for (int t = 0; t < T; ++t) {
        const size_t rh = (size_t)(row0 + t) * 8 + h;
        const f32x4* kp = (const f32x4*)(GKp + rh * 128 + half * 64); const f32x4* qp = (const f32x4*)(GQp + rh * 128 + half * 64);
        const float v = GVp[rh * 128 + col], gg = GGp[rh], beta = GBp[rh];
        const float eg = expf(gg);
        f32x4 kk[16];
        float ks0 = 0.f, ks1 = 0.f;
#pragma unroll
        for (int i = 0; i < 16; ++i) { kk[i] = kp[i]; ks0 += kk[i].x * S[4 * i] + kk[i].z * S[4 * i + 2]; ks1 += kk[i].y * S[4 * i + 1] + kk[i].w * S[4 * i + 3]; }
        float kS = ks0 + ks1; kS += __shfl_xor(kS, 1);
        const float cc = beta * (v - eg * kS);
        float o0 = 0.f, o1 = 0.f;
#pragma unroll
        for (int i = 0; i < 16; ++i) { const f32x4 qq = qp[i];
            S[4 * i] = eg * S[4 * i] + kk[i].x * cc; S[4 * i + 1] = eg * S[4 * i + 1] + kk[i].y * cc; S[4 * i + 2] = eg * S[4 * i + 2] + kk[i].z * cc; S[4 * i + 3] = eg * S[4 * i + 3] + kk[i].w * cc;
            o0 += S[4 * i] * qq.x + S[4 * i + 2] * qq.z; o1 += S[4 * i + 1] * qq.y + S[4 * i + 3] * qq.w; }
        float o = o0 + o1; o += __shfl_xor(o, 1);
        if (half == 0) GOp[rh * 128 + col] = o;
    }
    float* so = F.out + (isP ? O_PGDN + (((size_t)seq * NL + l) * GH + h) * 16384 : O_SGDN + (((size_t)(seq - 4) * NL + l) * GH + h) * 16384) + (size_t)half * 64 * 128 + col;
#pragma unroll
    for (int d = 0; d < 64; ++d) so[d * 128] = S[d];
}


__device__ __forceinline__ bf16x8 pack8(f32x4 a, f32x4 b) {
    u32x4 u; u.x = pg8::cvt_pk_bf16(a.x, a.y); u.y = pg8::cvt_pk_bf16(a.z, a.w); u.z = pg8::cvt_pk_bf16(b.x, b.y); u.w = pg8::cvt_pk_bf16(b.z, b.w);
    return __builtin_bit_cast(bf16x8, u);
}
#define MFMA16(a, b, c) __builtin_amdgcn_mfma_f32_16x16x32_bf16((a), (b), (c), 0, 0, 0)


template <int MODE, int PER>
__device__ __forceinline__ void skinny_gemm(Frame& F, const bf16* A, int lda, const bf16* Bt, int K, int nitems, float* outF, bf16* outB, int ldc) {
    const int lane = F.lane, wid = F.wave, q = lane >> 4, r16 = lane & 15;
    LAS float* red = (LAS float*)F.lds;
#pragma unroll 1
    for (int it = F.G - 1 - F.bid; it < nitems; it += F.G) {
        const int n0 = MODE != 1 ? it * 16 : (it >> 3) * 256 + (it & 7) * 16;
        const bf16* ap = A + (size_t)(r16 & 7) * lda + q * 8 + (size_t)wid * PER * 32;
        const bf16* bp0 = Bt + (size_t)(n0 + r16) * K + q * 8 + (size_t)wid * PER * 32;
        f32x4 acc0 = (f32x4){0.f, 0.f, 0.f, 0.f}, acc1 = acc0;
        constexpr int U = (PER % 11 == 0) ? 11 : 8;
#pragma unroll 1
        for (int s0 = 0; s0 < PER; s0 += U) {
            bf16x8 af[U], w0[U], w1[U];
#pragma unroll
            for (int u = 0; u < U; ++u) { af[u] = *(const bf16x8*)(ap + (s0 + u) * 32); w0[u] = *(const bf16x8*)(bp0 + (s0 + u) * 32); if (MODE == 1) w1[u] = *(const bf16x8*)(bp0 + (size_t)128 * K + (s0 + u) * 32); }
#pragma unroll
            for (int u = 0; u < U; ++u) { acc0 = MFMA16(w0[u], af[u], acc0); if (MODE == 1) acc1 = MFMA16(w1[u], af[u], acc1); }
        }
        *(LAS f32x4*)(red + (wid * 2 + 0) * 256 + lane * 4) = acc0;
        if (MODE == 1) *(LAS f32x4*)(red + (wid * 2 + 1) * 256 + lane * 4) = acc1;
        __syncthreads();
        if (wid == 0 && r16 < 8) {
            f32x4 s0v = (f32x4){0.f, 0.f, 0.f, 0.f}, s1v = s0v;
#pragma unroll
            for (int w = 0; w < 8; ++w) { s0v = s0v + *(const LAS f32x4*)(red + (w * 2 + 0) * 256 + lane * 4); if (MODE == 1) s1v = s1v + *(const LAS f32x4*)(red + (w * 2 + 1) * 256 + lane * 4); }
            if (MODE == 0) *(f32x4*)(outF + (size_t)(MP + r16) * ldc + n0 + 4 * q) = s0v;
            else if (MODE == 2) { u32x2 w2; w2.x = pg8::cvt_pk_bf16(s0v[0], s0v[1]); w2.y = pg8::cvt_pk_bf16(s0v[2], s0v[3]); *(u32x2*)(outB + (size_t)(MP + r16) * ldc + n0 + 4 * q) = w2; }
            else { float o[4];
#pragma unroll
                for (int j = 0; j < 4; ++j) o[j] = s0v[j] / (1.0f + __expf(-s0v[j])) * s1v[j];
                u32x2 w2; w2.x = pg8::cvt_pk_bf16(o[0], o[1]); w2.y = pg8::cvt_pk_bf16(o[2], o[3]);
                *(u32x2*)(outB + (size_t)(MP + r16) * ldc + it * 16 + 4 * q) = w2; }
        }
        __syncthreads();
    }
}


template <int MODE, int KSTEPS>
__device__ __forceinline__ void skinny_wave(Frame& F, const bf16* A, int lda, const bf16* Bt, int K, int nitems, float* outF, bf16* outB, int ldc, int rank, int nw) {
    const int lane = F.lane, q = lane >> 4, r16 = lane & 15;
#pragma unroll 1
    for (int it = rank; it < nitems; it += nw) {
        const int n0 = MODE == 0 ? it * 16 : (it >> 3) * 256 + (it & 7) * 16;
        const bf16* ap = A + (size_t)(r16 & 7) * lda + q * 8;
        const bf16* bp = Bt + (size_t)(n0 + r16) * K + q * 8;
        f32x4 acc0 = (f32x4){0.f, 0.f, 0.f, 0.f}, acc1 = acc0;
        constexpr int U = MODE == 0 ? 16 : 8;
#pragma unroll 1
        for (int s0 = 0; s0 < KSTEPS; s0 += U) { bf16x8 af[U], w0[U], w1[U];
#pragma unroll
            for (int u = 0; u < U; ++u) { af[u] = *(const bf16x8*)(ap + (s0 + u) * 32); w0[u] = *(const bf16x8*)(bp + (s0 + u) * 32); if (MODE == 1) w1[u] = *(const bf16x8*)(bp + (size_t)128 * K + (s0 + u) * 32); }
#pragma unroll
            for (int u = 0; u < U; ++u) { if (MODE == 1) { acc0 = MFMA16(w0[u], af[u], acc0); acc1 = MFMA16(w1[u], af[u], acc1); }
                else { if (u & 1) acc1 = MFMA16(w0[u], af[u], acc1); else acc0 = MFMA16(w0[u], af[u], acc0); } } }
        if (r16 < 8) {
            if (MODE == 0) *(f32x4*)(outF + (size_t)(MP + r16) * ldc + n0 + 4 * q) = acc0 + acc1;
            else { float o[4];
#pragma unroll
                for (int j = 0; j < 4; ++j) o[j] = acc0[j] / (1.0f + __expf(-acc0[j])) * acc1[j];
                u32x2 w2; w2.x = pg8::cvt_pk_bf16(o[0], o[1]); w2.y = pg8::cvt_pk_bf16(o[2], o[3]);
                *(u32x2*)(outB + (size_t)(MP + r16) * ldc + it * 16 + 4 * q) = w2; }
        }
    }
}
__device__ __forceinline__ void phase_cmp_direct(Frame& F) {
    const int lane = F.lane, wid = F.wave, q = lane >> 4, r16 = lane & 15;
    LAS unsigned char* lb = F.lds;
    constexpr int BB = 16384;
    const float* cache = (const float*)F.in[2]; const int* page_table = (const int*)F.in[7];
    const bf16* W1B = (const bf16*)(F.ws + WS_W1B); float* HID = (float*)(F.ws + WS_HIDS);
#pragma unroll 1
    for (int u = F.bid; u < 256; u += F.G) {
        const int combo = (u & 7) | (((u >> 3) & 1) << 3), mat = combo >> 2, pk = combo & 3, rt = u >> 4, l = mat >> 1, kv = mat & 1;
        const int rot = rt * 4;
        const float* arow[2];
#pragma unroll
        for (int mt = 0; mt < 2; ++mt) { const int m = rt * 256 + wid * 32 + mt * 16 + r16; const int b = m >> 9, j = (m >> 1) & 255, g = m & 1;
            const int phys = page_table[b * NPG + (j >> 1)];
            arow[mt] = cache + ((((size_t)phys * NL + l) * NKV + g) * PAGE + (j & 1) * 64) * 256 + kv * 128 + (size_t)(16 * pk) * 256 + 8 * q; }
        const bf16* brow[2];
#pragma unroll
        for (int i = 0; i < 2; ++i) brow[i] = W1B + (size_t)mat * 256 * 8192 + ((size_t)(64 * pk) * 256 + wid * 32 + i * 16 + (lane >> 2)) * 32 + (((lane & 3) ^ ((0x78 >> (2 * (lane >> 4))) & 3)) * 8);
#define CMPD_B(t, slot) do { _Pragma("unroll") for (int i = 0; i < 2; ++i) \
            __builtin_amdgcn_global_load_lds((const unsigned*)(brow[i] + (((t) + rot) & 63) * 8192), (LAS unsigned*)(lb + (slot) * BB + (wid * 2 + i) * 1024), 16, 0, 0); } while (0)
#define CMPD_A(t, j) do { const int tt = ((t) + rot) & 63; _Pragma("unroll") for (int mt = 0; mt < 2; ++mt) { const float* ap = arow[mt] + (tt >> 2) * 256 + (tt & 3) * 32; \
            ar[j][2 * mt] = *(const f32x4*)ap; ar[j][2 * mt + 1] = *(const f32x4*)(ap + 4); } } while (0)
        f32x4 acc[2][16];
#pragma unroll
        for (int mt = 0; mt < 2; ++mt)
#pragma unroll
            for (int nt = 0; nt < 16; ++nt) acc[mt][nt] = (f32x4){0.f, 0.f, 0.f, 0.f};
        f32x4 ar[4][4];
        __syncthreads();
#pragma unroll
        for (int j = 0; j < 4; ++j) { CMPD_B(j, j); CMPD_A(j, j); }
        const int boff = r16 * 64 + ((q ^ ((0x78 >> (2 * ((r16 >> 2) & 3))) & 3)) << 4);
        int slot = 0;
#pragma unroll 1
        for (int t0 = 0; t0 < 64; t0 += 4) {
#pragma unroll
            for (int j = 0; j < 4; ++j) {
                const int t = t0 + j;
                if (t0 < 60) asm volatile("s_waitcnt vmcnt(18) lgkmcnt(0)" ::: "memory"); else asm volatile("s_waitcnt vmcnt(0) lgkmcnt(0)" ::: "memory");
                __builtin_amdgcn_s_barrier();
                const LAS unsigned char* bb = lb + slot * BB + boff;
                bf16x8 af[2];
#pragma unroll
                for (int mt = 0; mt < 2; ++mt) af[mt] = pack8(ar[j][2 * mt], ar[j][2 * mt + 1]);
                int ns = slot + 4; if (ns >= 5) ns -= 5;
                if (t0 < 60) { CMPD_B(t + 4, ns); CMPD_A(t + 4, j); }
#pragma unroll
                for (int g2 = 0; g2 < 8; ++g2) { bf16x8 bf[2];
#pragma unroll
                    for (int e = 0; e < 2; ++e) bf[e] = *(const LAS bf16x8*)(bb + (2 * g2 + e) * 1024);
                    __builtin_amdgcn_sched_barrier(0);
#pragma unroll
                    for (int e = 0; e < 2; ++e) { acc[0][2 * g2 + e] = MFMA16(bf[e], af[0], acc[0][2 * g2 + e]); acc[1][2 * g2 + e] = MFMA16(bf[e], af[1], acc[1][2 * g2 + e]); } }
                slot = slot + 1; if (slot >= 5) slot = 0;
            }
        }
#undef CMPD_A
#undef CMPD_B
        float* hp = HID + (size_t)pk * ((size_t)16384 * 256);
#pragma unroll
        for (int mt = 0; mt < 2; ++mt) { float* rp = hp + (size_t)(mat * 4096 + rt * 256 + wid * 32 + mt * 16 + r16) * 256 + 4 * q;
#pragma unroll
            for (int nt = 0; nt < 16; ++nt) *(f32x4*)(rp + 16 * nt) = acc[mt][nt]; }
    }
    __syncthreads();
}

#ifndef GP_W0
#define GP_W0 128
#define GP_NW 8
#endif
__device__ __forceinline__ void phase_gdn_pre(Frame& F, int l) {
    if (F.bid < GP_W0 || F.wave >= GP_NW) return;
    const int NGW = (F.G - GP_W0) * GP_NW, gw = (F.bid - GP_W0) * GP_NW + F.wave;
    const int lane0 = F.lane;
    LAS float* Af = (LAS float*)(F.lds + F.wave * 16896);
    LAS unsigned char* Tb = (LAS unsigned char*)Af;
    const float* GQp = (const float*)(F.ws + WS_GQ); const float* GKp = (const float*)(F.ws + WS_GK); const float* GVp = (const float*)(F.ws + WS_GV);
    const float* GGp = (const float*)(F.ws + WS_GG); const float* GBp = (const float*)(F.ws + WS_GB); float* GDECp = (float*)(F.ws + WS_GDEC);
#pragma unroll 1
    for (int it = gw; it < 1024; it += NGW) {
        int lane = lane0; asm volatile("" : "+v"(lane));
        const int q = lane >> 4, r16 = lane & 15;
        const int c = it & 31, p = it >> 5, h = p & 7, b = p >> 3;
        const int row0 = b * SEQ + c * 64;
        unsigned char* fr = F.ws + WS_GFR + (size_t)it * FR_CH;
        const float gg = GGp[(size_t)(row0 + lane) * 8 + h], bt = GBp[(size_t)(row0 + lane) * 8 + h];
        float gc = gg;
#pragma unroll
        for (int o = 1; o < 64; o <<= 1) { const float tt = __shfl_up(gc, o); if (lane >= o) gc += tt; }
        const float gl = __shfl(gc, 63);
        if (lane == 0) GDECp[it] = __expf(gl);
        bf16x8 kf[4][4];
#pragma unroll
        for (int mt = 0; mt < 4; ++mt)
#pragma unroll
            for (int s = 0; s < 4; ++s) { const float* kr = GKp + ((size_t)(row0 + 16 * mt + r16) * 8 + h) * 128 + 32 * s + 4 * q; kf[mt][s] = pack8(*(const f32x4*)kr, *(const f32x4*)(kr + 16)); }
        asm volatile("s_waitcnt lgkmcnt(0)" ::: "memory");
#pragma unroll
        for (int mt = 0; mt < 4; ++mt)
#pragma unroll
            for (int nt = 0; nt <= mt; ++nt) {
                f32x4 acc = (f32x4){0.f, 0.f, 0.f, 0.f};
#pragma unroll
                for (int s = 0; s < 4; ++s) acc = MFMA16(kf[mt][s], kf[nt][s], acc);
                const int j = 16 * nt + r16; const float gcj = __shfl(gc, j);
#pragma unroll
                for (int r = 0; r < 4; ++r) { const int i = 16 * mt + 4 * q + r; const float gi = __shfl(gc, i), bi = __shfl(bt, i);
                    Af[i * 64 + j] = (j < i) ? bi * acc[r] * __expf(gi - gcj) : 0.f; }
            }
        {
            bf16x8 qf[4][4];
#pragma unroll
            for (int mt = 0; mt < 4; ++mt) { const float egi = __expf(__shfl(gc, 16 * mt + r16));
#pragma unroll
                for (int s = 0; s < 4; ++s) { const float* qr = GQp + ((size_t)(row0 + 16 * mt + r16) * 8 + h) * 128 + 32 * s + 4 * q;
                    const f32x4 a = *(const f32x4*)qr, b2 = *(const f32x4*)(qr + 16); qf[mt][s] = pack8(a, b2);
                    *(bf16x8*)(fr + FR_Q + ((mt * 4 + s) * 64 + lane) * 16) = pack8(a * egi, b2 * egi); } }
#pragma unroll
            for (int nt = 0; nt < 4; ++nt) { const int i = 16 * nt + r16; const float gci = __shfl(gc, i);
#pragma unroll
                for (int sp = 0; sp < 2; ++sp) { f32x4 v0 = (f32x4){0.f, 0.f, 0.f, 0.f}, v1 = v0;
                    if (2 * sp <= nt) { f32x4 acc = (f32x4){0.f, 0.f, 0.f, 0.f};
#pragma unroll
                        for (int s = 0; s < 4; ++s) acc = MFMA16(kf[2 * sp][s], qf[nt][s], acc);
#pragma unroll
                        for (int r = 0; r < 4; ++r) { const int jp = 32 * sp + 4 * q + r; const float gj = __shfl(gc, jp); v0[r] = (jp <= i) ? acc[r] * __expf(gci - gj) : 0.f; } }
                    if (2 * sp + 1 <= nt) { f32x4 acc = (f32x4){0.f, 0.f, 0.f, 0.f};
#pragma unroll
                        for (int s = 0; s < 4; ++s) acc = MFMA16(kf[2 * sp + 1][s], qf[nt][s], acc);
#pragma unroll
                        for (int r = 0; r < 4; ++r) { const int jp = 32 * sp + 16 + 4 * q + r; const float gj = __shfl(gc, jp); v1[r] = (jp <= i) ? acc[r] * __expf(gci - gj) : 0.f; } }
                    *(bf16x8*)(fr + FR_QK + ((nt * 2 + sp) * 64 + lane) * 16) = pack8(v0, v1); } }
        }
        float t[64];
#pragma unroll
        for (int i = 0; i < 64; ++i) {
            float acc = (lane == i) ? 1.f : 0.f;
#pragma unroll
            for (int j4 = 0; j4 < (i + 3) / 4; ++j4) { const f32x4 a = *(const LAS f32x4*)(Af + i * 64 + j4 * 4);
                if (4 * j4 + 0 < i) acc -= a.x * t[4 * j4 + 0];
                if (4 * j4 + 1 < i) acc -= a.y * t[4 * j4 + 1];
                if (4 * j4 + 2 < i) acc -= a.z * t[4 * j4 + 2];
                if (4 * j4 + 3 < i) acc -= a.w * t[4 * j4 + 3]; }
            t[i] = acc;
            if ((i & 3) == 3) asm volatile("" ::: "memory");
        }
        asm volatile("s_waitcnt lgkmcnt(0)" ::: "memory");
        { const float sb = bt, sg = bt * __expf(gc);
#pragma unroll
          for (int i = 0; i < 64; ++i) { const int off = i * 128 + ((((lane >> 3) ^ (i & 7)) << 4) + (lane & 7) * 2);
              *(LAS unsigned short*)(Tb + off) = (unsigned short)f2bf(t[i] * sb); *(LAS unsigned short*)(Tb + 8192 + off) = (unsigned short)f2bf(t[i] * sg); } }
        asm volatile("s_waitcnt lgkmcnt(0)" ::: "memory");
        {
            bf16x8 ta[4][2];
#pragma unroll
            for (int mt = 0; mt < 4; ++mt)
#pragma unroll
                for (int sp = 0; sp < 2; ++sp) ta[mt][sp] = *(const LAS bf16x8*)(Tb + (16 * mt + r16) * 128 + (((4 * sp + q) ^ (r16 & 7)) << 4));
#pragma unroll 4
            for (int n8 = 0; n8 < 8; ++n8) { bf16x8 vb[2];
#pragma unroll
                for (int sp = 0; sp < 2; ++sp) { float x[8];
#pragma unroll
                    for (int jj = 0; jj < 8; ++jj) x[jj] = GVp[((size_t)(row0 + 32 * sp + 8 * q + jj) * 8 + h) * 128 + 16 * n8 + r16];
                    vb[sp] = pack8((f32x4){x[0], x[1], x[2], x[3]}, (f32x4){x[4], x[5], x[6], x[7]}); }
#pragma unroll
                for (int mt = 0; mt < 4; ++mt) { f32x4 acc = (f32x4){0.f, 0.f, 0.f, 0.f};
#pragma unroll
                    for (int sp = 0; sp < 2; ++sp) acc = MFMA16(ta[mt][sp], vb[sp], acc);
                    *(f32x4*)(fr + FR_U + ((n8 * 4 + mt) * 64 + lane) * 16) = acc; } }
        }
        {
            float fdec[2][8]; const float ed = __expf(gl - gc);
#pragma unroll
            for (int sp = 0; sp < 2; ++sp)
#pragma unroll
                for (int j = 0; j < 8; ++j) fdec[sp][j] = __shfl(ed, 32 * sp + (j < 4 ? 4 * q + j : 16 + 4 * q + j - 4));
            bf16x8 tb[4][2];
#pragma unroll
            for (int nt = 0; nt < 4; ++nt)
#pragma unroll
                for (int sp = 0; sp < 2; ++sp) { const int i = 16 * nt + r16;
                    const u32x2 lo = *(const LAS u32x2*)(Tb + 8192 + i * 128 + ((((4 * sp + (q >> 1)) ^ (i & 7)) << 4) + (q & 1) * 8));
                    const u32x2 hi = *(const LAS u32x2*)(Tb + 8192 + i * 128 + ((((4 * sp + 2 + (q >> 1)) ^ (i & 7)) << 4) + (q & 1) * 8));
                    u32x4 w4; w4.x = lo.x; w4.y = lo.y; w4.z = hi.x; w4.w = hi.y; tb[nt][sp] = __builtin_bit_cast(bf16x8, w4); }
#pragma unroll 2
            for (int s = 0; s < 4; ++s) {
                f32x4 acc[2][4];
#pragma unroll
                for (int e = 0; e < 2; ++e)
#pragma unroll
                    for (int nt = 0; nt < 4; ++nt) acc[e][nt] = (f32x4){0.f, 0.f, 0.f, 0.f};
#pragma unroll
                for (int e = 0; e < 2; ++e)
#pragma unroll
                    for (int sp = 0; sp < 2; ++sp) { float x[8];
#pragma unroll
                        for (int j = 0; j < 8; ++j) { const int tok = 32 * sp + (j < 4 ? 4 * q + j : 16 + 4 * q + j - 4);
                            x[j] = GKp[((size_t)(row0 + tok) * 8 + h) * 128 + 16 * (2 * s + e) + r16]; }
                        const bf16x8 ka = pack8((f32x4){x[0], x[1], x[2], x[3]}, (f32x4){x[4], x[5], x[6], x[7]});
#pragma unroll
                        for (int nt = 0; nt < 4; ++nt) acc[e][nt] = MFMA16(ka, tb[nt][sp], acc[e][nt]);
#pragma unroll
                        for (int j = 0; j < 8; ++j) x[j] *= fdec[sp][j];
                        *(bf16x8*)(fr + FR_K + (((2 * s + e) * 2 + sp) * 64 + lane) * 16) = pack8((f32x4){x[0], x[1], x[2], x[3]}, (f32x4){x[4], x[5], x[6], x[7]}); }
#pragma unroll
                for (int nt = 0; nt < 4; ++nt) *(bf16x8*)(fr + FR_W + ((nt * 4 + s) * 64 + lane) * 16) = pack8(-acc[0][nt], -acc[1][nt]);
            }
        }
        asm volatile("s_waitcnt lgkmcnt(0)" ::: "memory");
    }
}

__device__ __forceinline__ void phase_gdn_scan(Frame& F, int l) {
    if (F.bid >= 64) return;
    const int lane = F.lane, wid = F.wave, q = lane >> 4, r16 = lane & 15;
    const int hf = (F.bid >> 3) & 1, p = (F.bid >> 4) * 8 + (F.bid & 7), h = p & 7, b = p >> 3;
    const float* GDECp = (const float*)(F.ws + WS_GDEC); float* GOp = (float*)(F.ws + WS_GO);
    LAS unsigned char* lb = F.lds;
    constexpr int CB = 57344, UB = 16384, UOFF = 2 * CB, DOFF = 2 * CB + 2 * UB;
    __syncthreads();
    if (wid >= 4) {
        const int lw = wid - 4, sl = hf * 4 + lw;
        const unsigned char* fr = F.ws + WS_GFR + (size_t)(p * 32) * FR_CH;
#pragma unroll
        for (int f = 0; f < 14; ++f) __builtin_amdgcn_global_load_lds((const unsigned*)(fr + (lw + 4 * f) * 1024 + lane * 16), (LAS unsigned*)(lb + (lw + 4 * f) * 1024), 16, 0, 0);
        f32x4 u4[4];
#pragma unroll
        for (int mt = 0; mt < 4; ++mt) u4[mt] = *(const f32x4*)(fr + FR_U + ((sl * 4 + mt) * 64 + lane) * 16);
        const float d0 = GDECp[p * 32];
#pragma unroll
        for (int mt = 0; mt < 4; ++mt) *(LAS f32x4*)(lb + UOFF + (lw * 4 + mt) * 1024 + lane * 16) = u4[mt];
        if (wid == 4 && lane == 0) *(LAS float*)(lb + DOFF) = d0;
        asm volatile("s_waitcnt vmcnt(0) lgkmcnt(0)" ::: "memory");
    }
    __builtin_amdgcn_s_barrier();
    f32x4 S[8];
#pragma unroll
    for (int m = 0; m < 8; ++m) S[m] = (f32x4){0.f, 0.f, 0.f, 0.f};
    const int sl = hf * 4 + (wid & 3);
#pragma unroll 1
    for (int c = 0; c < 32; ++c) {
        if (wid >= 4) {
            if (c + 1 < 32) {
                const int lw = wid - 4, nbuf = (c + 1) & 1;
                const unsigned char* fr = F.ws + WS_GFR + (size_t)(p * 32 + c + 1) * FR_CH; LAS unsigned char* nb = lb + nbuf * CB;
#pragma unroll
                for (int f = 0; f < 14; ++f) __builtin_amdgcn_global_load_lds((const unsigned*)(fr + (lw + 4 * f) * 1024 + lane * 16), (LAS unsigned*)(nb + (lw + 4 * f) * 1024), 16, 0, 0);
                f32x4 u4[4];
#pragma unroll
                for (int mt = 0; mt < 4; ++mt) u4[mt] = *(const f32x4*)(fr + FR_U + ((sl * 4 + mt) * 64 + lane) * 16);
                const float dn = GDECp[p * 32 + c + 1];
#pragma unroll
                for (int mt = 0; mt < 4; ++mt) *(LAS f32x4*)(lb + UOFF + nbuf * UB + (lw * 4 + mt) * 1024 + lane * 16) = u4[mt];
                if (wid == 4 && lane == 0) *(LAS float*)(lb + DOFF + nbuf * 64) = dn;
                asm volatile("s_waitcnt vmcnt(0) lgkmcnt(0)" ::: "memory");
            }
        } else {
            const LAS unsigned char* cb = lb + (c & 1) * CB;
            const float dec = *(const LAS float*)(lb + DOFF + (c & 1) * 64);
            f32x4 vn[4], o[4];
#pragma unroll
            for (int mt = 0; mt < 4; ++mt) { vn[mt] = *(const LAS f32x4*)(lb + UOFF + (c & 1) * UB + (wid * 4 + mt) * 1024 + lane * 16); o[mt] = (f32x4){0.f, 0.f, 0.f, 0.f}; }
            bf16x8 Sb[4];
#pragma unroll
            for (int s = 0; s < 4; ++s) Sb[s] = pack8(S[2 * s], S[2 * s + 1]);
#pragma unroll
            for (int s = 0; s < 4; ++s) { bf16x8 wf[4], qf[4];
#pragma unroll
                for (int mt = 0; mt < 4; ++mt) { wf[mt] = *(const LAS bf16x8*)(cb + FR_W + ((mt * 4 + s) * 64 + lane) * 16); qf[mt] = *(const LAS bf16x8*)(cb + FR_Q + ((mt * 4 + s) * 64 + lane) * 16); }
#pragma unroll
                for (int mt = 0; mt < 4; ++mt) { vn[mt] = MFMA16(wf[mt], Sb[s], vn[mt]); o[mt] = MFMA16(qf[mt], Sb[s], o[mt]); } }
            bf16x8 Vb[2];
#pragma unroll
            for (int sp = 0; sp < 2; ++sp) Vb[sp] = pack8(vn[2 * sp], vn[2 * sp + 1]);
#pragma unroll
            for (int m2 = 0; m2 < 4; ++m2) { bf16x8 kf[4];
#pragma unroll
                for (int e = 0; e < 4; ++e) kf[e] = *(const LAS bf16x8*)(cb + FR_K + (((2 * m2 + (e >> 1)) * 2 + (e & 1)) * 64 + lane) * 16);
                S[2 * m2] = S[2 * m2] * dec; S[2 * m2 + 1] = S[2 * m2 + 1] * dec;
                S[2 * m2] = MFMA16(kf[0], Vb[0], S[2 * m2]); S[2 * m2 + 1] = MFMA16(kf[2], Vb[0], S[2 * m2 + 1]);
                S[2 * m2] = MFMA16(kf[1], Vb[1], S[2 * m2]); S[2 * m2 + 1] = MFMA16(kf[3], Vb[1], S[2 * m2 + 1]); }
            { bf16x8 gf[8];
#pragma unroll
              for (int e = 0; e < 8; ++e) gf[e] = *(const LAS bf16x8*)(cb + FR_QK + (e * 64 + lane) * 16);
#pragma unroll
              for (int mt = 0; mt < 4; ++mt) { o[mt] = MFMA16(gf[mt * 2], Vb[0], o[mt]); }
#pragma unroll
              for (int mt = 0; mt < 4; ++mt) { o[mt] = MFMA16(gf[mt * 2 + 1], Vb[1], o[mt]); } }
#pragma unroll
            for (int mt = 0; mt < 4; ++mt)
#pragma unroll
                for (int r = 0; r < 4; ++r) GOp[((size_t)(b * SEQ + c * 64 + 16 * mt + 4 * q + r) * 8 + h) * 128 + sl * 16 + r16] = o[mt][r];
            asm volatile("s_waitcnt lgkmcnt(0)" ::: "memory");
        }
        __builtin_amdgcn_s_barrier();
    }
    if (wid < 4) {
        float* so = F.out + O_PGDN + (((size_t)b * NL + l) * GH + h) * 16384 + sl * 16 + r16;
#pragma unroll
        for (int m = 0; m < 8; ++m)
#pragma unroll
            for (int r = 0; r < 4; ++r) so[(size_t)(16 * m + 4 * q + r) * 128] = S[m][r];
    }
    __syncthreads();
}

__device__ __forceinline__ void phase_gdn_out(Frame& F, int l) {
    if (F.bid < 16 || F.bid >= 128) return;
    const int lane = F.lane, qb = F.bid >> 3;
    int cum = (F.bid & 7) * (25 - qb);
    for (int qq = 2; qq < qb; ++qq) cum += 8 * (25 - qq);
    const int r_lo = (int)(((long)MT * cum) / 1848), r_hi = (int)(((long)MT * (cum + 25 - qb)) / 1848);
    const float* gn = ((const float*)F.in[20]) + l * 128;
    const float g0 = gn[lane], g1 = gn[64 + lane];
    for (int r = r_lo + F.wave; r < r_hi; r += NWAVES) {
        const float* go = ((const float*)(F.ws + WS_GO)) + (size_t)r * 1024; const float* z = ((const float*)(F.ws + WS_PROJ)) + (size_t)r * NIN + PZ;
        float o[16], zz[16], ss[8];
#pragma unroll
        for (int i = 0; i < 16; ++i) { o[i] = go[(i >> 1) * 128 + (i & 1) * 64 + lane]; zz[i] = z[(i >> 1) * 128 + (i & 1) * 64 + lane]; }
#pragma unroll
        for (int h = 0; h < 8; ++h) ss[h] = o[2 * h] * o[2 * h] + o[2 * h + 1] * o[2 * h + 1];
#pragma unroll
        for (int ofs = 1; ofs < 64; ofs <<= 1)
#pragma unroll
            for (int h = 0; h < 8; ++h) ss[h] += __shfl_xor(ss[h], ofs);
        bf16* dst = ((bf16*)(F.ws + WS_OMIX)) + (size_t)r * DM + 1024;
#pragma unroll
        for (int h = 0; h < 8; ++h) { const float rs = __builtin_amdgcn_rsqf(ss[h] * (1.0f / 128.0f) + EPS);
            dst[h * 128 + lane] = (bf16)f2bf(o[2 * h] * rs * g0 * (zz[2 * h] * __builtin_amdgcn_rcpf(1.0f + __expf(-zz[2 * h])))); dst[h * 128 + 64 + lane] = (bf16)f2bf(o[2 * h + 1] * rs * g1 * (zz[2 * h + 1] * __builtin_amdgcn_rcpf(1.0f + __expf(-zz[2 * h + 1])))); }
    }
}

struct Soft { float m[4], l[4], a0[4], a1[4]; };
__device__ __forceinline__ void soft_init(Soft& s) {
#pragma unroll
    for (int i = 0; i < 4; ++i) { s.m[i] = -INFINITY; s.l[i] = 0.f; s.a0[i] = 0.f; s.a1[i] = 0.f; }
}
__device__ __forceinline__ void attn_block(const LAS float* qs, const float* kptr, const float* vbase, int vstride, int k_lo, int k_hi, int lane, Soft& st, float (&sout)[4]) {
    const bool valid = lane >= k_lo && lane <= k_hi;
    float s[4] = {0.f, 0.f, 0.f, 0.f};
    if (valid) {
#pragma unroll 1
        for (int half = 0; half < 2; ++half) { f32x4 kk[16];
#pragma unroll
            for (int i = 0; i < 16; ++i) kk[i] = *(const f32x4*)(kptr + half * 64 + i * 4);
#pragma unroll
            for (int i = 0; i < 16; ++i)
#pragma unroll
                for (int hh = 0; hh < 4; ++hh) { const f32x4 qq = *(const LAS f32x4*)(qs + hh * 128 + half * 64 + i * 4); s[hh] += (kk[i].x * qq.x + kk[i].y * qq.y) + (kk[i].z * qq.z + kk[i].w * qq.w); } }
    }
    float p[4];
#pragma unroll
    for (int hh = 0; hh < 4; ++hh) {
        s[hh] = valid ? s[hh] * 0.08838834764831845f : -INFINITY; sout[hh] = s[hh];
        const float mn = fmaxf(st.m[hh], wave_max(s[hh]));
        const float corr = (st.m[hh] == -INFINITY) ? 0.f : expf(st.m[hh] - mn);
        p[hh] = valid ? expf(s[hh] - mn) : 0.f;
        st.l[hh] = st.l[hh] * corr + wave_sum(p[hh]); st.a0[hh] *= corr; st.a1[hh] *= corr; st.m[hh] = mn;
    }
    int k = k_lo;
#pragma unroll 1
    for (; k + 7 <= k_hi; k += 8) { float v0[8], v1[8];
#pragma unroll
        for (int e = 0; e < 8; ++e) { const float* vr = vbase + (size_t)(k + e) * vstride; v0[e] = vr[lane]; v1[e] = vr[64 + lane]; }
#pragma unroll
        for (int e = 0; e < 8; ++e)
#pragma unroll
            for (int hh = 0; hh < 4; ++hh) { const float pb = __shfl(p[hh], k + e); st.a0[hh] += pb * v0[e]; st.a1[hh] += pb * v1[e]; } }
#pragma unroll 1
    for (; k <= k_hi; ++k) { const float* vr = vbase + (size_t)k * vstride; const float v0 = vr[lane], v1 = vr[64 + lane];
#pragma unroll
        for (int hh = 0; hh < 4; ++hh) { const float pb = __shfl(p[hh], k); st.a0[hh] += pb * v0; st.a1[hh] += pb * v1; } }
}

__device__ __forceinline__ void phase_nsa_sample(Frame& F, int l) {
    if (F.bid >= MS * 2) return;
    const int tid = F.tid, lane = F.lane, wid = F.wave;
    const int s = F.bid >> 1, g = F.bid & 1, r = MP + s;
    LAS float* qs = (LAS float*)F.lds;
    LAS float* imps = qs + 512;
    LAS unsigned* selw = (LAS unsigned*)(imps + 256);
    LAS float* part = imps + 512;
    constexpr int PST = 520;
    const float* QFp = (const float*)(F.ws + WS_QF); const float* CBSp = (const float*)(F.ws + WS_CBS); const float* GATp = (const float*)(F.ws + WS_GATES);
    const float* cache_sel = (const float*)F.in[3]; const float* cache_win = (const float*)F.in[4]; const int* page_table = (const int*)F.in[7];
    __syncthreads();
    qs[tid] = QFp[((size_t)r * 8 + g * 4) * 128 + tid];
    __syncthreads();
    Soft sc, ss, sw; soft_init(sc); soft_init(ss); soft_init(sw);
    float sraw[4] = {0.f, 0.f, 0.f, 0.f}, sdum[4];
    const float* kcb = CBSp + (((size_t)(l * 2 + 0) * 4096) + ((size_t)s * 256) * 2 + g) * 128; const float* vcb = kcb + (size_t)4096 * 128;
    if (wid < 4) attn_block(qs, kcb + ((size_t)wid * 64 + lane) * 256, vcb + (size_t)wid * 64 * 256, 256, 0, 63, lane, sc, sraw);
    { LAS float* pp = part + (wid * 3 + 0) * PST;
#pragma unroll
      for (int hh = 0; hh < 4; ++hh) { if (lane == 0) { pp[hh] = sc.m[hh]; pp[4 + hh] = sc.l[hh]; } pp[8 + hh * 128 + lane] = sc.a0[hh]; pp[8 + hh * 128 + 64 + lane] = sc.a1[hh]; } }
    __syncthreads();
    if (wid < 4) {
        float imp = 0.f;
#pragma unroll
        for (int hh = 0; hh < 4; ++hh) { float M = -INFINITY;
#pragma unroll
            for (int w = 0; w < 4; ++w) M = fmaxf(M, part[(w * 3) * PST + hh]);
            float L = 0.f;
#pragma unroll
            for (int w = 0; w < 4; ++w) L += part[(w * 3) * PST + 4 + hh] * expf(part[(w * 3) * PST + hh] - M);
            imp += expf(sraw[hh] - M) / L; }
        imps[wid * 64 + lane] = imp;
    }
    __syncthreads();
    if (wid < 4) {
        const int j = tid; const float mine = imps[j]; int cnt = 0;
#pragma unroll 2
        for (int jj = 1; jj <= 254; ++jj) { const float o = imps[jj]; cnt += (o > mine || (o == mine && jj < j)) ? 1 : 0; }
        const bool sel = (j == 0) || (j == 255) || (j >= 1 && j <= 254 && cnt < 13);
        const unsigned long long bal = __ballot(sel);
        if (lane == 0) { selw[wid * 2] = (unsigned)bal; selw[wid * 2 + 1] = (unsigned)(bal >> 32); }
    }
    __syncthreads();
    if (wid < 4) {
        const int j = tid; const unsigned lo = selw[wid * 2], hi = selw[wid * 2 + 1];
        const unsigned long long bal = ((unsigned long long)hi << 32) | lo;
        if ((bal >> lane) & 1ull) { int pos = __popcll(bal & ((1ull << lane) - 1ull));
            for (int w = 0; w < wid; ++w) pos += __popc(selw[w * 2]) + __popc(selw[w * 2 + 1]);
            if (pos < 15) selw[8 + pos] = (unsigned)j; }
    }
    __syncthreads();
#pragma unroll 1
    for (int t = wid; t < 25; t += 8) {
        if (t < 15) { const int idx = (int)selw[8 + t];
            const int phys = page_table[s * NPG + (idx >> 1)];
            const float* blk = cache_sel + (((((size_t)phys * NL + l) * NKV + g) * 2 + (idx & 1)) * 64) * 256;
            attn_block(qs, blk + (size_t)lane * 256, blk + 128, 256, 0, 63, lane, ss, sdum);
        } else if (t == 15) { const float* nw = F.out + O_SSEL + (((size_t)s * NL + l) * NKV + g) * 256;
            attn_block(qs, nw, nw + 128, 256, 0, 0, lane, ss, sdum);
        } else if (t < 24) { const int c = t - 16; const float* wb = cache_win + ((((size_t)s * NL + l) * NKV + g) * WIN) * 256;
            attn_block(qs, wb + ((size_t)c * 64 + lane) * 256, wb + (size_t)c * 64 * 256 + 128, 256, 0, 63, lane, sw, sdum);
        } else { const float* nw = F.out + O_SWIN + ((((size_t)s * NL + l) * NKV + g) * WIN + (WIN - 1)) * 256;
            attn_block(qs, nw, nw + 128, 256, 0, 0, lane, sw, sdum); }
    }
    { LAS float* p1 = part + (wid * 3 + 1) * PST; LAS float* p2 = part + (wid * 3 + 2) * PST;
#pragma unroll
      for (int hh = 0; hh < 4; ++hh) { if (lane == 0) { p1[hh] = ss.m[hh]; p1[4 + hh] = ss.l[hh]; p2[hh] = sw.m[hh]; p2[4 + hh] = sw.l[hh]; }
          p1[8 + hh * 128 + lane] = ss.a0[hh]; p1[8 + hh * 128 + 64 + lane] = ss.a1[hh]; p2[8 + hh * 128 + lane] = sw.a0[hh]; p2[8 + hh * 128 + 64 + lane] = sw.a1[hh]; } }
    __syncthreads();
    { const int hh = tid >> 7, d = tid & 127; float res = 0.f;
#pragma unroll
      for (int br = 0; br < 3; ++br) { const int nw = br == 0 ? 4 : 8; float M = -INFINITY;
          for (int w = 0; w < nw; ++w) M = fmaxf(M, part[(w * 3 + br) * PST + hh]);
          float L = 0.f, A = 0.f;
          for (int w = 0; w < nw; ++w) { const float mw = part[(w * 3 + br) * PST + hh]; if (mw == -INFINITY) continue; const float e = expf(mw - M);
              L += part[(w * 3 + br) * PST + 4 + hh] * e; A += part[(w * 3 + br) * PST + 8 + hh * 128 + d] * e; }
          const float gt = GATp[(size_t)r * 24 + (g * 4 + hh) * 3 + br];
          res += L > 0.f ? gt * A / L : 0.f; }
      ((bf16*)(F.ws + WS_OMIX))[(size_t)r * DM + (g * 4 + hh) * 128 + d] = (bf16)f2bf(res); }
    __syncthreads();
}

namespace att {
typedef short s16x4 __attribute__((ext_vector_type(4)));
typedef float f32x16 __attribute__((ext_vector_type(16)));
constexpr int SHM = 16384;
constexpr float SCALE = 0.08838834764831845f, THR = 8.f, C2 = 1.4426950408889634f * SCALE;
#define ATT_KSWZ(row, colB) ((row) * 256 + ((colB) ^ (((row) & 7) << 4)))
#define ATT_SBAR() __builtin_amdgcn_sched_barrier(0)
__device__ __forceinline__ int v_st(int k, int c) { const int kk = (k & ~0xC) | ((k & 4) << 1) | ((k & 8) >> 1); return ((kk >> 3) * 4 + (c >> 5)) * 512 + ((kk & 7) * 32 + (c & 31)) * 2; }
__device__ __forceinline__ int v_rd_base(int lane) { return ((lane & 3) << 3) | (((lane >> 2) & 3) << 6) | (((lane >> 4) & 1) << 5) | (((lane >> 5) & 1) << 8); }
constexpr int v_rd_off(int d0, int ks, int half) { return d0 * 512 + ks * 4096 + half * 2048; }
__device__ __forceinline__ int crow(int r, int hi) { return (r & 3) + 8 * (r >> 2) + 4 * hi; }
__device__ __forceinline__ void partialSM(f32x16& p0, f32x16& p1, float& m_reg, float& mn, float& alpha) {
    float pmax = p0[0];
#pragma unroll
    for (int r = 1; r < 16; ++r) pmax = fmaxf(pmax, p0[r]);
#pragma unroll
    for (int r = 0; r < 16; ++r) pmax = fmaxf(pmax, p1[r]);
    { auto rr = __builtin_amdgcn_permlane32_swap(__float_as_uint(pmax), __float_as_uint(pmax), false, false);
      pmax = fmaxf(__uint_as_float(rr[0]), __uint_as_float(rr[1])); }
    if (__builtin_expect(__all((pmax - m_reg) * SCALE <= THR), 1)) { mn = m_reg; alpha = 1.f; }
    else { mn = fmaxf(m_reg, pmax); alpha = __builtin_amdgcn_exp2f((m_reg - mn) * C2); m_reg = mn; }
    const float mnL = -mn * C2;
#pragma unroll
    for (int r = 0; r < 16; ++r) p0[r] = fmaf(p0[r], C2, mnL);
#pragma unroll
    for (int r = 0; r < 16; ++r) p1[r] = fmaf(p1[r], C2, mnL);
#pragma unroll
    for (int r = 0; r < 16; ++r) p0[r] = __builtin_amdgcn_exp2f(p0[r]);
}
__device__ __forceinline__ void finishSM(f32x16& p0, f32x16& p1, float alpha, float& l_reg, bf16x8& pa0, bf16x8& pa1, bf16x8& pa2, bf16x8& pa3) {
#pragma unroll
    for (int r = 0; r < 16; ++r) p1[r] = __builtin_amdgcn_exp2f(p1[r]);
    float ps = 0;
#pragma unroll
    for (int r = 0; r < 16; ++r) ps += p0[r];
#pragma unroll
    for (int r = 0; r < 16; ++r) ps += p1[r];
    { auto rr = __builtin_amdgcn_permlane32_swap(__float_as_uint(ps), __float_as_uint(ps), false, false);
      ps = __uint_as_float(rr[0]) + __uint_as_float(rr[1]); }
    l_reg = l_reg * alpha + ps;
#define ATT_PK4(P, B_, OUT) do { unsigned a0 = pg8::cvt_pk_bf16(P[B_+0], P[B_+1]), a1 = pg8::cvt_pk_bf16(P[B_+2], P[B_+3]);                          \
        unsigned b0 = pg8::cvt_pk_bf16(P[B_+4], P[B_+5]), b1 = pg8::cvt_pk_bf16(P[B_+6], P[B_+7]);                                             \
        auto r0 = __builtin_amdgcn_permlane32_swap(a0, b0, false, false); auto r1 = __builtin_amdgcn_permlane32_swap(a1, b1, false, false); \
        u32x4 w = {r0[0], r1[0], r0[1], r1[1]}; OUT = __builtin_bit_cast(bf16x8, w); } while (0)
    ATT_PK4(p0, 0, pa0); ATT_PK4(p0, 8, pa1); ATT_PK4(p1, 0, pa2); ATT_PK4(p1, 8, pa3);
#undef ATT_PK4
}
template <bool ZERO>
__device__ __forceinline__ void qkt(f32x16& p0, f32x16& p1, const LAS char* Kb, int r32, int hi, const bf16x8* qr) {
    if (ZERO) { p0 = f32x16{}; p1 = f32x16{}; }
    const LAS char* kb[4];
#pragma unroll
    for (int dd = 0; dd < 4; ++dd) kb[dd] = Kb + ATT_KSWZ(r32, (dd * 16 + hi * 8) * 2);
#pragma unroll
    for (int d0 = 0; d0 < 8; ++d0) { const LAS char* a = kb[d0 & 3] + (d0 >> 2) * 128;
        const bf16x8 b0 = *(const LAS bf16x8*)a;
        const bf16x8 b1 = *(const LAS bf16x8*)(a + 32 * 256);
        p0 = __builtin_amdgcn_mfma_f32_32x32x16_bf16(b0, qr[d0], p0, 0, 0, 0);
        p1 = __builtin_amdgcn_mfma_f32_32x32x16_bf16(b1, qr[d0], p1, 0, 0, 0); }
}
__device__ __forceinline__ void pv_tile(f32x16* o, int vb0, bf16x8 pa0, bf16x8 pa1, bf16x8 pa2, bf16x8 pa3) {
#define ATT_TRRD(dst, off) asm volatile("ds_read_b64_tr_b16 %0, %1 offset:%2" : "=&v"(dst) : "v"(vb0), "i"(off) : "memory")
#define ATT_PV_D0(d0) do { s16x4 l0, l1, l2, l3, h0, h1, h2, h3; constexpr int b_ = v_rd_off(d0, 0, 0); \
        ATT_TRRD(l0, b_); ATT_TRRD(h0, b_ + 2048); ATT_TRRD(l1, b_ + 4096); ATT_TRRD(h1, b_ + 6144); ATT_TRRD(l2, b_ + 8192); ATT_TRRD(h2, b_ + 10240); ATT_TRRD(l3, b_ + 12288); ATT_TRRD(h3, b_ + 14336); \
        asm volatile("s_waitcnt lgkmcnt(0)" ::: "memory"); ATT_SBAR();   \
        o[d0] = __builtin_amdgcn_mfma_f32_32x32x16_bf16(pa0, (bf16x8){l0[0], l0[1], l0[2], l0[3], h0[0], h0[1], h0[2], h0[3]}, o[d0], 0, 0, 0);   \
        o[d0] = __builtin_amdgcn_mfma_f32_32x32x16_bf16(pa1, (bf16x8){l1[0], l1[1], l1[2], l1[3], h1[0], h1[1], h1[2], h1[3]}, o[d0], 0, 0, 0);   \
        o[d0] = __builtin_amdgcn_mfma_f32_32x32x16_bf16(pa2, (bf16x8){l2[0], l2[1], l2[2], l2[3], h2[0], h2[1], h2[2], h2[3]}, o[d0], 0, 0, 0);   \
        o[d0] = __builtin_amdgcn_mfma_f32_32x32x16_bf16(pa3, (bf16x8){l3[0], l3[1], l3[2], l3[3], h3[0], h3[1], h3[2], h3[3]}, o[d0], 0, 0, 0); } while (0)
    ATT_PV_D0(0); ATT_PV_D0(1); ATT_PV_D0(2); ATT_PV_D0(3);
#undef ATT_PV_D0
#undef ATT_TRRD
}
}

__device__ __forceinline__ void phase_nsa_mfma(Frame& F, int l) {
    using namespace att;
    const int tid0 = F.tid, wid = F.wave;
    LAS char* V_lds = (LAS char*)F.lds; LAS char* K_lds = V_lds + SHM; LAS char* K2_lds = V_lds + 3 * SHM;
    LAS float* tbl = (LAS float*)(V_lds + 4 * SHM) + wid * 256; LAS float* al_l = tbl; LAS float* sc_l = tbl + 32;
    LAS unsigned* uni = (LAS unsigned*)(V_lds + 4 * SHM + 8192);
    const float NEG = -__builtin_inff();
#pragma unroll 1
    for (int it = F.bid; it < 256; it += F.G) {
        unsigned char* wsl = F.ws; asm volatile("" : "+s"(wsl));
        const float* QFp = (const float*)(wsl + WS_QF); const float* GATp = (const float*)(wsl + WS_GATES); const float* CBPp = (const float*)(wsl + WS_CBP);
        int tid = tid0; asm volatile("" : "+v"(tid));
        const int lane = tid & 63, r32 = lane & 31, hi = lane >> 5;
        const int sr = tid >> 4, sc = (tid & 15) * 8, vst0 = v_st(sr, sc), vst1 = v_st(32 + sr, sc), kws = ATT_KSWZ(sr, sc * 2);
        const int vb0 = (int)(unsigned)(size_t)V_lds + v_rd_base(lane);
        const int xc = it & 7, b = xc >> 1, g = xc & 1, qb = it >> 3;
        const int q0 = qb * 64;
        const int rho = wid * 32 + r32, qi = rho >> 2, hh = rho & 3, trow = b * SEQ + q0 + qi, tq = q0 + qi;
        const unsigned kvoff = (unsigned)((b * NKV + g) * SEQ * HD);
        __syncthreads();
        if (tid == 0) uni[0] = 0u;
        bf16x8 qr[8];
        f32x16 o[4];
        f32x4* ata = (f32x4*)(wsl + WS_ATA) + ((size_t)(it * 8 + wid) * 16) * 64 + lane;
        float m_reg = -1e30f, l_reg = 0.f, mn, alpha;
        f32x16 p0, p1; bf16x8 pa0, pa1, pa2, pa3;
        unsigned selmask;
        {
            bf16x8 ql[8];
            const float* qp = QFp + ((size_t)trow * 8 + g * 4 + hh) * 128 + hi * 8;
#pragma unroll
            for (int d0 = 0; d0 < 8; ++d0) { const f32x4 a = *(const f32x4*)(qp + d0 * 16), c = *(const f32x4*)(qp + d0 * 16 + 4);
                qr[d0] = pack8(a, c); const u32x4 u = __builtin_bit_cast(u32x4, qr[d0]);
                f32x4 ra, rc; ra.x = a.x - __uint_as_float(u.x << 16); ra.y = a.y - __uint_as_float(u.x & 0xffff0000u); ra.z = a.z - __uint_as_float(u.y << 16); ra.w = a.w - __uint_as_float(u.y & 0xffff0000u);
                rc.x = c.x - __uint_as_float(u.z << 16); rc.y = c.y - __uint_as_float(u.z & 0xffff0000u); rc.z = c.z - __uint_as_float(u.w << 16); rc.w = c.w - __uint_as_float(u.w & 0xffff0000u);
                ql[d0] = pack8(ra, rc); }
            { const float* kr = CBPp + ((size_t)(b * 32 + sr) * 2 + g) * 128 + sc; const float* vr = kr + (size_t)256 * 128;
              const f32x4 a = *(const f32x4*)kr, c = *(const f32x4*)(kr + 4); const bf16x8 kh = pack8(a, c); const u32x4 u = __builtin_bit_cast(u32x4, kh);
              f32x4 ra, rc; ra.x = a.x - __uint_as_float(u.x << 16); ra.y = a.y - __uint_as_float(u.x & 0xffff0000u); ra.z = a.z - __uint_as_float(u.y << 16); ra.w = a.w - __uint_as_float(u.y & 0xffff0000u);
              rc.x = c.x - __uint_as_float(u.z << 16); rc.y = c.y - __uint_as_float(u.z & 0xffff0000u); rc.z = c.z - __uint_as_float(u.w << 16); rc.w = c.w - __uint_as_float(u.w & 0xffff0000u);
              unsigned zr; asm volatile("v_mov_b32 %0, 0" : "=v"(zr)); u32x4 z4u; z4u.x = zr; z4u.y = zr; z4u.z = zr; z4u.w = zr;
              const bf16x8 z8 = __builtin_bit_cast(bf16x8, z4u);
              *(LAS bf16x8*)(K_lds + kws) = kh; *(LAS bf16x8*)(K_lds + kws + 32 * 256) = z8;
              *(LAS bf16x8*)(K2_lds + kws) = pack8(ra, rc); *(LAS bf16x8*)(K2_lds + kws + 32 * 256) = z8;
              *(LAS bf16x8*)(V_lds + vst0) = pack8(*(const f32x4*)vr, *(const f32x4*)(vr + 4)); *(LAS bf16x8*)(V_lds + vst1) = z8; }
            __syncthreads();
            qkt<true>(p0, p1, K_lds, r32, hi, qr); qkt<false>(p0, p1, K_lds, r32, hi, ql); qkt<false>(p0, p1, K2_lds, r32, hi, qr);
            const int nvis = (tq + 1) >> 6;
#pragma unroll
            for (int r = 0; r < 16; ++r) { if (crow(r, hi) >= nvis) p0[r] = NEG; p1[r] = NEG; }
            partialSM(p0, p1, m_reg, mn, alpha); finishSM(p0, p1, alpha, l_reg, pa0, pa1, pa2, pa3);
            const int cur = qb;
            if (cur < 16) selmask = (2u << cur) - 1u;
            else {
                const float inv = l_reg > 0.f ? 1.0f / l_reg : 0.f;
                float il[16], ih[16];
#pragma unroll
                for (int r = 0; r < 16; ++r) { float v = p0[r] * inv; v += __shfl_xor(v, 1); v += __shfl_xor(v, 2);
                    const int kj = crow(r, hi); if (kj < 1 || kj > cur - 2) v = -1.f;
                    auto rr = __builtin_amdgcn_permlane32_swap(__float_as_uint(v), __float_as_uint(v), false, false); il[r] = __uint_as_float(rr[0]); ih[r] = __uint_as_float(rr[1]); }
                unsigned part = 0u;
#pragma unroll
                for (int r = 0; r < 16; ++r) { const int kj = crow(r, hi); const float mine = hi ? ih[r] : il[r]; int cnt = 0;
#pragma unroll
                    for (int r2 = 0; r2 < 16; ++r2) { const int j0 = crow(r2, 0), j1 = crow(r2, 1);
                        cnt += (il[r2] > mine || (il[r2] == mine && j0 < kj)) ? 1 : 0; cnt += (ih[r2] > mine || (ih[r2] == mine && j1 < kj)) ? 1 : 0; }
                    const bool sel = (kj == 0) || (kj == cur) || (kj == cur - 1) || (mine >= 0.f && cnt < 13);
                    part |= sel ? (1u << kj) : 0u; }
                auto rr = __builtin_amdgcn_permlane32_swap(part, part, false, false); selmask = rr[0] | rr[1];
            }
            unsigned wu = selmask;
#pragma unroll
            for (int ofs = 1; ofs < 32; ofs <<= 1) wu |= (unsigned)__shfl_xor((int)wu, ofs);
            if (lane == 0) atomicOr((unsigned*)uni, wu);
            asm volatile("" ::: "memory");
#pragma unroll
            for (int d = 0; d < 4; ++d) o[d] = f32x16{};
            pv_tile(o, vb0, pa0, pa1, pa2, pa3);
            if (hi == 0) sc_l[r32] = l_reg > 0.f ? GATp[(size_t)trow * 24 + (g * 4 + hh) * 3 + 0] / l_reg : 0.f;
            asm volatile("s_waitcnt lgkmcnt(0)" ::: "memory");
#pragma unroll
            for (int d = 0; d < 4; ++d)
#pragma unroll
                for (int r4 = 0; r4 < 4; ++r4) { f32x4 v;
#pragma unroll
                    for (int e = 0; e < 4; ++e) { v[e] = o[d][r4 * 4 + e] * sc_l[crow(r4 * 4 + e, hi)]; o[d][r4 * 4 + e] = 0.f; }
                    ata[(d * 4 + r4) * 64] = v; }
            m_reg = -1e30f; l_reg = 0.f;
        }
        __syncthreads();
        const unsigned un = uni[0];
        const unsigned wun = (unsigned)__builtin_amdgcn_readfirstlane((int)({ unsigned w_ = selmask;
#pragma unroll
            for (int ofs = 1; ofs < 32; ofs <<= 1) w_ |= (unsigned)__shfl_xor((int)w_, ofs); w_; }));
#pragma unroll 1
        for (int br = 1; br <= 2; ++br) {
            const bf16* Kp = (const bf16*)(wsl + (br == 1 ? WS_KSB : WS_KWB)) + kvoff; const bf16* Vp = (const bf16*)(wsl + (br == 1 ? WS_VSB : WS_VWB)) + kvoff;
            unsigned tiles = br == 1 ? (un & ((2u << qb) - 1u)) : ((2u << qb) - 1u) & ~((qb >= 9) ? ((1u << (qb - 8)) - 1u) : 0u);
            bf16x8 st_k0, st_k1, st_v0, st_v1;
#define ATT_LOAD(jt) do { const size_t ro = (size_t)((jt) * 64 + sr) * HD + sc; st_k0 = *(const bf16x8*)(Kp + ro); st_k1 = *(const bf16x8*)(Kp + ro + 32 * HD); st_v0 = *(const bf16x8*)(Vp + ro); st_v1 = *(const bf16x8*)(Vp + ro + 32 * HD); } while (0)
#define ATT_WRITE(bo) do { *(LAS bf16x8*)(K_lds + (bo) + kws) = st_k0; *(LAS bf16x8*)(K_lds + (bo) + kws + 32 * 256) = st_k1; *(LAS bf16x8*)(V_lds + (bo) + vst0) = st_v0; *(LAS bf16x8*)(V_lds + (bo) + vst1) = st_v1; } while (0)
            int j = __builtin_ctz(tiles); tiles &= tiles - 1u;
            ATT_LOAD(j);
            __syncthreads();
            ATT_WRITE(0);
            int jn = tiles ? __builtin_ctz(tiles) : -1;
            if (jn >= 0) ATT_LOAD(jn);
            __syncthreads();
            int cur = 0;
#pragma unroll 1
            while (true) {
                const bool act = br == 2 || ((wun >> j) & 1u);
                if (act) {
                    qkt<true>(p0, p1, K_lds + cur, r32, hi, qr);
                    if (br == 1) {
                        if (!((selmask >> j) & 1u)) {
#pragma unroll
                            for (int r = 0; r < 16; ++r) { p0[r] = NEG; p1[r] = NEG; } }
                        if (j == qb) {
#pragma unroll
                            for (int r = 0; r < 16; ++r) { if (crow(r, hi) > qi) p0[r] = NEG; if (crow(r, hi) + 32 > qi) p1[r] = NEG; } }
                    } else if (j == qb || j == qb - 8) {
                        const int dq = tq - j * 64;
#pragma unroll
                        for (int r = 0; r < 16; ++r) { if ((unsigned)(dq - crow(r, hi)) > 512u) p0[r] = NEG; if ((unsigned)(dq - crow(r, hi) - 32) > 512u) p1[r] = NEG; }
                    }
                    partialSM(p0, p1, m_reg, mn, alpha); finishSM(p0, p1, alpha, l_reg, pa0, pa1, pa2, pa3);
                    if (__any(alpha < 1.f)) { if (hi == 0) al_l[r32] = alpha; asm volatile("s_waitcnt lgkmcnt(0)" ::: "memory");
#pragma unroll
                        for (int d = 0; d < 4; ++d)
#pragma unroll
                            for (int r = 0; r < 16; ++r) o[d][r] *= al_l[crow(r, hi)]; }
                    pv_tile(o, vb0 + cur, pa0, pa1, pa2, pa3);
                }
                if (jn < 0) break;
                ATT_WRITE(cur ^ 32768);
                j = jn; tiles &= tiles - 1u; jn = tiles ? __builtin_ctz(tiles) : -1;
                if (jn >= 0) ATT_LOAD(jn);
                __syncthreads();
                cur ^= 32768;
            }
#undef ATT_LOAD
#undef ATT_WRITE
            if (hi == 0) sc_l[r32] = l_reg > 0.f ? GATp[(size_t)trow * 24 + (g * 4 + hh) * 3 + br] / l_reg : 0.f;
            asm volatile("s_waitcnt lgkmcnt(0)" ::: "memory");
#pragma unroll
            for (int d = 0; d < 4; ++d)
#pragma unroll
                for (int r4 = 0; r4 < 4; ++r4) { f32x4 v = ata[(d * 4 + r4) * 64];
#pragma unroll
                    for (int e = 0; e < 4; ++e) { v[e] += o[d][r4 * 4 + e] * sc_l[crow(r4 * 4 + e, hi)]; o[d][r4 * 4 + e] = v[e]; }
                    if (br == 1) { ata[(d * 4 + r4) * 64] = v;
#pragma unroll
                        for (int e = 0; e < 4; ++e) o[d][r4 * 4 + e] = 0.f; } }
            m_reg = -1e30f; l_reg = 0.f;
        }
        bf16* OM = (bf16*)(wsl + WS_OMIX);
#pragma unroll
        for (int r = 0; r < 16; ++r) { const int rw = wid * 32 + crow(r, hi); bf16* op = OM + (size_t)(b * SEQ + q0 + (rw >> 2)) * DM + (g * 4 + (rw & 3)) * 128;
#pragma unroll
            for (int d = 0; d < 4; ++d) { const float v = o[d][r]; const float vn = __shfl_xor(v, 1);
                if ((r32 & 1) == 0) *(unsigned*)(op + d * 32 + r32) = pg8::cvt_pk_bf16(v, vn); } }
    }
    __syncthreads();
}

__device__ __forceinline__ void phase_resid(Frame& F, int l, int which  ) {
    const int lane = F.lane, gw = F.bid * NWAVES + F.wave, NGW = F.G * NWAVES;
    const float* gpost = (which == 0 ? ((const float*)F.in[22]) : ((const float*)F.in[27])) + l * DM;
    for (int r = gw; r < MT; r += NGW) {
        const float* md = ((float*)(F.ws + WS_MOD)) + ((size_t)l * 12 + modrow(r)) * 12288;
        const float* ga = md + (which == 0 ? 4096 : 10240);
        const f32x4* xr = (const f32x4*)((which == 0) ? xrow_in(F, l, r) : ((float*)(F.ws + WS_X)) + (size_t)r * DM) + lane;
        const u32x2* mr = (const u32x2*)(((const bf16*)(F.ws + WS_MIX)) + (size_t)r * DM) + lane;
        f32x4 v[8], m[8]; float ss = 0.f;
#pragma unroll
        for (int j = 0; j < 8; ++j) { v[j] = xr[64 * j]; const u32x2 mb = mr[64 * j]; m[j] = (f32x4){__uint_as_float(mb.x << 16), __uint_as_float(mb.x & 0xffff0000u), __uint_as_float(mb.y << 16), __uint_as_float(mb.y & 0xffff0000u)}; ss += (m[j].x * m[j].x + m[j].y * m[j].y) + (m[j].z * m[j].z + m[j].w * m[j].w); }
        ss = wave_sum(ss);
        const float rs = 1.0f / sqrtf(ss * (1.0f / DM) + EPS);
#pragma unroll
        for (int j = 0; j < 8; ++j) { const int c = (lane + 64 * j) * 4; v[j] = v[j] + *(const f32x4*)(ga + c) * (m[j] * rs * *(const f32x4*)(gpost + c)); }
        if (which == 1 && l == NL - 1) {
            f32x4* o = (f32x4*)(r < MP ? F.out + O_YP + (size_t)r * DM : F.out + O_YS + (size_t)(r - MP) * DM) + lane;
#pragma unroll
            for (int j = 0; j < 8; ++j) o[64 * j] = v[j];
        } else {
            f32x4* xo = (f32x4*)(((float*)(F.ws + WS_X)) + (size_t)r * DM) + lane;
#pragma unroll
            for (int j = 0; j < 8; ++j) xo[64 * j] = v[j];
            if (which == 0) norm_mod_store(v, ((const float*)F.in[23]) + l * DM, md + 6144, md + 8192, ((bf16*)(F.ws + WS_H)) + (size_t)r * DM, lane);
            else { const float* md2 = ((float*)(F.ws + WS_MOD)) + ((size_t)(l + 1) * 12 + modrow(r)) * 12288; norm_mod_store(v, ((const float*)F.in[12]) + (l + 1) * DM, md2, md2 + 2048, ((bf16*)(F.ws + WS_H)) + (size_t)r * DM, lane); }
        }
    }
}

constexpr int PH_LAYER0 = 3, PH_PER_LAYER = 10, NPHASE = PH_LAYER0 + NL * PH_PER_LAYER;
#ifndef PHMASK
#define PHMASK 0xFFFFFFFFu
#endif
#define EN(b) (((PHMASK) >> (b)) & 1u)
#ifndef REP_MASK
#define REP_MASK 0u
#endif
#ifndef REP_N
#define REP_N 3
#endif
#define REPS(b, on) (((((REP_MASK) >> (b)) & 1u) && (on)) ? 1 + (REP_N) : 1)
#define IN(k) (lo <= (k) && (k) < hi)
#define SEAM(k) do { if (IN(k) && IN((k) + 1)) xcd_barrier(bar); } while (0)
template <int l>
__device__ __forceinline__ void layer_phases(Frame& F, const int lo, const int hi, const XcdBarrier& bar) {

        const int p0 = PH_LAYER0 + l * PH_PER_LAYER;
        if (EN(3) && IN(p0 + 0)) for (int rep = 0; rep < REPS(3, l == 0); ++rep, ((REP_MASK) ? __syncthreads() : (void)0)) {
            if constexpr (l == 0) { if (F.bid & 1) phase_cmp_direct(F); }
            pg8::Gemm g{((bf16*)(F.ws + WS_H)), ((bf16*)(F.ws + WS_WIN)) + (size_t)l * NIN * DM, DM, DM}; pg8::StaticOrder S; S.init(MP, NIN, F.G, F.bid); pg8::EpiF32 E{((float*)(F.ws + WS_PROJ)), NIN};
            pg8::gemm_phase<pg8::EpiF32, pg8::StaticOrder, true, true>(F.lds, g, S, E);
            if (F.bid >= 96)
                skinny_wave<0, 64>(F, ((bf16*)(F.ws + WS_H)) + (size_t)MP * DM, DM, ((bf16*)(F.ws + WS_WIN)) + (size_t)l * NIN * DM, DM, NIN / 16, ((float*)(F.ws + WS_PROJ)), nullptr, NIN, (F.bid - 96) * NWAVES + F.wave, 160 * NWAVES);
            __syncthreads();
            if (l == 0) { if (F.bid >= 224) tr_range(F, TR_I_L + TR_I_IN, TR_I_OUT, (F.bid - 224) * NWAVES + F.wave, 32 * NWAVES);
                          else if (F.bid >= 96) tr_range(F, TR_I_L, TR_I_IN, (F.bid - 96) * NWAVES + F.wave, 128 * NWAVES); }
            else { if (F.bid >= 96) tr_range(F, TR_I_L + TR_I_IN + TR_I_OUT + TR_I_GU, TR_I_DN, (F.bid - 96) * NWAVES + F.wave, 160 * NWAVES); }
            if constexpr (l == 0) { if (!(F.bid & 1)) phase_cmp_direct(F); }
        }
        SEAM(p0 + 0);
        if (EN(4) && IN(p0 + 1)) for (int rep = 0; rep < REPS(4, l == 0); ++rep, ((REP_MASK) ? __syncthreads() : (void)0)) { phase_postproj(F, l); }
        SEAM(p0 + 1);
        if (EN(5) && IN(p0 + 2)) for (int rep = 0; rep < REPS(5, l == 0); ++rep, ((REP_MASK) ? __syncthreads() : (void)0)) {
            pg8::Gemm g{((bf16*)(F.ws + WS_AP)), ((bf16*)(F.ws + WS_W1)) + (size_t)l * 2 * 256 * 8192, 256, 8192}; pg8::SplitOrder S{64, F.G, F.bid, 32, 1}; pg8::EpiPart E{((float*)(F.ws + WS_HIDP)), (size_t)512 * 256};
            pg8::gemm_phase<pg8::EpiPart, pg8::SplitOrder, true, true>(F.lds, g, S, E);
#ifndef NO_SCAN
            phase_gdn_scan_naive(F, l);
#endif
            phase_gdn_pre(F, l);
        }
        SEAM(p0 + 2);
        if (EN(6) && IN(p0 + 3)) for (int rep = 0; rep < REPS(6, l == 0); ++rep, ((REP_MASK) ? __syncthreads() : (void)0)) { cmp_finish<32>(F, ((float*)(F.ws + WS_HIDP)), (size_t)512 * 256, 512, 256, ((const float*)F.in[16]) + (size_t)l * 2 * 32768, ((float*)(F.ws + WS_CBP)), 64);
            cmp_finish16<4>(F, ((float*)(F.ws + WS_HIDS)), (size_t)16384 * 256, 8192, 4096, ((const float*)F.in[16]), ((float*)(F.ws + WS_CBS)), 64, l * 8192, ((const float*)(F.ws + WS_PEC)));
            phase_gdn_scan(F, l); }
        SEAM(p0 + 3);
        if (EN(7) && IN(p0 + 4)) for (int rep = 0; rep < REPS(7, l == 0); ++rep, ((REP_MASK) ? __syncthreads() : (void)0)) { phase_nsa_mfma(F, l); phase_nsa_sample(F, l); phase_gdn_out(F, l); }
        SEAM(p0 + 4);
        if (EN(8) && IN(p0 + 5)) for (int rep = 0; rep < REPS(8, l == 0); ++rep, ((REP_MASK) ? __syncthreads() : (void)0)) {
            pg8::Gemm g{((bf16*)(F.ws + WS_OMIX)), ((bf16*)(F.ws + WS_WOUT)) + (size_t)l * DM * DM, DM, DM}; pg8::StaticOrder S; S.init(MP, DM, F.G, F.bid); pg8::EpiBf16 E{((bf16*)(F.ws + WS_MIX)), DM};
            pg8::gemm_phase<pg8::EpiBf16, pg8::StaticOrder, true, true>(F.lds, g, S, E);
            skinny_gemm<2, 8>(F, ((bf16*)(F.ws + WS_OMIX)) + (size_t)MP * DM, DM, ((bf16*)(F.ws + WS_WOUT)) + (size_t)l * DM * DM, DM, DM / 16, nullptr, ((bf16*)(F.ws + WS_MIX)), DM);
        }
        SEAM(p0 + 5);
        if (EN(9) && IN(p0 + 6)) for (int rep = 0; rep < REPS(9, l == 0); ++rep, ((REP_MASK) ? __syncthreads() : (void)0)) { phase_resid(F, l, 0); }
        SEAM(p0 + 6);
        if (EN(10) && IN(p0 + 7)) for (int rep = 0; rep < REPS(10, l == 0); ++rep, ((REP_MASK) ? __syncthreads() : (void)0)) {
            pg8::Gemm g{((bf16*)(F.ws + WS_H)), ((bf16*)(F.ws + WS_WGU)) + (size_t)l * NGU * DM, DM, DM}; pg8::StaticOrder S; S.init(MP, NGU, F.G, F.bid); pg8::EpiSwiGLU E{((bf16*)(F.ws + WS_ACT)), DFF};
            pg8::gemm_phase<pg8::EpiSwiGLU, pg8::StaticOrder, true, true>(F.lds, g, S, E);
            if (F.bid >= 128)
                skinny_wave<1, 64>(F, ((bf16*)(F.ws + WS_H)) + (size_t)MP * DM, DM, ((bf16*)(F.ws + WS_WGU)) + (size_t)l * NGU * DM, DM, DFF / 16, nullptr, ((bf16*)(F.ws + WS_ACT)), DFF, (F.bid - 128) * NWAVES + F.wave, 128 * NWAVES);
            __syncthreads();
            if (l == 0 && F.bid >= 128) tr_range(F, TR_I_L + TR_I_IN + TR_I_OUT, TR_I_GU, (F.bid - 128) * NWAVES + F.wave, 128 * NWAVES);
        }
        SEAM(p0 + 7);
        if (EN(11) && IN(p0 + 8)) for (int rep = 0; rep < REPS(11, l == 0); ++rep, ((REP_MASK) ? __syncthreads() : (void)0)) {
            pg8::Gemm g{((bf16*)(F.ws + WS_ACT)), ((bf16*)(F.ws + WS_WDN)) + (size_t)l * DM * DFF, DFF, DFF}; pg8::StaticOrder S; S.init(MP, DM, F.G, F.bid); pg8::EpiBf16 E{((bf16*)(F.ws + WS_MIX)), DM};
            pg8::gemm_phase<pg8::EpiBf16, pg8::StaticOrder, true, true>(F.lds, g, S, E);
            skinny_gemm<2, 22>(F, ((bf16*)(F.ws + WS_ACT)) + (size_t)MP * DFF, DFF, ((bf16*)(F.ws + WS_WDN)) + (size_t)l * DM * DFF, DFF, DM / 16, nullptr, ((bf16*)(F.ws + WS_MIX)), DM);
        }
        SEAM(p0 + 8);
        if (EN(12) && IN(p0 + 9)) for (int rep = 0; rep < REPS(12, l == 0); ++rep, ((REP_MASK) ? __syncthreads() : (void)0)) { phase_resid(F, l, 1); }
        SEAM(p0 + 9);
    }

__global__ void __launch_bounds__(NTHR, 2) mega(Args args) {
    extern __shared__ __attribute__((aligned(16))) unsigned char lds_raw[];
    Frame F;
    F.lds = (LAS unsigned char*)lds_raw;
    F.tid = threadIdx.x; F.lane = F.tid & 63; F.wave = __builtin_amdgcn_readfirstlane(F.tid >> 6); F.G = gridDim.x; F.bid = blockIdx.x;
    F.in = args.in; F.out = args.out; F.ws = args.ws;
    unsigned char* ws = args.ws;
    volatile LAS unsigned* MISC = (volatile LAS unsigned*)(F.lds + MISC_OFF);
    if (F.tid < 16) MISC[F.tid] = 0u;
    __syncthreads();
    const int lo = args.ph_lo, hi = args.ph_hi;
    unsigned* barw = (unsigned*)(ws + WS_CTL) + CW_BAR;
    XcdBarrier bar; bar.bar = barw; bar.x = 0; bar.st = MISC + 8;
    if (hi - lo > 1) bar = xcd_barrier_post(barw, MISC + 8);

    if (EN(0) && IN(0)) for (int rep = 0; rep < REPS(0, true); ++rep, ((REP_MASK) ? __syncthreads() : (void)0)) { phase_prologue(F); }
    SEAM(0);
    if (EN(1) && IN(1)) for (int rep = 0; rep < REPS(1, true); ++rep, ((REP_MASK) ? __syncthreads() : (void)0)) {
        ada_reduce(F);
    }
    SEAM(1);
    if (EN(2) && IN(2)) for (int rep = 0; rep < REPS(2, true); ++rep, ((REP_MASK) ? __syncthreads() : (void)0)) { phase_norm1(F, 0); pe_w1(F); }
    SEAM(2);
    layer_phases<0>(F, lo, hi, bar);
    layer_phases<1>(F, lo, hi, bar);
#undef IN
#undef SEAM
}

extern "C" void kernel_launch(void* const* d_in, const int* in_sizes, int n_in, void* d_out, int out_size, void* d_ws, size_t ws_size, hipStream_t stream) {
    static int grid = 0;
    if (grid == 0) {
        if (n_in != 28 || (size_t)out_size != O_END || ws_size < WS_END) { fprintf(stderr, "kernel_launch: unexpected shapes: n_in %d out %d (want %zu) ws %zu (want %zu)\n", n_in, out_size, (size_t)O_END, ws_size, (size_t)WS_END); grid = -1; return; }
        int dev = 0, cus = 0, per_cu = 0;
        if (hipGetDevice(&dev) != hipSuccess || hipDeviceGetAttribute(&cus, hipDeviceAttributeMultiprocessorCount, dev) != hipSuccess) { grid = -1; return; }
        if (hipFuncSetAttribute((const void*)mega, hipFuncAttributeMaxDynamicSharedMemorySize, LDS_BYTES) != hipSuccess) { fprintf(stderr, "kernel_launch: hipFuncSetAttribute failed\n"); grid = -1; return; }
        if (hipOccupancyMaxActiveBlocksPerMultiprocessor(&per_cu, (const void*)mega, NTHR, LDS_BYTES) != hipSuccess || per_cu < 1) fprintf(stderr, "kernel_launch: occupancy query reports %d\n", per_cu);
        (void)hipGetLastError();
        grid = cus;
    }
    if (grid < 0) return;
    if (hipMemsetAsync((char*)d_ws + WS_CTL, 0, CTL_BYTES, stream) != hipSuccess) return;
    Args a{};
    for (int i = 0; i < 28; ++i) a.in[i] = d_in[i];
    a.out = (float*)d_out; a.ws = (unsigned char*)d_ws;
#if ONE_LAUNCH
    a.ph_lo = 0; a.ph_hi = NPHASE;
    hipLaunchKernelGGL(mega, dim3(grid), dim3(NTHR), LDS_BYTES, stream, a);
#else
    for (int p = 0; p < NPHASE; ++p) { a.ph_lo = p; a.ph_hi = p + 1; hipLaunchKernelGGL(mega, dim3(grid), dim3(NTHR), LDS_BYTES, stream, a); }
#endif
}
```

```cpp
#include <hip/hip_runtime.h>
#include <cstdio>
#include <cstdint>

#ifndef ONE_LAUNCH
#define ONE_LAUNCH 1
#endif

#define LAS __attribute__((address_space(3)))
typedef unsigned short bf16;
typedef unsigned u32x4 __attribute__((ext_vector_type(4)));
typedef unsigned u32x2 __attribute__((ext_vector_type(2)));
typedef float f32x4 __attribute__((ext_vector_type(4)));
typedef float f32x2 __attribute__((ext_vector_type(2)));
typedef short bf16x8 __attribute__((ext_vector_type(8)));

namespace pg8 {
#define PG8_LAS __attribute__((address_space(3)))
typedef unsigned short bf16_t;
constexpr int BM = 256, BK = 64, HALF = 128, HTB = HALF * BK * 2  , STAGE_BYTES = 8 * HTB, NXCD = 8, WGM = 8;

__host__ __device__ __forceinline__ int lds_byte(int r, int c) { const int st = (r >> 4) * 2 + (c >> 5), rr = r & 15, cc = c & 31, ob = rr * 64 + cc * 2; return st * 1024 + (ob ^ (((ob >> 9) & 1) << 5)); }
__host__ __device__ __forceinline__ void stage_rc(int b, int& R, int& C) { const int st = b / 1024, sb = b % 1024, swz = sb ^ (((sb >> 9) & 1) << 5); R = (st >> 1) * 16 + swz / 64; C = (st & 1) * 32 + (swz % 64) / 2; }
__host__ __device__ __forceinline__ int perm32(int rho) { const int n = rho >> 4, i = rho & 15; return 8 * (i >> 2) + 4 * n + (i & 3); }

struct Unit { int pm, pn, pk; };
struct Gemm { const bf16_t* A; const bf16_t* Bt; int K; int ld; };

struct StaticOrder {
    int nM, nN, nwg, G, c;
    __host__ __device__ void init(int M, int N, int G_, int c_) { nM = M / BM; nN = N / BM; nwg = nM * nN; G = G_; c = c_; }
    __host__ __device__ bool next(int i, Unit& u) const {
        const long L = (long)i * G + c; if (L >= nwg) return false;
        int wgid = (int)L; { const int q = nwg / NXCD, r = nwg % NXCD, xcd = wgid % NXCD, off = wgid / NXCD; wgid = (xcd < r ? xcd * (q + 1) : r * (q + 1) + (xcd - r) * q) + off; }
        const int nig = WGM * nN, gid = wgid / nig, fm = gid * WGM, gsz = (nM - fm) < WGM ? (nM - fm) : WGM;
        u.pm = fm + ((wgid % nig) % gsz); u.pn = (wgid % nig) / gsz; u.pk = 0; return true;
    }
    __device__ __forceinline__ void a_ready(const Unit&) const {}
    __device__ __forceinline__ void done(const Unit&) const {}
};
struct OneUnit {
    int L, nsplit, pn_div;
    __host__ __device__ bool next(int i, Unit& u) const { if (i != 0 || L < 0) return false; u.pk = L % nsplit; u.pm = L / nsplit; u.pn = u.pm / pn_div; return true; }
    __device__ __forceinline__ void a_ready(const Unit&) const {}
    __device__ __forceinline__ void done(const Unit&) const {}
};
struct SplitOrder {
    int nU, G, c, nsplit, pn_div;
    __host__ __device__ bool next(int i, Unit& u) const {
        const long L = (long)i * G + c; if (L >= nU) return false;
        u.pk = (int)(L % nsplit); u.pm = (int)(L / nsplit); u.pn = u.pm / pn_div; return true;
    }
    __device__ __forceinline__ void a_ready(const Unit&) const {}
    __device__ __forceinline__ void done(const Unit&) const {}
};

typedef __bf16 bf16x2_v __attribute__((ext_vector_type(2)));
__device__ __forceinline__ unsigned cvt_pk_bf16(float lo, float hi) { const f32x2 v = {lo, hi}; return __builtin_bit_cast(unsigned, __builtin_convertvector(v, bf16x2_v)); }

struct EpiF32 {
    static constexpr bool PERM = false, AFTER_DRAIN = false;
    float* C; int ldc;
    __device__ __forceinline__ void operator()(const f32x4 (&acc)[2][2][4][2], const Unit& u, int wr, int wc, int fr, int fq) const {
        const int row0 = u.pm * BM + wr * 64 + fr, col0 = u.pn * BM + wc * 32 + 4 * fq;
#pragma unroll
        for (int ai = 0; ai < 2; ++ai)
#pragma unroll
            for (int m = 0; m < 4; ++m) { float* rowp = C + (size_t)(row0 + ai * HALF + m * 16) * ldc + col0;
#pragma unroll
                for (int bj = 0; bj < 2; ++bj)
#pragma unroll
                    for (int n = 0; n < 2; ++n) *(f32x4*)(rowp + bj * HALF + n * 16) = acc[ai][bj][m][n]; }
    }
    __device__ __forceinline__ void fused(f32x4 (&)[2][2][4][2], const Unit&, int, int, int, int, PG8_LAS unsigned char*, int, int) const {}
};
struct EpiBf16 {
    static constexpr bool PERM = true, AFTER_DRAIN = false;
    bf16_t* O; int ldc;
    __device__ __forceinline__ void operator()(const f32x4 (&acc)[2][2][4][2], const Unit& u, int wr, int wc, int fr, int fq) const {
        const int row0 = u.pm * BM + wr * 64 + fr, col0 = u.pn * BM + wc * 32 + 8 * fq;
#pragma unroll
        for (int ai = 0; ai < 2; ++ai)
#pragma unroll
            for (int m = 0; m < 4; ++m) { bf16_t* rowp = O + (size_t)(row0 + ai * HALF + m * 16) * ldc + col0;
#pragma unroll
                for (int bj = 0; bj < 2; ++bj) { const f32x4 v0 = acc[ai][bj][m][0], v1 = acc[ai][bj][m][1];
                    u32x4 w; w.x = cvt_pk_bf16(v0[0], v0[1]); w.y = cvt_pk_bf16(v0[2], v0[3]); w.z = cvt_pk_bf16(v1[0], v1[1]); w.w = cvt_pk_bf16(v1[2], v1[3]);
                    *(u32x4*)(rowp + bj * HALF) = w; } }
    }
    __device__ __forceinline__ void fused(f32x4 (&)[2][2][4][2], const Unit&, int, int, int, int, PG8_LAS unsigned char*, int, int) const {}
};
struct EpiPart {
    static constexpr bool PERM = false, AFTER_DRAIN = false;
    float* C; size_t slab;
    __device__ __forceinline__ void operator()(const f32x4 (&acc)[2][2][4][2], const Unit& u, int wr, int wc, int fr, int fq) const {
        const int row0 = u.pm * BM + wr * 64 + fr, col0 = wc * 32 + 4 * fq;
        float* base = C + (size_t)u.pk * slab;
#pragma unroll
        for (int ai = 0; ai < 2; ++ai)
#pragma unroll
            for (int m = 0; m < 4; ++m) { float* rowp = base + (size_t)(row0 + ai * HALF + m * 16) * 256 + col0;
#pragma unroll
                for (int bj = 0; bj < 2; ++bj)
#pragma unroll
                    for (int n = 0; n < 2; ++n) *(f32x4*)(rowp + bj * HALF + n * 16) = acc[ai][bj][m][n]; }
    }
    __device__ __forceinline__ void fused(f32x4 (&)[2][2][4][2], const Unit&, int, int, int, int, PG8_LAS unsigned char*, int, int) const {}
};
struct EpiSwiGLU {
    static constexpr bool PERM = true, AFTER_DRAIN = false;
    bf16_t* O; int ldc;
    __device__ __forceinline__ void operator()(const f32x4 (&acc)[2][2][4][2], const Unit& u, int wr, int wc, int fr, int fq) const {
        const int row0 = u.pm * BM + wr * 64 + fr, col0 = u.pn * HALF + wc * 32 + 8 * fq;
#pragma unroll
        for (int ai = 0; ai < 2; ++ai)
#pragma unroll
            for (int m = 0; m < 4; ++m) { bf16_t* rowp = O + (size_t)(row0 + ai * HALF + m * 16) * ldc + col0;
                float o[8];
#pragma unroll
                for (int n = 0; n < 2; ++n)
#pragma unroll
                    for (int j = 0; j < 4; ++j) { const float g = acc[ai][0][m][n][j], up = acc[ai][1][m][n][j]; o[n * 4 + j] = g / (1.0f + __expf(-g)) * up; }
                u32x4 w; w.x = cvt_pk_bf16(o[0], o[1]); w.y = cvt_pk_bf16(o[2], o[3]); w.z = cvt_pk_bf16(o[4], o[5]); w.w = cvt_pk_bf16(o[6], o[7]);
                *(u32x4*)rowp = w; }
    }
    __device__ __forceinline__ void fused(f32x4 (&)[2][2][4][2], const Unit&, int, int, int, int, PG8_LAS unsigned char*, int, int) const {}
};

template <class Epi, class Sched, bool ALIGN_EPI = false, bool SP2 = false>
__device__ __forceinline__ void gemm_phase(PG8_LAS unsigned char* lds, const Gemm g, const Sched& S, const Epi& E) {
    const int tid = threadIdx.x, wid = __builtin_amdgcn_readfirstlane(tid >> 6), lane = tid & 63, wr = wid >> 2, wc = wid & 3, fr = lane & 15, fq = lane >> 4;
    int K = g.K, ld = g.ld; asm volatile("" : "+s"(K), "+s"(ld));
    const int nt = K / BK;
    unsigned voffA[2], voffB[2];
#pragma unroll
    for (int i = 0; i < 2; ++i) { int R, C; stage_rc(tid * 16 + i * 8192, R, C); const int Rb = Epi::PERM ? ((R & ~31) + perm32(R & 31)) : R;
        voffA[i] = (unsigned)(R * ld + C) * 2u; voffB[i] = (unsigned)(Rb * ld + C) * 2u; }
    const size_t kstep = (size_t)(BK * 2);
    const size_t hstep = (size_t)HALF * ld * 2;
    const size_t tstep = 2 * hstep;
    const size_t sstep = (size_t)K * 2;
    const unsigned ldsw = (unsigned)wid * 1024u;
    const int aoff = lds_byte(wr * 64 + fr, fq * 8), boff = lds_byte(wc * 32 + fr, fq * 8);
#define PG8_SA(b, h) (((b) * 2 + (h)) * HTB)
#define PG8_SB(b, h) ((4 + (b) * 2 + (h)) * HTB)
#define PG8_STAGE(bufoff, gbase, voff) do { _Pragma("unroll") for (int _i = 0; _i < 2; ++_i) \
        __builtin_amdgcn_global_load_lds((const unsigned*)((const char*)(gbase) + (voff)[_i]), (PG8_LAS unsigned*)(lds + (bufoff) + ldsw + _i * 8192), 16, 0, 0); } while (0)
#define PG8_LDA(dst, b, h) do { _Pragma("unroll") for (int m = 0; m < 4; ++m) _Pragma("unroll") for (int k = 0; k < 2; ++k) dst[m][k] = *(const PG8_LAS bf16x8*)(lds + PG8_SA(b, h) + aoff + m * 2048 + k * 1024); } while (0)
#define PG8_LDB(dst, b, h) do { _Pragma("unroll") for (int n = 0; n < 2; ++n) _Pragma("unroll") for (int k = 0; k < 2; ++k) dst[n][k] = *(const PG8_LAS bf16x8*)(lds + PG8_SB(b, h) + boff + n * 2048 + k * 1024); } while (0)
#define PG8_MMA(ai, bj, At, Bt) do { __builtin_amdgcn_s_setprio(1); _Pragma("unroll") for (int m = 0; m < 4; ++m) _Pragma("unroll") for (int n = 0; n < 2; ++n) _Pragma("unroll") for (int k = 0; k < 2; ++k) \
        acc[ai][bj][m][n] = __builtin_amdgcn_mfma_f32_16x16x32_bf16(Bt[n][k], At[m][k], acc[ai][bj][m][n], 0, 0, 0); __builtin_amdgcn_s_setprio(0); } while (0)
#define PG8_WAIT_V(n) asm volatile("s_waitcnt vmcnt(" #n ")" ::: "memory")
#define PG8_WAIT_L(n) asm volatile("s_waitcnt lgkmcnt(" #n ")" ::: "memory")
#define PG8_BAR __builtin_amdgcn_s_barrier()
#define PG8_SCHED __builtin_amdgcn_sched_barrier(0)
    Unit cur, nxt; int ui = 0;
    if (!S.next(0, cur)) return;
    f32x4 acc[2][2][4][2];
#pragma unroll
    for (int a = 0; a < 2; ++a)
#pragma unroll
        for (int b = 0; b < 2; ++b)
#pragma unroll
            for (int m = 0; m < 4; ++m)
#pragma unroll
                for (int n = 0; n < 2; ++n) acc[a][b][m][n] = (f32x4){0.f, 0.f, 0.f, 0.f};
    bf16x8 At[4][2], B0[2][2], B1[2][2];
    const char* cA = (const char*)g.A + (size_t)cur.pm * tstep + (size_t)cur.pk * sstep; const char* cB = (const char*)g.Bt + (size_t)cur.pn * tstep + (size_t)cur.pk * sstep;
    S.a_ready(cur);
    if constexpr (SP2) {
        PG8_STAGE(PG8_SB(0, 0), cB, voffB); PG8_STAGE(PG8_SB(0, 1), cB + hstep, voffB); PG8_STAGE(PG8_SA(0, 0), cA, voffA); PG8_STAGE(PG8_SA(0, 1), cA + hstep, voffA);
        if (wr == 1) PG8_BAR;
        PG8_WAIT_V(2); PG8_BAR;
        PG8_STAGE(PG8_SB(1, 0), cB + kstep, voffB); PG8_STAGE(PG8_SA(1, 0), cA + kstep, voffA); PG8_STAGE(PG8_SB(1, 1), cB + hstep + kstep, voffB);
        PG8_WAIT_V(6); PG8_BAR;
    } else {
        PG8_STAGE(PG8_SB(0, 0), cB, voffB); PG8_STAGE(PG8_SA(0, 0), cA, voffA); PG8_STAGE(PG8_SB(0, 1), cB + hstep, voffB); PG8_STAGE(PG8_SA(0, 1), cA + hstep, voffA);
        if (wr == 1) PG8_BAR;
        PG8_WAIT_V(4); PG8_BAR;
        PG8_STAGE(PG8_SB(1, 0), cB + kstep, voffB); PG8_STAGE(PG8_SA(1, 0), cA + kstep, voffA); PG8_STAGE(PG8_SB(1, 1), cB + hstep + kstep, voffB);
        PG8_WAIT_V(6); PG8_BAR;
    }
    for (;;) {
        const bool has_next = S.next(ui + 1, nxt);
        const char* nA = has_next ? (const char*)g.A + (size_t)nxt.pm * tstep + (size_t)nxt.pk * sstep : cA; const char* nB = has_next ? (const char*)g.Bt + (size_t)nxt.pn * tstep + (size_t)nxt.pk * sstep : cB;
        for (int t = 0; t < nt; t += 2) {
            const bool last = (t == nt - 2);
            const char* a1 = cA + (size_t)(t + 1) * kstep;
            const char* a2 = last ? nA : cA + (size_t)(t + 2) * kstep; const char* b2 = last ? nB : cB + (size_t)(t + 2) * kstep;
            const char* a3 = a2 + kstep; const char* b3 = b2 + kstep;
            if (last && has_next) S.a_ready(nxt);
            if constexpr (SP2) {
            PG8_LDB(B0, 0, 0); PG8_LDB(B1, 0, 1); PG8_SCHED; PG8_LDA(At, 0, 0); PG8_STAGE(PG8_SA(1, 1), a1 + hstep, voffA);
            PG8_WAIT_V(8); PG8_WAIT_L(0); PG8_BAR; PG8_MMA(0, 0, At, B0); PG8_MMA(0, 1, At, B1); PG8_BAR; PG8_SCHED;
            PG8_LDA(At, 0, 1); PG8_STAGE(PG8_SB(0, 0), b2, voffB); PG8_STAGE(PG8_SB(0, 1), b2 + hstep, voffB); PG8_STAGE(PG8_SA(0, 0), a2, voffA);
            PG8_WAIT_V(8); PG8_WAIT_L(0); PG8_BAR; PG8_MMA(1, 0, At, B0); PG8_MMA(1, 1, At, B1); PG8_BAR; PG8_SCHED;
            PG8_LDB(B0, 1, 0); PG8_LDB(B1, 1, 1); PG8_SCHED; PG8_LDA(At, 1, 0); PG8_STAGE(PG8_SA(0, 1), a2 + hstep, voffA);
            PG8_WAIT_V(8); PG8_WAIT_L(0); PG8_BAR; PG8_MMA(0, 0, At, B0); PG8_MMA(0, 1, At, B1); PG8_BAR; PG8_SCHED;
            PG8_LDA(At, 1, 1); PG8_STAGE(PG8_SB(1, 0), b3, voffB); PG8_STAGE(PG8_SB(1, 1), b3 + hstep, voffB); PG8_STAGE(PG8_SA(1, 0), a3, voffA);
            PG8_WAIT_V(8); PG8_WAIT_L(0); PG8_BAR; PG8_MMA(1, 0, At, B0); PG8_MMA(1, 1, At, B1); PG8_BAR; PG8_SCHED;
            } else {
            PG8_LDB(B0, 0, 0); PG8_SCHED; PG8_LDA(At, 0, 0); PG8_STAGE(PG8_SA(1, 1), a1 + hstep, voffA);
            PG8_WAIT_L(8); PG8_BAR; PG8_WAIT_L(0); PG8_MMA(0, 0, At, B0); PG8_BAR; PG8_SCHED;
            PG8_LDB(B1, 0, 1); PG8_STAGE(PG8_SB(0, 0), b2, voffB);
            PG8_BAR; PG8_WAIT_L(0); PG8_MMA(0, 1, At, B1); PG8_BAR;
            PG8_LDA(At, 0, 1); PG8_STAGE(PG8_SA(0, 0), a2, voffA);
            PG8_BAR; PG8_WAIT_L(0); PG8_MMA(1, 0, At, B0); PG8_BAR; PG8_SCHED;
            PG8_STAGE(PG8_SB(0, 1), b2 + hstep, voffB);
            PG8_WAIT_V(6); PG8_BAR; PG8_MMA(1, 1, At, B1); PG8_BAR;
            PG8_LDB(B0, 1, 0); PG8_SCHED; PG8_LDA(At, 1, 0); PG8_STAGE(PG8_SA(0, 1), a2 + hstep, voffA);
            PG8_WAIT_L(8); PG8_BAR; PG8_WAIT_L(0); PG8_MMA(0, 0, At, B0); PG8_BAR; PG8_SCHED;
            PG8_LDB(B1, 1, 1); PG8_STAGE(PG8_SB(1, 0), b3, voffB);
            PG8_BAR; PG8_WAIT_L(0); PG8_MMA(0, 1, At, B1); PG8_BAR;
            PG8_LDA(At, 1, 1); PG8_STAGE(PG8_SA(1, 0), a3, voffA);
            PG8_BAR; PG8_WAIT_L(0); PG8_MMA(1, 0, At, B0); PG8_BAR; PG8_SCHED;
            PG8_STAGE(PG8_SB(1, 1), b3 + hstep, voffB);
            PG8_WAIT_V(6); PG8_BAR; PG8_MMA(1, 1, At, B1); PG8_BAR;
            }
        }
        if constexpr (ALIGN_EPI) { if (wr == 0) PG8_BAR; }
        if constexpr (!Epi::AFTER_DRAIN) { E(acc, cur, wr, wc, fr, fq); S.done(cur); }
        if (!has_next) break;
#pragma unroll
        for (int a = 0; a < 2; ++a)
#pragma unroll
            for (int b = 0; b < 2; ++b)
#pragma unroll
                for (int m = 0; m < 4; ++m)
#pragma unroll
                    for (int n = 0; n < 2; ++n) acc[a][b][m][n] = (f32x4){0.f, 0.f, 0.f, 0.f};
        cur = nxt; cA = nA; cB = nB; ++ui;
        if constexpr (ALIGN_EPI) { if (wr == 1) PG8_BAR; }
    }
    PG8_WAIT_V(0);
    if constexpr (!ALIGN_EPI) { if (wr == 0) PG8_BAR; }
    PG8_BAR;
    if constexpr (Epi::AFTER_DRAIN) { E.fused(acc, cur, wr, wc, fr, fq, lds, wid, lane); S.done(cur); }
#undef PG8_SA
#undef PG8_SB
#undef PG8_STAGE
#undef PG8_LDA
#undef PG8_LDB
#undef PG8_MMA
#undef PG8_WAIT_V
#undef PG8_WAIT_L
#undef PG8_BAR
#undef PG8_SCHED
}
}

constexpr int DM = 2048, NB = 4, SEQ = 2048, NL = 2, DB = 8, PAST = 16384, PAGE = 128, HD = 128;
constexpr int NH = 8, NKV = 2, HPG = 4, GH = 8, WIN = 512, CONVCH = 3072, DFF = 5632, INW = 6696;
constexpr int MP = NB * SEQ, MS = DB, MT = MP + MS, MPAD = 8448, NIN = 6912, NGU = 2 * DFF, NPG = PAST / PAGE;
constexpr float EPS = 1e-6f;
constexpr int PQ = 0, PKV = 1024, PCONV = 2560, PZ = 5632, PGL = 6656, PA = 6680, PBB = 6688;

constexpr size_t O_YP = 0, O_YS = O_YP + (size_t)MP * DM, O_PCMP = O_YS + (size_t)MS * DM, O_PSEL = O_PCMP + (size_t)NB * NL * NKV * SEQ * 2 * HD,
    O_PWIN = O_PSEL + (size_t)NB * NL * NKV * SEQ * 2 * HD, O_PGDN = O_PWIN + (size_t)NB * NL * NKV * WIN * 2 * HD, O_PCONV = O_PGDN + (size_t)NB * NL * GH * HD * HD,
    O_SCMP = O_PCONV + (size_t)NB * NL * 3 * CONVCH, O_SSEL = O_SCMP + (size_t)DB * NL * NKV * 2 * HD, O_SWIN = O_SSEL + (size_t)DB * NL * NKV * 2 * HD,
    O_SGDN = O_SWIN + (size_t)DB * NL * NKV * WIN * 2 * HD, O_SCONV = O_SGDN + (size_t)DB * NL * GH * HD * HD, O_END = O_SCONV + (size_t)DB * NL * 3 * CONVCH;

constexpr size_t MiB = 1u << 20;
constexpr size_t al(size_t x) { return (x + MiB - 1) / MiB * MiB; }
constexpr size_t WS_CTL = 0, CTL_BYTES = 1 * MiB;
constexpr size_t WS_WIN = WS_CTL + CTL_BYTES;
constexpr size_t WS_WOUT = WS_WIN + al((size_t)NL * NIN * DM * 2);
constexpr size_t WS_WGU = WS_WOUT + al((size_t)NL * DM * DM * 2);
constexpr size_t WS_WDN = WS_WGU + al((size_t)NL * NGU * DM * 2);
constexpr size_t WS_W1 = WS_WDN + al((size_t)NL * DM * DFF * 2);
constexpr size_t WS_MODP = WS_W1 + al((size_t)4 * 256 * 8192 * 2);
constexpr size_t WS_MOD = WS_MODP + al((size_t)8 * 2 * 12 * 12288 * 4);
constexpr size_t WS_ROPE = WS_MOD + al((size_t)2 * 12 * 12288 * 4);
constexpr size_t WS_X = WS_ROPE + al((size_t)2049 * 32 * 4);
constexpr size_t WS_H = WS_X + al((size_t)MPAD * DM * 4);
constexpr size_t WS_PROJ = WS_H + al((size_t)MPAD * DM * 2);
constexpr size_t WS_QF = WS_PROJ + al((size_t)MPAD * NIN * 4);
constexpr size_t WS_KWF = WS_QF + al((size_t)MT * 1024 * 4);
constexpr size_t WS_GATES = WS_KWF + al((size_t)NB * NKV * SEQ * 256 * 4);
constexpr size_t WS_GQ = WS_GATES + al((size_t)MT * 24 * 4);
constexpr size_t WS_GK = WS_GQ + al((size_t)MT * 1024 * 4);
constexpr size_t WS_GV = WS_GK + al((size_t)MT * 1024 * 4);
constexpr size_t WS_GO = WS_GV + al((size_t)MT * 1024 * 4);
constexpr size_t WS_GG = WS_GO + al((size_t)MT * 1024 * 4);
constexpr size_t WS_GB = WS_GG + al((size_t)MT * 8 * 4);
constexpr size_t WS_AS = WS_GB + al((size_t)MT * 8 * 4);
constexpr size_t WS_AP = WS_AS + al((size_t)4 * 4096 * 8192 * 2);
constexpr size_t WS_HIDS = WS_AP + al((size_t)2 * 256 * 8192 * 2);
constexpr size_t WS_HIDP = WS_HIDS + al((size_t)4 * 16384 * 256 * 4);
constexpr size_t WS_CBS = WS_HIDP + al((size_t)32 * 512 * 256 * 4);
constexpr size_t WS_CBP = WS_CBS + al((size_t)16384 * 128 * 4);
constexpr size_t WS_OMIX = WS_CBP + al((size_t)512 * 128 * 4);
constexpr size_t WS_MIX = WS_OMIX + al((size_t)MPAD * DM * 2);
constexpr size_t WS_ACT = WS_MIX + al((size_t)MPAD * DM * 4);
constexpr size_t WS_KSB = WS_ACT + al((size_t)MPAD * DFF * 2);
constexpr size_t KVB_SZ = (size_t)NB * NKV * SEQ * HD * 2;
constexpr size_t WS_VSB = WS_KSB + al(KVB_SZ), WS_KWB = WS_VSB + al(KVB_SZ), WS_VWB = WS_KWB + al(KVB_SZ);
constexpr size_t WS_ATA = WS_VWB + al(KVB_SZ);
constexpr size_t WS_GFR = WS_ATA + al((size_t)256 * 8 * 16 * 64 * 16);
constexpr size_t FR_W = 0, FR_Q = 16384, FR_K = 32768, FR_QK = 49152, FR_U = 57344, FR_CH = 90112;
constexpr size_t WS_GDEC = WS_GFR + al((size_t)1024 * FR_CH);
constexpr size_t WS_PEC = WS_GDEC + al(1024 * 4);
constexpr size_t WS_W1B = WS_PEC + al(1024 * 4);
constexpr size_t WS_END = WS_W1B + al((size_t)4 * 256 * 8192 * 2);

constexpr int CW_BAR = 4096;

constexpr int RING_BYTES = 131072, LDS_BYTES = 163840, MISC_OFF = LDS_BYTES - 256;
constexpr int NWAVES = 8, NTHR = 512;

__device__ __forceinline__ unsigned f2bf(float f) { unsigned u = __float_as_uint(f); return (u + 0x7fffu + ((u >> 16) & 1u)) >> 16; }
__device__ __forceinline__ unsigned pk2(float lo, float hi) { return f2bf(lo) | (f2bf(hi) << 16); }
__device__ __forceinline__ float wave_sum(float v) {
#pragma unroll
    for (int o = 1; o < 64; o <<= 1) v += __shfl_xor(v, o);
    return v;
}
__device__ __forceinline__ float wave_max(float v) {
#pragma unroll
    for (int o = 1; o < 64; o <<= 1) v = fmaxf(v, __shfl_xor(v, o));
    return v;
}
__device__ __forceinline__ float sigm(float x) { return 1.0f / (1.0f + expf(-x)); }
__device__ __forceinline__ float siluf(float x) { return x / (1.0f + expf(-x)); }
__device__ __forceinline__ float softplusf(float x) { return fmaxf(x, 0.f) + log1pf(expf(-fabsf(x))); }
__device__ __forceinline__ float gelu_tanh(float x) { return 0.5f * x * (1.0f + tanhf(0.7978845608028654f * (x + 0.044715f * x * x * x))); }

__constant__ double ROPE_INV[16] = {1.0, 0.44036660267178046, 0.19392274474868576, 0.08539710028576561, 0.03760603093086393, 0.016560440080994446, 0.007292664737217109,
    0.003211445994752591, 0.001414213562373095, 0.000622772421914596, 0.0002742481756762073, 0.00012076973741146504, 5.318295896944988e-05, 2.341999896140934e-05,
    1.031338537721246e-05, 4.5416704806078695e-06};

__device__ __forceinline__ void sincos_d(double a, float& c, float& s) {
    const double k = rint(a * 0.6366197723675814);
    const double r = (a - k * 1.5707963267948966) - k * 6.123233995736766e-17;
    const int q = (int)((long long)k & 3);
    const double r2 = r * r;
    const double sp = r * (1.0 + r2 * (-1.0 / 6 + r2 * (1.0 / 120 + r2 * (-1.0 / 5040 + r2 * (1.0 / 362880 + r2 * (-1.0 / 39916800 + r2 * (1.0 / 6227020800.0)))))));
    const double cp = 1.0 + r2 * (-0.5 + r2 * (1.0 / 24 + r2 * (-1.0 / 720 + r2 * (1.0 / 40320 + r2 * (-1.0 / 3628800 + r2 * (1.0 / 479001600 + r2 * (-1.0 / 87178291200.0)))))));
    double ss, cc;
    if (q == 0) { ss = sp; cc = cp; } else if (q == 1) { ss = cp; cc = -sp; } else if (q == 2) { ss = -sp; cc = -cp; } else { ss = -cp; cc = sp; }
    c = (float)cc; s = (float)ss;
}

#define XB_TMO      128
#define XB_XCNT(j)  (256  + 64 * (j))
#define XB_XSUB(j)  (1280 + 64 * (j))
#define XB_XGEN(j)  (2304 + 64 * (j))
#define XB_TOP      3328
#define XB_TOPGEN   3392
#define XCD_BAR_WORDS 3456
#define XB_SPIN_CAP (1u << 22)
__device__ __forceinline__ unsigned xb_ld(unsigned* p)              { return __hip_atomic_load(p, __ATOMIC_RELAXED, __HIP_MEMORY_SCOPE_AGENT); }
__device__ __forceinline__ unsigned xb_add(unsigned* p, unsigned v) { return __hip_atomic_fetch_add(p, v, __ATOMIC_RELAXED, __HIP_MEMORY_SCOPE_AGENT); }
__device__ __forceinline__ unsigned xb_xcc_id() { return (unsigned)__builtin_amdgcn_s_getreg((3 << 11) | 20) & 0xFu; }
#define XB_SPIN(cond, bar) do { unsigned _sp = 0; while (cond) { __builtin_amdgcn_s_sleep(1); \
    if ((++_sp & 255u) == 0u) { if (xb_ld(&(bar)[XB_TMO])) break; if (_sp > XB_SPIN_CAP) { atomicAdd(&(bar)[XB_TMO], 1u); break; } } } } while (0)
struct XcdBarrier { unsigned* bar; unsigned x; volatile LAS unsigned* st; };
__device__ __forceinline__ XcdBarrier xcd_barrier_post(unsigned* bar, volatile LAS unsigned* st) {
    XcdBarrier b; b.bar = bar; b.x = xb_xcc_id(); b.st = st;
    if (threadIdx.x == 0) (void)xb_add(&bar[XB_XCNT(b.x)], 1u);
    return b;
}
__device__ __forceinline__ void xcd_barrier_complete(unsigned* bar, unsigned x, unsigned& nloc, unsigned& nx) {
    const unsigned G = gridDim.x * gridDim.y * gridDim.z;
    unsigned sum, cnt, mine, sp = 0u;
    for (;;) {
        sum = 0u; cnt = 0u; mine = 0u;
#pragma unroll
        for (unsigned j = 0; j < 16; ++j) { const unsigned c = xb_ld(&bar[XB_XCNT(j)]); sum += c; cnt += (c > 0u) ? 1u : 0u; mine = (j == x) ? c : mine; }
        if (sum == G) break;
        __builtin_amdgcn_s_sleep(1);
        if ((++sp & 255u) == 0u) { if (xb_ld(&bar[XB_TMO])) break; if (sp > XB_SPIN_CAP) { atomicAdd(&bar[XB_TMO], 1u); break; } }
    }
    nloc = mine > 0u ? mine : 1u; nx = cnt > 0u ? cnt : 1u;
}
__device__ __forceinline__ void xcd_barrier(const XcdBarrier& b) {
    asm volatile("s_waitcnt vmcnt(0)" ::: "memory");
    __syncthreads();
    if (threadIdx.x == 0) {
        unsigned* bar = b.bar;
        __builtin_amdgcn_s_waitcnt(0);
        unsigned nloc = b.st[0], nx = b.st[1];
        if (nloc == 0u) { xcd_barrier_complete(bar, b.x, nloc, nx); b.st[0] = nloc; b.st[1] = nx; }
        const unsigned old = xb_add(&bar[XB_XSUB(b.x)], 1u);
        const unsigned gen = old / nloc;
        if (old + 1u == (gen + 1u) * nloc) {
            __builtin_amdgcn_fence(__ATOMIC_RELEASE, "agent");
            asm volatile("s_waitcnt vmcnt(0)" ::: "memory");
            const unsigned og = xb_add(&bar[XB_TOP], 1u);
            const unsigned tg = og / nx;
            if (og + 1u == (tg + 1u) * nx) xb_add(&bar[XB_TOPGEN], 1u);
            else XB_SPIN(xb_ld(&bar[XB_TOPGEN]) == tg, bar);
            __builtin_amdgcn_fence(__ATOMIC_ACQUIRE, "agent");
            xb_add(&bar[XB_XGEN(b.x)], 1u);
            asm volatile("s_waitcnt vmcnt(0)" ::: "memory");
        } else {
            XB_SPIN(xb_ld(&bar[XB_XGEN(b.x)]) == gen, bar);
            __builtin_amdgcn_fence(__ATOMIC_ACQUIRE, "agent");
            asm volatile("s_waitcnt vmcnt(0)" ::: "memory");
        }
    }
    __syncthreads();
}

struct Args { const void* in[28]; float* out; unsigned char* ws; int ph_lo, ph_hi; };

struct Frame {
    LAS unsigned char* lds;
    int tid, lane, wave, G, bid;
    const void* const* in; float* out; unsigned char* ws;
};


template <class Map>
__device__ __forceinline__ void tr_item(const Map& mp, int K, int NNEW, bf16* WT, LAS float* scr, int item, int lane, bf16* WB = nullptr) {
    const int nblk = NNEW / 64, kb = item / nblk, nb = item % nblk, k0 = 64 * kb, n0 = 64 * nb;
    const float* colp; int stride; const bool ok = mp(n0 + lane, colp, stride);
#pragma unroll
    for (int h = 0; h < 2; ++h) { float tv[32];
#pragma unroll
        for (int i = 0; i < 32; ++i) tv[i] = ok ? colp[(size_t)(k0 + 32 * h + i) * stride] : 0.f;
#pragma unroll
        for (int i = 0; i < 32; ++i) scr[(32 * h + i) * 65 + lane] = tv[i]; }
    asm volatile("s_waitcnt lgkmcnt(0)" ::: "memory");
    const int c = lane & 7;
#pragma unroll
    for (int j = 0; j < 8; ++j) { const int n = (lane >> 3) + 8 * j; const LAS float* s = scr + (8 * c) * 65 + n;
        u32x4 o; o.x = pk2(s[0 * 65], s[1 * 65]); o.y = pk2(s[2 * 65], s[3 * 65]); o.z = pk2(s[4 * 65], s[5 * 65]); o.w = pk2(s[6 * 65], s[7 * 65]);
        *(u32x4*)(WT + (size_t)(n0 + n) * K + k0 + 8 * c) = o;
        if (WB) *(u32x4*)(WB + ((size_t)((k0 >> 5) + (c >> 2)) * NNEW + n0 + n) * 32 + (c & 3) * 8) = o; }
    asm volatile("s_waitcnt lgkmcnt(0)" ::: "memory");
}
struct MapIn { const float* W; __device__ __forceinline__ bool operator()(int n, const float*& p, int& st) const {
    int o; if (n < 2560) o = n; else if (n < 5632) o = n + 24; else if (n < 6656) o = n + 40; else if (n < 6680) o = n - 4096; else if (n < 6696) o = n - 1024; else o = -1;
    st = INW; p = W + (o < 0 ? 0 : o); return o >= 0; } };
struct MapPlain { const float* W; int N; __device__ __forceinline__ bool operator()(int n, const float*& p, int& st) const { st = N; p = W + n; return true; } };
struct MapBase { const float* base; int stride, n0; __device__ __forceinline__ bool operator()(int n, const float*& p, int& st) const { st = stride; p = base + (n - n0); return true; } };

__device__ __forceinline__ const float* xrow_in(const Frame& F, int l, int r) {
    if (l == 0) return r < MP ? ((const float*)F.in[0]) + (size_t)r * DM : ((const float*)F.in[1]) + (size_t)(r - MP) * DM;
    return ((float*)(F.ws + WS_X)) + (size_t)r * DM;
}
__device__ __forceinline__ int modrow(int r) { return r < MP ? (r >> 11) : 4 + (r - MP); }

__device__ __forceinline__ void norm_mod_store(const f32x4 (&v)[8], const float* gain, const float* sh, const float* sc, bf16* orow, int lane) {
    float ss = 0.f;
#pragma unroll
    for (int j = 0; j < 8; ++j) ss += (v[j].x * v[j].x + v[j].y * v[j].y) + (v[j].z * v[j].z + v[j].w * v[j].w);
    ss = wave_sum(ss);
    const float rs = 1.0f / sqrtf(ss * (1.0f / DM) + EPS);
#pragma unroll
    for (int j = 0; j < 8; ++j) { const int c = (lane + 64 * j) * 4;
        const f32x4 g = *(const f32x4*)(gain + c), a = *(const f32x4*)(sc + c), b = *(const f32x4*)(sh + c);
        const f32x4 h = v[j] * rs * g * (a + 1.0f) + b;
        u32x2 o; o.x = pk2(h.x, h.y); o.y = pk2(h.z, h.w); *(u32x2*)(orow + c) = o; }
}

constexpr int TR_I_IN = (DM / 64) * (NIN / 64), TR_I_OUT = (DM / 64) * (DM / 64), TR_I_GU = (DM / 64) * (NGU / 64), TR_I_DN = (DFF / 64) * (DM / 64), TR_I_W1 = (8192 / 64) * (256 / 64);
constexpr int TR_I_L = TR_I_IN + TR_I_OUT + TR_I_GU + TR_I_DN;
__device__ __forceinline__ void tr_range(Frame& F, int first, int count, int rank, int nw) {
    LAS float* scr = (LAS float*)(F.lds + F.wave * 16896);
    const int lane = F.lane;
#pragma unroll 1
    for (int it = first + rank; it < first + count; it += nw) {
        int r = it;
        if (r < 2 * TR_I_L) {
            const int l = r / TR_I_L; r -= l * TR_I_L;
            if (r < TR_I_IN) { MapIn mp{((const float*)F.in[13]) + (size_t)l * DM * INW}; tr_item(mp, DM, NIN, ((bf16*)(F.ws + WS_WIN)) + (size_t)l * NIN * DM, scr, r, lane); continue; } r -= TR_I_IN;
            if (r < TR_I_OUT) { MapPlain mp{((const float*)F.in[21]) + (size_t)l * DM * DM, DM}; tr_item(mp, DM, DM, ((bf16*)(F.ws + WS_WOUT)) + (size_t)l * DM * DM, scr, r, lane); continue; } r -= TR_I_OUT;
            if (r < TR_I_GU) { const int n0 = (r % (NGU / 64)) * 64, tt = n0 >> 8, rr = n0 & 255;
                if (rr < 128) { MapBase mp{((const float*)F.in[24]) + (size_t)l * DM * DFF + tt * 128 + rr, DFF, n0}; tr_item(mp, DM, NGU, ((bf16*)(F.ws + WS_WGU)) + (size_t)l * NGU * DM, scr, r, lane); }
                else { MapBase mp{((const float*)F.in[25]) + (size_t)l * DM * DFF + tt * 128 + rr - 128, DFF, n0}; tr_item(mp, DM, NGU, ((bf16*)(F.ws + WS_WGU)) + (size_t)l * NGU * DM, scr, r, lane); }
                continue; } r -= TR_I_GU;
            { MapPlain mp{((const float*)F.in[26]) + (size_t)l * DFF * DM, DM}; tr_item(mp, DFF, DM, ((bf16*)(F.ws + WS_WDN)) + (size_t)l * DM * DFF, scr, r, lane); continue; }
        }
        r -= 2 * TR_I_L;
        { const int m = r / TR_I_W1; r -= m * TR_I_W1; MapPlain mp{((const float*)F.in[15]) + (size_t)m * 8192 * 256, 256}; tr_item(mp, 8192, 256, ((bf16*)(F.ws + WS_W1)) + (size_t)m * 256 * 8192, scr, r, lane, ((bf16*)(F.ws + WS_W1B)) + (size_t)m * 256 * 8192); }
    }
}

__device__ __forceinline__ void phase_prologue(Frame& F) {
    const int tid = F.tid, lane = F.lane, G = F.G;
    {
        LAS float* sc = (LAS float*)F.lds;
        for (int it = F.bid; it < 2 * 24 * 8; it += G) {
            const int ks = it & 7, chunk = (it >> 3) % 24, l = it / 192;
            for (int i = tid; i < 12 * 256; i += NTHR) { const int row = i >> 8, k = i & 255;
                const float c = row < 4 ? ((const float*)F.in[8])[row * DM + ks * 256 + k] : ((const float*)F.in[9])[(row - 4) * DM + ks * 256 + k]; sc[i] = siluf(c); }
            __syncthreads();
            const int n = chunk * 512 + tid;
            float acc[12];
#pragma unroll
            for (int r = 0; r < 12; ++r) acc[r] = 0.f;
            const float* w = ((const float*)F.in[10]) + ((size_t)l * DM + ks * 256) * 12288 + n;
#pragma unroll 1
            for (int k0 = 0; k0 < 256; k0 += 16) { float wv[16];
#pragma unroll
                for (int u = 0; u < 16; ++u) wv[u] = w[(size_t)(k0 + u) * 12288];
#pragma unroll
                for (int u = 0; u < 16; ++u)
#pragma unroll
                    for (int r = 0; r < 12; ++r) acc[r] += sc[r * 256 + k0 + u] * wv[u]; }
#pragma unroll
            for (int r = 0; r < 12; ++r) ((float*)(F.ws + WS_MODP))[((size_t)(ks * 2 + l) * 12 + r) * 12288 + n] = acc[r];
            __syncthreads();
        }
    }
    for (int i = F.bid * NTHR + tid; i < 2049 * 16; i += G * NTHR) {
        const int p = i >> 4, k = i & 15; const double pos = p < 2048 ? (double)p : (double)PAST;
        float c, s; sincos_d(pos * ROPE_INV[k], c, s); ((float*)(F.ws + WS_ROPE))[2 * i] = c; ((float*)(F.ws + WS_ROPE))[2 * i + 1] = s;
    }
    for (int i = F.bid * NTHR + tid; i < (MPAD - MT) * DM / 2; i += G * NTHR) { ((unsigned*)(((bf16*)(F.ws + WS_H)) + (size_t)MT * DM))[i] = 0u; ((unsigned*)(((bf16*)(F.ws + WS_OMIX)) + (size_t)MT * DM))[i] = 0u; }
    __syncthreads();
    tr_range(F, 0, TR_I_L, F.bid * NWAVES + F.wave, G * NWAVES);
    tr_range(F, 2 * TR_I_L, 4 * TR_I_W1, F.bid * NWAVES + F.wave, G * NWAVES);
}

__device__ __forceinline__ void ada_reduce(Frame& F) {
    for (int i = F.bid * NTHR + F.tid; i < 2 * 12 * 12288; i += F.G * NTHR) {
        const int n = i % 12288, l = i / (12 * 12288);
        float s = ((const float*)F.in[11])[l * 12288 + n];
#pragma unroll
        for (int ks = 0; ks < 8; ++ks) s += ((float*)(F.ws + WS_MODP))[(size_t)ks * (2 * 12 * 12288) + i];
        ((float*)(F.ws + WS_MOD))[i] = s;
    }
}

__device__ __forceinline__ void pe_w1(Frame& F) {
    const int gw = F.bid * NWAVES + F.wave;
    if (gw >= 1024) return;
    const bf16* wr = ((const bf16*)(F.ws + WS_W1)) + (size_t)gw * 8192; const float* pe = ((const float*)F.in[14]) + (size_t)(gw >> 8) * 8192;
    float s = 0.f;
#pragma unroll 4
    for (int i = 0; i < 16; ++i) { const int k = i * 512 + F.lane * 8;
        const u32x4 w = *(const u32x4*)(wr + k); const f32x4 p0 = *(const f32x4*)(pe + k), p1 = *(const f32x4*)(pe + k + 4);
        s += __uint_as_float(w.x << 16) * p0.x + __uint_as_float(w.x & 0xffff0000u) * p0.y + __uint_as_float(w.y << 16) * p0.z + __uint_as_float(w.y & 0xffff0000u) * p0.w
           + __uint_as_float(w.z << 16) * p1.x + __uint_as_float(w.z & 0xffff0000u) * p1.y + __uint_as_float(w.w << 16) * p1.z + __uint_as_float(w.w & 0xffff0000u) * p1.w; }
    s = wave_sum(s);
    if (F.lane == 0) ((float*)(F.ws + WS_PEC))[gw] = s;
}

template <int NSPLIT>
__device__ __forceinline__ void cmp_finish(Frame& F, const float* hid, size_t slab, int rows, int rows_per_mat, const float* w2base, float* outp, int bid0 = 0, int row0 = 0, const float* cadd = nullptr) {
    LAS float* hs = (LAS float*)F.lds;
    if (F.bid < bid0) return;
    for (int it = F.bid - bid0; it < rows / 4; it += F.G - bid0) {
#pragma unroll
        for (int i0 = 0; i0 < 2; ++i0) { const int i = F.tid + i0 * NTHR; const int rr = i >> 8, n = i & 255; const size_t R = (size_t)row0 + (size_t)it * 4 + rr;
            float pv[NSPLIT];
#pragma unroll
            for (int ks = 0; ks < NSPLIT; ++ks) pv[ks] = hid[(size_t)ks * slab + R * 256 + n];
            float s = cadd ? cadd[(R / rows_per_mat) * 256 + n] : 0.f;
#pragma unroll
            for (int ks = 0; ks < NSPLIT; ++ks) s += pv[ks];
            hs[i] = gelu_tanh(s); }
        __syncthreads();
        const int rr = F.tid >> 7, c = F.tid & 127; const size_t R = (size_t)row0 + (size_t)it * 4 + rr;
        const float* w2 = w2base + (R / rows_per_mat) * 32768;
        float acc = 0.f;
#pragma unroll 1
        for (int n0 = 0; n0 < 256; n0 += 32) { float wv[32];
#pragma unroll
            for (int u = 0; u < 32; ++u) wv[u] = w2[(n0 + u) * 128 + c];
#pragma unroll
            for (int u = 0; u < 32; ++u) acc += hs[rr * 256 + n0 + u] * wv[u]; }
        outp[R * 128 + c] = acc;
        __syncthreads();
    }
}

template <int NSPLIT>
__device__ __forceinline__ void cmp_finish16(Frame& F, const float* hid, size_t slab, int rows, int rows_per_mat, const float* w2base, float* outp, int bid0 = 0, int row0 = 0, const float* cadd = nullptr) {
    LAS float* hs = (LAS float*)F.lds;
    if (F.bid < bid0) return;
    for (int it = F.bid - bid0; it < rows / 16; it += F.G - bid0) {
        const size_t R0 = (size_t)row0 + (size_t)it * 16; const int mat = (int)(R0 / rows_per_mat);
#pragma unroll
        for (int i0 = 0; i0 < 8; ++i0) { const int i = F.tid + i0 * NTHR; const int rr = i >> 8, n = i & 255; const size_t R = R0 + rr;
            float pv[NSPLIT];
#pragma unroll
            for (int ks = 0; ks < NSPLIT; ++ks) pv[ks] = hid[(size_t)ks * slab + R * 256 + n];
            float s = cadd ? cadd[mat * 256 + n] : 0.f;
#pragma unroll
            for (int ks = 0; ks < NSPLIT; ++ks) s += pv[ks];
            hs[i] = gelu_tanh(s); }
        __syncthreads();
        const int g = F.tid >> 7, c = F.tid & 127;
        const float* w2 = w2base + (size_t)mat * 32768;
        float acc[4] = {0.f, 0.f, 0.f, 0.f};
#pragma unroll 1
        for (int n0 = 0; n0 < 256; n0 += 32) { float wv[32];
#pragma unroll
            for (int u = 0; u < 32; ++u) wv[u] = w2[(n0 + u) * 128 + c];
#pragma unroll
            for (int u = 0; u < 32; ++u)
#pragma unroll
                for (int r = 0; r < 4; ++r) acc[r] += hs[(g * 4 + r) * 256 + n0 + u] * wv[u]; }
#pragma unroll
        for (int r = 0; r < 4; ++r) outp[(R0 + g * 4 + r) * 128 + c] = acc[r];
        __syncthreads();
    }
}

__device__ __forceinline__ void phase_norm1(Frame& F, int l) {
    const int gw = F.bid * NWAVES + F.wave, NGW = F.G * NWAVES;
    for (int r = gw; r < MT; r += NGW) {
        const f32x4* xr = (const f32x4*)xrow_in(F, l, r) + F.lane;
        f32x4 v[8];
#pragma unroll
        for (int j = 0; j < 8; ++j) v[j] = xr[64 * j];
        const float* md = ((float*)(F.ws + WS_MOD)) + ((size_t)l * 12 + modrow(r)) * 12288;
        norm_mod_store(v, ((const float*)F.in[12]) + l * DM, md, md + 2048, ((bf16*)(F.ws + WS_H)) + (size_t)r * DM, F.lane);
    }
}

__device__ __forceinline__ void phase_postproj(Frame& F, int l, int parts = 7) {
    const int lane = F.lane, gw = F.bid * NWAVES + F.wave, NGW = F.G * NWAVES;
    const int j = lane & 31, hs = lane >> 5;
    float* PROJp = (float*)(F.ws + WS_PROJ);
    if (parts & 1)
#pragma unroll 1
    for (int r = gw; r < MT; r += NGW) {
        const float* pr = PROJp + (size_t)r * NIN;
        const bool isP = r < MP; const int b = isP ? (r >> 11) : (r - MP), t = isP ? (r & 2047) : 0;
        const float* rp = ((float*)(F.ws + WS_ROPE)) + (size_t)(isP ? t : 2048) * 32;
        f32x4 cs, sn;
#pragma unroll
        for (int e = 0; e < 4; ++e) { const int i = (4 * j + e) & 15; cs[e] = rp[2 * i]; sn[e] = rp[2 * i + 1]; }
        f32x4 qv[4], kv[3], vv[3];
#pragma unroll
        for (int i = 0; i < 4; ++i) qv[i] = *(const f32x4*)(pr + PQ + i * 256 + lane * 4);
#pragma unroll
        for (int s = 0; s < 3; ++s) { kv[s] = *(const f32x4*)(pr + PKV + s * 512 + lane * 4); vv[s] = *(const f32x4*)(pr + PKV + s * 512 + 256 + lane * 4); }
#pragma unroll
        for (int i = 0; i < 4; ++i) { f32x4 x = qv[i], o;
#pragma unroll
            for (int e = 0; e < 4; ++e) o[e] = __shfl_xor(x[e], 4);
            if (j < 4) x = x * cs - o * sn; else if (j < 8) x = x * cs + o * sn;
            *(f32x4*)(((float*)(F.ws + WS_QF)) + ((size_t)r * 8 + 2 * i + hs) * 128 + 4 * j) = x; }
        const int g = hs;
#pragma unroll
        for (int s = 0; s < 3; ++s) { f32x4 x = kv[s], o; const f32x4 v = vv[s];
#pragma unroll
            for (int e = 0; e < 4; ++e) o[e] = __shfl_xor(x[e], 4);
            if (j < 4) x = x * cs - o * sn; else if (j < 8) x = x * cs + o * sn;
            float* dst;
            if (s < 2) {
                if (isP) dst = F.out + (s == 0 ? O_PCMP : O_PSEL) + ((((size_t)b * NL + l) * NKV + g) * SEQ + t) * 256;
                else dst = F.out + (s == 0 ? O_SCMP : O_SSEL) + (((size_t)b * NL + l) * NKV + g) * 256;
            } else {
                dst = isP ? nullptr : F.out + O_SWIN + ((((size_t)b * NL + l) * NKV + g) * WIN + (WIN - 1)) * 256;
            }
            if (dst) { *(f32x4*)(dst + 4 * j) = x; *(f32x4*)(dst + 128 + 4 * j) = v; }
            if (s >= 1 && isP) { const size_t o2 = (((size_t)b * NKV + g) * SEQ + t) * HD + 4 * j;
                u32x2 kk, v2; kk.x = pg8::cvt_pk_bf16(x.x, x.y); kk.y = pg8::cvt_pk_bf16(x.z, x.w); v2.x = pg8::cvt_pk_bf16(v.x, v.y); v2.y = pg8::cvt_pk_bf16(v.z, v.w);
                *(u32x2*)((bf16*)(F.ws + (s == 1 ? WS_KSB : WS_KWB)) + o2) = kk; *(u32x2*)((bf16*)(F.ws + (s == 1 ? WS_VSB : WS_VWB)) + o2) = v2; }
            if (s == 2 && isP && t >= SEQ - WIN) { float* d2 = F.out + O_PWIN + ((((size_t)b * NL + l) * NKV + g) * WIN + (t - (SEQ - WIN))) * 256;
                *(f32x4*)(d2 + 4 * j) = x; *(f32x4*)(d2 + 128 + 4 * j) = v; }
            if (s == 0 && isP) {
                const int tt = t & 63; const size_t arow = ((size_t)b * 32 + (t >> 6)) * 2 + g;
                const float* pek = ((const float*)F.in[14]) + (((size_t)l * 2 + 0) * 64 + tt) * 128 + 4 * j;
                const f32x4 pk = *(const f32x4*)pek, pv = *(const f32x4*)(pek + 64 * 128);
                const f32x4 xa = x + pk, va = v + pv;
                u32x2 kk, v2; kk.x = pg8::cvt_pk_bf16(xa.x, xa.y); kk.y = pg8::cvt_pk_bf16(xa.z, xa.w); v2.x = pg8::cvt_pk_bf16(va.x, va.y); v2.y = pg8::cvt_pk_bf16(va.z, va.w);
                bf16* ak = ((bf16*)(F.ws + WS_AP)) + arow * 8192 + tt * 128 + 4 * j;
                *(u32x2*)ak = kk; *(u32x2*)(ak + (size_t)256 * 8192) = v2;
            }
        }
        if (lane < 24) ((float*)(F.ws + WS_GATES))[(size_t)r * 24 + lane] = sigm(pr[PGL + lane]);
        if (lane < 8) { ((float*)(F.ws + WS_GG))[(size_t)r * 8 + lane] = -expf(((const float*)F.in[18])[l * 8 + lane]) * softplusf(pr[PA + lane] + ((const float*)F.in[19])[l * 8 + lane]); ((float*)(F.ws + WS_GB))[(size_t)r * 8 + lane] = sigm(pr[PBB + lane]); }
        const float* stc = ((const float*)F.in[6]) + ((size_t)(isP ? 0 : b) * NL + l) * 3 * CONVCH;
        if (isP) { if (t >= SEQ - 3) { float* d = F.out + O_PCONV + (((size_t)b * NL + l) * 3 + (t - (SEQ - 3))) * CONVCH;
#pragma unroll
                for (int i = 0; i < 12; ++i) *(f32x4*)(d + i * 256 + lane * 4) = *(const f32x4*)(pr + PCONV + i * 256 + lane * 4); } }
        else { float* d = F.out + O_SCONV + ((size_t)b * NL + l) * 3 * CONVCH;
#pragma unroll
            for (int i = 0; i < 12; ++i) { const int c = i * 256 + lane * 4; *(f32x4*)(d + c) = *(const f32x4*)(stc + CONVCH + c); *(f32x4*)(d + CONVCH + c) = *(const f32x4*)(stc + 2 * CONVCH + c);
                *(f32x4*)(d + 2 * CONVCH + c) = *(const f32x4*)(pr + PCONV + c); } }
    }
    if (parts & 2) {
        const float* cwp = ((const float*)F.in[17]) + (size_t)l * 4 * CONVCH;
        const int NITEM = 12 * (NB * 32 + MS);
#pragma unroll 1
        for (int it = NGW - 1 - gw; it < NITEM; it += NGW) {
            const int cg = it % 12, tb = it / 12; const int part = cg >> 2;
            const int c = cg * 256 + lane * 4, head = (cg & 3) * 2 + hs;
            const bool isP = tb < NB * 32; const int b = isP ? (tb >> 5) : (tb - NB * 32);
            const int row0 = isP ? b * SEQ + (tb & 31) * 64 : MP + b, t0 = isP ? (tb & 31) * 64 : 0, nt = isP ? 64 : 1;
            f32x4 w0 = *(const f32x4*)(cwp + c), w1 = *(const f32x4*)(cwp + CONVCH + c), w2 = *(const f32x4*)(cwp + 2 * CONVCH + c), w3 = *(const f32x4*)(cwp + 3 * CONVCH + c);
            f32x4 x0, x1, x2; const f32x4 z4 = (f32x4){0.f, 0.f, 0.f, 0.f};
            if (isP) { if (t0 > 0) { x0 = *(const f32x4*)(PROJp + (size_t)(row0 - 3) * NIN + PCONV + c); x1 = *(const f32x4*)(PROJp + (size_t)(row0 - 2) * NIN + PCONV + c); x2 = *(const f32x4*)(PROJp + (size_t)(row0 - 1) * NIN + PCONV + c); }
                       else { x0 = z4; x1 = z4; x2 = z4; } }
            else { const float* stc = ((const float*)F.in[6]) + ((size_t)b * NL + l) * 3 * CONVCH + c; x0 = *(const f32x4*)stc; x1 = *(const f32x4*)(stc + CONVCH); x2 = *(const f32x4*)(stc + 2 * CONVCH); }
            float* dstb = (part == 0 ? ((float*)(F.ws + WS_GQ)) : part == 1 ? ((float*)(F.ws + WS_GK)) : ((float*)(F.ws + WS_GV)));
            const float qs = part == 0 ? 0.08838834764831845f : 1.0f;
            f32x4 xq[8];
#pragma unroll
            for (int u = 0; u < 8; ++u) xq[u] = (u < nt) ? *(const f32x4*)(PROJp + (size_t)(row0 + u) * NIN + PCONV + c) : z4;
#pragma unroll 1
            for (int tt0 = 0; tt0 < nt; tt0 += 8) {
                f32x4 xn[8];
#pragma unroll
                for (int u = 0; u < 8; ++u) xn[u] = xq[u];
                if (tt0 + 8 < nt) {
#pragma unroll
                    for (int u = 0; u < 8; ++u) xq[u] = *(const f32x4*)(PROJp + (size_t)(row0 + tt0 + 8 + u) * NIN + PCONV + c); }
                f32x4 y[8]; float ss[8];
#pragma unroll
                for (int u = 0; u < 8; ++u) {
                    const f32x4 xm3 = u >= 3 ? xn[u - 3 < 0 ? 0 : u - 3] : (u == 0 ? x0 : u == 1 ? x1 : x2);
                    const f32x4 xm2 = u >= 2 ? xn[u - 2 < 0 ? 0 : u - 2] : (u == 0 ? x1 : x2);
                    const f32x4 xm1 = u >= 1 ? xn[u - 1 < 0 ? 0 : u - 1] : x2;
                    f32x4 v = xm3 * w0 + xm2 * w1 + xm1 * w2 + xn[u] * w3;
#pragma unroll
                    for (int e = 0; e < 4; ++e) v[e] = v[e] * __builtin_amdgcn_rcpf(1.0f + __expf(-v[e]));
                    y[u] = v; ss[u] = (v.x * v.x + v.y * v.y) + (v.z * v.z + v.w * v.w); }
                if (part < 2) {
#pragma unroll
                    for (int o = 1; o < 32; o <<= 1)
#pragma unroll
                        for (int u = 0; u < 8; ++u) ss[u] += __shfl_xor(ss[u], o);
#pragma unroll
                    for (int u = 0; u < 8; ++u) y[u] = y[u] * (__builtin_amdgcn_rsqf(ss[u] + EPS) * qs); }
#pragma unroll
                for (int u = 0; u < 8; ++u) if (tt0 + u < nt) *(f32x4*)(dstb + ((size_t)(row0 + tt0 + u) * 8 + head) * 128 + 4 * j) = y[u];
                x0 = xn[5]; x1 = xn[6]; x2 = xn[7];
            }
        }
    }
    if (parts & 4)
    for (size_t i = (size_t)F.bid * NTHR + F.tid; i < (size_t)DB * NKV * 511 * 64; i += (size_t)F.G * NTHR) {
        const int q4 = (int)(i & 63); const size_t rest = i >> 6; const int row = (int)(rest % 511); const int bg = (int)(rest / 511); const int b = bg >> 1, g = bg & 1;
        const size_t base = (((size_t)b * NL + l) * NKV + g) * WIN;
        *(f32x4*)(F.out + O_SWIN + (base + row) * 256 + q4 * 4) = *(const f32x4*)(((const float*)F.in[4]) + (base + row + 1) * 256 + q4 * 4);
    }
}

__device__ __forceinline__ void phase_gdn_scan_naive(Frame& F, int l) {
    const int vb = F.G - 1 - F.bid;
    if (vb >= 32) return;
    const int pi = __builtin_amdgcn_readfirstlane(32 + vb * 2 + (F.tid >> 8)), w = F.tid & 255, col = w >> 1, half = w & 1;
    const int seq = pi >> 3, h = pi & 7;
    const bool isP = seq < 4; const int T = isP ? SEQ : 1; const int row0 = isP ? seq * SEQ : MP + (seq - 4);
    float S[64];
    if (isP) {
#pragma unroll
        for (int d = 0; d < 64; ++d) S[d] = 0.f;
    } else { const float* s0 = ((const float*)F.in[5]) + (((size_t)(seq - 4) * NL + l) * GH + h) * 16384 + (size_t)half * 64 * 128 + col;
#pragma unroll
        for (int d = 0; d < 64; ++d) S[d] = s0[d * 128]; }
    const float* GKp = (const float*)(F.ws + WS_GK); const float* GQp = (const float*)(F.ws + WS_GQ); const float* GVp = (const float*)(F.ws + WS_GV);
    const float* GGp = (const float*)(F.ws + WS_GG); const float* GBp = (const float*)(F.ws + WS_GB); float* GOp = (float*)(F.ws + WS_GO);
#pragma unroll 1
    for (int t = 0; t < T; ++t) {
        const size_t rh = (size_t)(row0 + t) * 8 + h;
        const f32x4* kp = (const f32x4*)(GKp + rh * 128 + half * 64); const f32x4* qp = (const f32x4*)(GQp + rh * 128 + half * 64);
        const float v = GVp[rh * 128 + col], gg = GGp[rh], beta = GBp[rh];
        const float eg = expf(gg);
        f32x4 kk[16];
        float ks0 = 0.f, ks1 = 0.f;
#pragma unroll
        for (int i = 0; i < 16; ++i) { kk[i] = kp[i]; ks0 += kk[i].x * S[4 * i] + kk[i].z * S[4 * i + 2]; ks1 += kk[i].y * S[4 * i + 1] + kk[i].w * S[4 * i + 3]; }
        float kS = ks0 + ks1; kS += __shfl_xor(kS, 1);
        const float cc = beta * (v - eg * kS);
        float o0 = 0.f, o1 = 0.f;
#pragma unroll
        for (int i = 0; i < 16; ++i) { const f32x4 qq = qp[i];
            S[4 * i] = eg * S[4 * i] + kk[i].x * cc; S[4 * i + 1] = eg * S[4 * i + 1] + kk[i].y * cc; S[4 * i + 2] = eg * S[4 * i + 2] + kk[i].z * cc; S[4 * i + 3] = eg * S[4 * i + 3] + kk[i].w * cc;
            o0 += S[4 * i] * qq.x + S[4 * i + 2] * qq.z; o1 += S[4 * i + 1] * qq.y + S[4 * i + 3] * qq.w; }
        float o = o0 + o1; o += __shfl_xor(o, 1);
        if (half == 0) GOp[rh * 128 + col] = o;
    }
    float* so = F.out + (isP ? O_PGDN + (((size_t)seq * NL + l) * GH + h) * 16384 : O_SGDN + (((size_t)(seq - 4) * NL + l) * GH + h) * 16384) + (size_t)half * 64 * 128 + col;
#pragma unroll
    for (int d = 0; d < 64; ++d) so[d * 128] = S[d];
}


__device__ __forceinline__ bf16x8 pack8(f32x4 a, f32x4 b) {
    u32x4 u; u.x = pg8::cvt_pk_bf16(a.x, a.y); u.y = pg8::cvt_pk_bf16(a.z, a.w); u.z = pg8::cvt_pk_bf16(b.x, b.y); u.w = pg8::cvt_pk_bf16(b.z, b.w);
    return __builtin_bit_cast(bf16x8, u);
}
#define MFMA16(a, b, c) __builtin_amdgcn_mfma_f32_16x16x32_bf16((a), (b), (c), 0, 0, 0)


template <int MODE, int PER>
__device__ __forceinline__ void skinny_gemm(Frame& F, const bf16* A, int lda, const bf16* Bt, int K, int nitems, float* outF, bf16* outB, int ldc) {
    const int lane = F.lane, wid = F.wave, q = lane >> 4, r16 = lane & 15;
    LAS float* red = (LAS float*)F.lds;
#pragma unroll 1
    for (int it = F.G - 1 - F.bid; it < nitems; it += F.G) {
        const int n0 = MODE != 1 ? it * 16 : (it >> 3) * 256 + (it & 7) * 16;
        const bf16* ap = A + (size_t)(r16 & 7) * lda + q * 8 + (size_t)wid * PER * 32;
        const bf16* bp0 = Bt + (size_t)(n0 + r16) * K + q * 8 + (size_t)wid * PER * 32;
        f32x4 acc0 = (f32x4){0.f, 0.f, 0.f, 0.f}, acc1 = acc0;
        constexpr int U = (PER % 11 == 0) ? 11 : 8;
#pragma unroll 1
        for (int s0 = 0; s0 < PER; s0 += U) {
            bf16x8 af[U], w0[U], w1[U];
#pragma unroll
            for (int u = 0; u < U; ++u) { af[u] = *(const bf16x8*)(ap + (s0 + u) * 32); w0[u] = *(const bf16x8*)(bp0 + (s0 + u) * 32); if (MODE == 1) w1[u] = *(const bf16x8*)(bp0 + (size_t)128 * K + (s0 + u) * 32); }
#pragma unroll
            for (int u = 0; u < U; ++u) { acc0 = MFMA16(w0[u], af[u], acc0); if (MODE == 1) acc1 = MFMA16(w1[u], af[u], acc1); }
        }
        *(LAS f32x4*)(red + (wid * 2 + 0) * 256 + lane * 4) = acc0;
        if (MODE == 1) *(LAS f32x4*)(red + (wid * 2 + 1) * 256 + lane * 4) = acc1;
        __syncthreads();
        if (wid == 0 && r16 < 8) {
            f32x4 s0v = (f32x4){0.f, 0.f, 0.f, 0.f}, s1v = s0v;
#pragma unroll
            for (int w = 0; w < 8; ++w) { s0v = s0v + *(const LAS f32x4*)(red + (w * 2 + 0) * 256 + lane * 4); if (MODE == 1) s1v = s1v + *(const LAS f32x4*)(red + (w * 2 + 1) * 256 + lane * 4); }
            if (MODE == 0) *(f32x4*)(outF + (size_t)(MP + r16) * ldc + n0 + 4 * q) = s0v;
            else if (MODE == 2) { u32x2 w2; w2.x = pg8::cvt_pk_bf16(s0v[0], s0v[1]); w2.y = pg8::cvt_pk_bf16(s0v[2], s0v[3]); *(u32x2*)(outB + (size_t)(MP + r16) * ldc + n0 + 4 * q) = w2; }
            else { float o[4];
#pragma unroll
                for (int j = 0; j < 4; ++j) o[j] = s0v[j] / (1.0f + __expf(-s0v[j])) * s1v[j];
                u32x2 w2; w2.x = pg8::cvt_pk_bf16(o[0], o[1]); w2.y = pg8::cvt_pk_bf16(o[2], o[3]);
                *(u32x2*)(outB + (size_t)(MP + r16) * ldc + it * 16 + 4 * q) = w2; }
        }
        __syncthreads();
    }
}


template <int MODE, int KSTEPS>
__device__ __forceinline__ void skinny_wave(Frame& F, const bf16* A, int lda, const bf16* Bt, int K, int nitems, float* outF, bf16* outB, int ldc, int rank, int nw) {
    const int lane = F.lane, q = lane >> 4, r16 = lane & 15;
#pragma unroll 1
    for (int it = rank; it < nitems; it += nw) {
        const int n0 = MODE == 0 ? it * 16 : (it >> 3) * 256 + (it & 7) * 16;
        const bf16* ap = A + (size_t)(r16 & 7) * lda + q * 8;
        const bf16* bp = Bt + (size_t)(n0 + r16) * K + q * 8;
        f32x4 acc0 = (f32x4){0.f, 0.f, 0.f, 0.f}, acc1 = acc0;
        constexpr int U = MODE == 0 ? 16 : 8;
#pragma unroll 1
        for (int s0 = 0; s0 < KSTEPS; s0 += U) { bf16x8 af[U], w0[U], w1[U];
#pragma unroll
            for (int u = 0; u < U; ++u) { af[u] = *(const bf16x8*)(ap + (s0 + u) * 32); w0[u] = *(const bf16x8*)(bp + (s0 + u) * 32); if (MODE == 1) w1[u] = *(const bf16x8*)(bp + (size_t)128 * K + (s0 + u) * 32); }
#pragma unroll
            for (int u = 0; u < U; ++u) { if (MODE == 1) { acc0 = MFMA16(w0[u], af[u], acc0); acc1 = MFMA16(w1[u], af[u], acc1); }
                else { if (u & 1) acc1 = MFMA16(w0[u], af[u], acc1); else acc0 = MFMA16(w0[u], af[u], acc0); } } }
        if (r16 < 8) {
            if (MODE == 0) *(f32x4*)(outF + (size_t)(MP + r16) * ldc + n0 + 4 * q) = acc0 + acc1;
            else { float o[4];
#pragma unroll
                for (int j = 0; j < 4; ++j) o[j] = acc0[j] / (1.0f + __expf(-acc0[j])) * acc1[j];
                u32x2 w2; w2.x = pg8::cvt_pk_bf16(o[0], o[1]); w2.y = pg8::cvt_pk_bf16(o[2], o[3]);
                *(u32x2*)(outB + (size_t)(MP + r16) * ldc + it * 16 + 4 * q) = w2; }
        }
    }
}
__device__ __forceinline__ void phase_cmp_direct(Frame& F) {
    const int lane = F.lane, wid = F.wave, q = lane >> 4, r16 = lane & 15;
    LAS unsigned char* lb = F.lds;
    constexpr int BB = 16384;
    const float* cache = (const float*)F.in[2]; const int* page_table = (const int*)F.in[7];
    const bf16* W1B = (const bf16*)(F.ws + WS_W1B); float* HID = (float*)(F.ws + WS_HIDS);
#pragma unroll 1
    for (int u = F.bid; u < 256; u += F.G) {
        const int combo = (u & 7) | (((u >> 3) & 1) << 3), mat = combo >> 2, pk = combo & 3, rt = u >> 4, l = mat >> 1, kv = mat & 1;
        const int rot = rt * 4;
        const float* arow[2];
#pragma unroll
        for (int mt = 0; mt < 2; ++mt) { const int m = rt * 256 + wid * 32 + mt * 16 + r16; const int b = m >> 9, j = (m >> 1) & 255, g = m & 1;
            const int phys = page_table[b * NPG + (j >> 1)];
            arow[mt] = cache + ((((size_t)phys * NL + l) * NKV + g) * PAGE + (j & 1) * 64) * 256 + kv * 128 + (size_t)(16 * pk) * 256 + 8 * q; }
        const bf16* brow[2];
#pragma unroll
        for (int i = 0; i < 2; ++i) brow[i] = W1B + (size_t)mat * 256 * 8192 + ((size_t)(64 * pk) * 256 + wid * 32 + i * 16 + (lane >> 2)) * 32 + (((lane & 3) ^ ((0x78 >> (2 * (lane >> 4))) & 3)) * 8);
#define CMPD_B(t, slot) do { _Pragma("unroll") for (int i = 0; i < 2; ++i) \
            __builtin_amdgcn_global_load_lds((const unsigned*)(brow[i] + (((t) + rot) & 63) * 8192), (LAS unsigned*)(lb + (slot) * BB + (wid * 2 + i) * 1024), 16, 0, 0); } while (0)
#define CMPD_A(t, j) do { const int tt = ((t) + rot) & 63; _Pragma("unroll") for (int mt = 0; mt < 2; ++mt) { const float* ap = arow[mt] + (tt >> 2) * 256 + (tt & 3) * 32; \
            ar[j][2 * mt] = *(const f32x4*)ap; ar[j][2 * mt + 1] = *(const f32x4*)(ap + 4); } } while (0)
        f32x4 acc[2][16];
#pragma unroll
        for (int mt = 0; mt < 2; ++mt)
#pragma unroll
            for (int nt = 0; nt < 16; ++nt) acc[mt][nt] = (f32x4){0.f, 0.f, 0.f, 0.f};
        f32x4 ar[4][4];
        __syncthreads();
#pragma unroll
        for (int j = 0; j < 4; ++j) { CMPD_B(j, j); CMPD_A(j, j); }
        const int boff = r16 * 64 + ((q ^ ((0x78 >> (2 * ((r16 >> 2) & 3))) & 3)) << 4);
        int slot = 0;
#pragma unroll 1
        for (int t0 = 0; t0 < 64; t0 += 4) {
#pragma unroll
            for (int j = 0; j < 4; ++j) {
                const int t = t0 + j;
                if (t0 < 60) asm volatile("s_waitcnt vmcnt(18) lgkmcnt(0)" ::: "memory"); else asm volatile("s_waitcnt vmcnt(0) lgkmcnt(0)" ::: "memory");
                __builtin_amdgcn_s_barrier();
                const LAS unsigned char* bb = lb + slot * BB + boff;
                bf16x8 af[2];
#pragma unroll
                for (int mt = 0; mt < 2; ++mt) af[mt] = pack8(ar[j][2 * mt], ar[j][2 * mt + 1]);
                int ns = slot + 4; if (ns >= 5) ns -= 5;
                if (t0 < 60) { CMPD_B(t + 4, ns); CMPD_A(t + 4, j); }
#pragma unroll
                for (int g2 = 0; g2 < 8; ++g2) { bf16x8 bf[2];
#pragma unroll
                    for (int e = 0; e < 2; ++e) bf[e] = *(const LAS bf16x8*)(bb + (2 * g2 + e) * 1024);
                    __builtin_amdgcn_sched_barrier(0);
#pragma unroll
                    for (int e = 0; e < 2; ++e) { acc[0][2 * g2 + e] = MFMA16(bf[e], af[0], acc[0][2 * g2 + e]); acc[1][2 * g2 + e] = MFMA16(bf[e], af[1], acc[1][2 * g2 + e]); } }
                slot = slot + 1; if (slot >= 5) slot = 0;
            }
        }
#undef CMPD_A
#undef CMPD_B
        float* hp = HID + (size_t)pk * ((size_t)16384 * 256);
#pragma unroll
        for (int mt = 0; mt < 2; ++mt) { float* rp = hp + (size_t)(mat * 4096 + rt * 256 + wid * 32 + mt * 16 + r16) * 256 + 4 * q;
#pragma unroll
            for (int nt = 0; nt < 16; ++nt) *(f32x4*)(rp + 16 * nt) = acc[mt][nt]; }
    }
    __syncthreads();
}

#ifndef GP_W0
#define GP_W0 128
#define GP_NW 8
#endif
__device__ __forceinline__ void phase_gdn_pre(Frame& F, int l) {
    if (F.bid < GP_W0 || F.wave >= GP_NW) return;
    const int NGW = (F.G - GP_W0) * GP_NW, gw = (F.bid - GP_W0) * GP_NW + F.wave;
    const int lane0 = F.lane;
    LAS float* Af = (LAS float*)(F.lds + F.wave * 16896);
    LAS unsigned char* Tb = (LAS unsigned char*)Af;
    const float* GQp = (const float*)(F.ws + WS_GQ); const float* GKp = (const float*)(F.ws + WS_GK); const float* GVp = (const float*)(F.ws + WS_GV);
    const float* GGp = (const float*)(F.ws + WS_GG); const float* GBp = (const float*)(F.ws + WS_GB); float* GDECp = (float*)(F.ws + WS_GDEC);
#pragma unroll 1
    for (int it = gw; it < 1024; it += NGW) {
        int lane = lane0; asm volatile("" : "+v"(lane));
        const int q = lane >> 4, r16 = lane & 15;
        const int c = it & 31, p = it >> 5, h = p & 7, b = p >> 3;
        const int row0 = b * SEQ + c * 64;
        unsigned char* fr = F.ws + WS_GFR + (size_t)it * FR_CH;
        const float gg = GGp[(size_t)(row0 + lane) * 8 + h], bt = GBp[(size_t)(row0 + lane) * 8 + h];
        float gc = gg;
#pragma unroll
        for (int o = 1; o < 64; o <<= 1) { const float tt = __shfl_up(gc, o); if (lane >= o) gc += tt; }
        const float gl = __shfl(gc, 63);
        if (lane == 0) GDECp[it] = __expf(gl);
        bf16x8 kf[4][4];
#pragma unroll
        for (int mt = 0; mt < 4; ++mt)
#pragma unroll
            for (int s = 0; s < 4; ++s) { const float* kr = GKp + ((size_t)(row0 + 16 * mt + r16) * 8 + h) * 128 + 32 * s + 4 * q; kf[mt][s] = pack8(*(const f32x4*)kr, *(const f32x4*)(kr + 16)); }
        asm volatile("s_waitcnt lgkmcnt(0)" ::: "memory");
#pragma unroll
        for (int mt = 0; mt < 4; ++mt)
#pragma unroll
            for (int nt = 0; nt <= mt; ++nt) {
                f32x4 acc = (f32x4){0.f, 0.f, 0.f, 0.f};
#pragma unroll
                for (int s = 0; s < 4; ++s) acc = MFMA16(kf[mt][s], kf[nt][s], acc);
                const int j = 16 * nt + r16; const float gcj = __shfl(gc, j);
#pragma unroll
                for (int r = 0; r < 4; ++r) { const int i = 16 * mt + 4 * q + r; const float gi = __shfl(gc, i), bi = __shfl(bt, i);
                    Af[i * 64 + j] = (j < i) ? bi * acc[r] * __expf(gi - gcj) : 0.f; }
            }
        {
            bf16x8 qf[4][4];
#pragma unroll
            for (int mt = 0; mt < 4; ++mt) { const float egi = __expf(__shfl(gc, 16 * mt + r16));
#pragma unroll
                for (int s = 0; s < 4; ++s) { const float* qr = GQp + ((size_t)(row0 + 16 * mt + r16) * 8 + h) * 128 + 32 * s + 4 * q;
                    const f32x4 a = *(const f32x4*)qr, b2 = *(const f32x4*)(qr + 16); qf[mt][s] = pack8(a, b2);
                    *(bf16x8*)(fr + FR_Q + ((mt * 4 + s) * 64 + lane) * 16) = pack8(a * egi, b2 * egi); } }
#pragma unroll
            for (int nt = 0; nt < 4; ++nt) { const int i = 16 * nt + r16; const float gci = __shfl(gc, i);
#pragma unroll
                for (int sp = 0; sp < 2; ++sp) { f32x4 v0 = (f32x4){0.f, 0.f, 0.f, 0.f}, v1 = v0;
                    if (2 * sp <= nt) { f32x4 acc = (f32x4){0.f, 0.f, 0.f, 0.f};
#pragma unroll
                        for (int s = 0; s < 4; ++s) acc = MFMA16(kf[2 * sp][s], qf[nt][s], acc);
#pragma unroll
                        for (int r = 0; r < 4; ++r) { const int jp = 32 * sp + 4 * q + r; const float gj = __shfl(gc, jp); v0[r] = (jp <= i) ? acc[r] * __expf(gci - gj) : 0.f; } }
                    if (2 * sp + 1 <= nt) { f32x4 acc = (f32x4){0.f, 0.f, 0.f, 0.f};
#pragma unroll
                        for (int s = 0; s < 4; ++s) acc = MFMA16(kf[2 * sp + 1][s], qf[nt][s], acc);
#pragma unroll
                        for (int r = 0; r < 4; ++r) { const int jp = 32 * sp + 16 + 4 * q + r; const float gj = __shfl(gc, jp); v1[r] = (jp <= i) ? acc[r] * __expf(gci - gj) : 0.f; } }
                    *(bf16x8*)(fr + FR_QK + ((nt * 2 + sp) * 64 + lane) * 16) = pack8(v0, v1); } }
        }
        float t[64];
#pragma unroll
        for (int i = 0; i < 64; ++i) {
            float acc = (lane == i) ? 1.f : 0.f;
#pragma unroll
            for (int j4 = 0; j4 < (i + 3) / 4; ++j4) { const f32x4 a = *(const LAS f32x4*)(Af + i * 64 + j4 * 4);
                if (4 * j4 + 0 < i) acc -= a.x * t[4 * j4 + 0];
                if (4 * j4 + 1 < i) acc -= a.y * t[4 * j4 + 1];
                if (4 * j4 + 2 < i) acc -= a.z * t[4 * j4 + 2];
                if (4 * j4 + 3 < i) acc -= a.w * t[4 * j4 + 3]; }
            t[i] = acc;
            if ((i & 3) == 3) asm volatile("" ::: "memory");
        }
        asm volatile("s_waitcnt lgkmcnt(0)" ::: "memory");
        { const float sb = bt, sg = bt * __expf(gc);
#pragma unroll
          for (int i = 0; i < 64; ++i) { const int off = i * 128 + ((((lane >> 3) ^ (i & 7)) << 4) + (lane & 7) * 2);
              *(LAS unsigned short*)(Tb + off) = (unsigned short)f2bf(t[i] * sb); *(LAS unsigned short*)(Tb + 8192 + off) = (unsigned short)f2bf(t[i] * sg); } }
        asm volatile("s_waitcnt lgkmcnt(0)" ::: "memory");
        {
            bf16x8 ta[4][2];
#pragma unroll
            for (int mt = 0; mt < 4; ++mt)
#pragma unroll
                for (int sp = 0; sp < 2; ++sp) ta[mt][sp] = *(const LAS bf16x8*)(Tb + (16 * mt + r16) * 128 + (((4 * sp + q) ^ (r16 & 7)) << 4));
#pragma unroll 4
            for (int n8 = 0; n8 < 8; ++n8) { bf16x8 vb[2];
#pragma unroll
                for (int sp = 0; sp < 2; ++sp) { float x[8];
#pragma unroll
                    for (int jj = 0; jj < 8; ++jj) x[jj] = GVp[((size_t)(row0 + 32 * sp + 8 * q + jj) * 8 + h) * 128 + 16 * n8 + r16];
                    vb[sp] = pack8((f32x4){x[0], x[1], x[2], x[3]}, (f32x4){x[4], x[5], x[6], x[7]}); }
#pragma unroll
                for (int mt = 0; mt < 4; ++mt) { f32x4 acc = (f32x4){0.f, 0.f, 0.f, 0.f};
#pragma unroll
                    for (int sp = 0; sp < 2; ++sp) acc = MFMA16(ta[mt][sp], vb[sp], acc);
                    *(f32x4*)(fr + FR_U + ((n8 * 4 + mt) * 64 + lane) * 16) = acc; } }
        }
        {
            float fdec[2][8]; const float ed = __expf(gl - gc);
#pragma unroll
            for (int sp = 0; sp < 2; ++sp)
#pragma unroll
                for (int j = 0; j < 8; ++j) fdec[sp][j] = __shfl(ed, 32 * sp + (j < 4 ? 4 * q + j : 16 + 4 * q + j - 4));
            bf16x8 tb[4][2];
#pragma unroll
            for (int nt = 0; nt < 4; ++nt)
#pragma unroll
                for (int sp = 0; sp < 2; ++sp) { const int i = 16 * nt + r16;
                    const u32x2 lo = *(const LAS u32x2*)(Tb + 8192 + i * 128 + ((((4 * sp + (q >> 1)) ^ (i & 7)) << 4) + (q & 1) * 8));
                    const u32x2 hi = *(const LAS u32x2*)(Tb + 8192 + i * 128 + ((((4 * sp + 2 + (q >> 1)) ^ (i & 7)) << 4) + (q & 1) * 8));
                    u32x4 w4; w4.x = lo.x; w4.y = lo.y; w4.z = hi.x; w4.w = hi.y; tb[nt][sp] = __builtin_bit_cast(bf16x8, w4); }
#pragma unroll 2
            for (int s = 0; s < 4; ++s) {
                f32x4 acc[2][4];
#pragma unroll
                for (int e = 0; e < 2; ++e)
#pragma unroll
                    for (int nt = 0; nt < 4; ++nt) acc[e][nt] = (f32x4){0.f, 0.f, 0.f, 0.f};
#pragma unroll
                for (int e = 0; e < 2; ++e)
#pragma unroll
                    for (int sp = 0; sp < 2; ++sp) { float x[8];
#pragma unroll
                        for (int j = 0; j < 8; ++j) { const int tok = 32 * sp + (j < 4 ? 4 * q + j : 16 + 4 * q + j - 4);
                            x[j] = GKp[((size_t)(row0 + tok) * 8 + h) * 128 + 16 * (2 * s + e) + r16]; }
                        const bf16x8 ka = pack8((f32x4){x[0], x[1], x[2], x[3]}, (f32x4){x[4], x[5], x[6], x[7]});
#pragma unroll
                        for (int nt = 0; nt < 4; ++nt) acc[e][nt] = MFMA16(ka, tb[nt][sp], acc[e][nt]);
#pragma unroll
                        for (int j = 0; j < 8; ++j) x[j] *= fdec[sp][j];
                        *(bf16x8*)(fr + FR_K + (((2 * s + e) * 2 + sp) * 64 + lane) * 16) = pack8((f32x4){x[0], x[1], x[2], x[3]}, (f32x4){x[4], x[5], x[6], x[7]}); }
#pragma unroll
                for (int nt = 0; nt < 4; ++nt) *(bf16x8*)(fr + FR_W + ((nt * 4 + s) * 64 + lane) * 16) = pack8(-acc[0][nt], -acc[1][nt]);
            }
        }
        asm volatile("s_waitcnt lgkmcnt(0)" ::: "memory");
    }
}

__device__ __forceinline__ void phase_gdn_scan(Frame& F, int l) {
    if (F.bid >= 64) return;
    const int lane = F.lane, wid = F.wave, q = lane >> 4, r16 = lane & 15;
    const int hf = (F.bid >> 3) & 1, p = (F.bid >> 4) * 8 + (F.bid & 7), h = p & 7, b = p >> 3;
    const float* GDECp = (const float*)(F.ws + WS_GDEC); float* GOp = (float*)(F.ws + WS_GO);
    LAS unsigned char* lb = F.lds;
    constexpr int CB = 57344, UB = 16384, UOFF = 2 * CB, DOFF = 2 * CB + 2 * UB;
    __syncthreads();
    if (wid >= 4) {
        const int lw = wid - 4, sl = hf * 4 + lw;
        const unsigned char* fr = F.ws + WS_GFR + (size_t)(p * 32) * FR_CH;
#pragma unroll
        for (int f = 0; f < 14; ++f) __builtin_amdgcn_global_load_lds((const unsigned*)(fr + (lw + 4 * f) * 1024 + lane * 16), (LAS unsigned*)(lb + (lw + 4 * f) * 1024), 16, 0, 0);
        f32x4 u4[4];
#pragma unroll
        for (int mt = 0; mt < 4; ++mt) u4[mt] = *(const f32x4*)(fr + FR_U + ((sl * 4 + mt) * 64 + lane) * 16);
        const float d0 = GDECp[p * 32];
#pragma unroll
        for (int mt = 0; mt < 4; ++mt) *(LAS f32x4*)(lb + UOFF + (lw * 4 + mt) * 1024 + lane * 16) = u4[mt];
        if (wid == 4 && lane == 0) *(LAS float*)(lb + DOFF) = d0;
        asm volatile("s_waitcnt vmcnt(0) lgkmcnt(0)" ::: "memory");
    }
    __builtin_amdgcn_s_barrier();
    f32x4 S[8];
#pragma unroll
    for (int m = 0; m < 8; ++m) S[m] = (f32x4){0.f, 0.f, 0.f, 0.f};
    const int sl = hf * 4 + (wid & 3);
#pragma unroll 1
    for (int c = 0; c < 32; ++c) {
        if (wid >= 4) {
            if (c + 1 < 32) {
                const int lw = wid - 4, nbuf = (c + 1) & 1;
                const unsigned char* fr = F.ws + WS_GFR + (size_t)(p * 32 + c + 1) * FR_CH; LAS unsigned char* nb = lb + nbuf * CB;
#pragma unroll
                for (int f = 0; f < 14; ++f) __builtin_amdgcn_global_load_lds((const unsigned*)(fr + (lw + 4 * f) * 1024 + lane * 16), (LAS unsigned*)(nb + (lw + 4 * f) * 1024), 16, 0, 0);
                f32x4 u4[4];
#pragma unroll
                for (int mt = 0; mt < 4; ++mt) u4[mt] = *(const f32x4*)(fr + FR_U + ((sl * 4 + mt) * 64 + lane) * 16);
                const float dn = GDECp[p * 32 + c + 1];
#pragma unroll
                for (int mt = 0; mt < 4; ++mt) *(LAS f32x4*)(lb + UOFF + nbuf * UB + (lw * 4 + mt) * 1024 + lane * 16) = u4[mt];
                if (wid == 4 && lane == 0) *(LAS float*)(lb + DOFF + nbuf * 64) = dn;
                asm volatile("s_waitcnt vmcnt(0) lgkmcnt(0)" ::: "memory");
            }
        } else {
            const LAS unsigned char* cb = lb + (c & 1) * CB;
            const float dec = *(const LAS float*)(lb + DOFF + (c & 1) * 64);
            f32x4 vn[4], o[4];
#pragma unroll
            for (int mt = 0; mt < 4; ++mt) { vn[mt] = *(const LAS f32x4*)(lb + UOFF + (c & 1) * UB + (wid * 4 + mt) * 1024 + lane * 16); o[mt] = (f32x4){0.f, 0.f, 0.f, 0.f}; }
            bf16x8 Sb[4];
#pragma unroll
            for (int s = 0; s < 4; ++s) Sb[s] = pack8(S[2 * s], S[2 * s + 1]);
#pragma unroll
            for (int s = 0; s < 4; ++s) { bf16x8 wf[4], qf[4];
#pragma unroll
                for (int mt = 0; mt < 4; ++mt) { wf[mt] = *(const LAS bf16x8*)(cb + FR_W + ((mt * 4 + s) * 64 + lane) * 16); qf[mt] = *(const LAS bf16x8*)(cb + FR_Q + ((mt * 4 + s) * 64 + lane) * 16); }
#pragma unroll
                for (int mt = 0; mt < 4; ++mt) { vn[mt] = MFMA16(wf[mt], Sb[s], vn[mt]); o[mt] = MFMA16(qf[mt], Sb[s], o[mt]); } }
            bf16x8 Vb[2];
#pragma unroll
            for (int sp = 0; sp < 2; ++sp) Vb[sp] = pack8(vn[2 * sp], vn[2 * sp + 1]);
#pragma unroll
            for (int m2 = 0; m2 < 4; ++m2) { bf16x8 kf[4];
#pragma unroll
                for (int e = 0; e < 4; ++e) kf[e] = *(const LAS bf16x8*)(cb + FR_K + (((2 * m2 + (e >> 1)) * 2 + (e & 1)) * 64 + lane) * 16);
                S[2 * m2] = S[2 * m2] * dec; S[2 * m2 + 1] = S[2 * m2 + 1] * dec;
                S[2 * m2] = MFMA16(kf[0], Vb[0], S[2 * m2]); S[2 * m2 + 1] = MFMA16(kf[2], Vb[0], S[2 * m2 + 1]);
                S[2 * m2] = MFMA16(kf[1], Vb[1], S[2 * m2]); S[2 * m2 + 1] = MFMA16(kf[3], Vb[1], S[2 * m2 + 1]); }
            { bf16x8 gf[8];
#pragma unroll
              for (int e = 0; e < 8; ++e) gf[e] = *(const LAS bf16x8*)(cb + FR_QK + (e * 64 + lane) * 16);
#pragma unroll
              for (int mt = 0; mt < 4; ++mt) { o[mt] = MFMA16(gf[mt * 2], Vb[0], o[mt]); }
#pragma unroll
              for (int mt = 0; mt < 4; ++mt) { o[mt] = MFMA16(gf[mt * 2 + 1], Vb[1], o[mt]); } }
#pragma unroll
            for (int mt = 0; mt < 4; ++mt)
#pragma unroll
                for (int r = 0; r < 4; ++r) GOp[((size_t)(b * SEQ + c * 64 + 16 * mt + 4 * q + r) * 8 + h) * 128 + sl * 16 + r16] = o[mt][r];
            asm volatile("s_waitcnt lgkmcnt(0)" ::: "memory");
        }
        __builtin_amdgcn_s_barrier();
    }
    if (wid < 4) {
        float* so = F.out + O_PGDN + (((size_t)b * NL + l) * GH + h) * 16384 + sl * 16 + r16;
#pragma unroll
        for (int m = 0; m < 8; ++m)
#pragma unroll
            for (int r = 0; r < 4; ++r) so[(size_t)(16 * m + 4 * q + r) * 128] = S[m][r];
    }
    __syncthreads();
}

__device__ __forceinline__ void phase_gdn_out(Frame& F, int l) {
    if (F.bid < 16 || F.bid >= 128) return;
    const int lane = F.lane, qb = F.bid >> 3;
    int cum = (F.bid & 7) * (20 - qb);
    for (int qq = 2; qq < qb; ++qq) cum += 8 * (20 - qq);
    const int r_lo = (int)(((long)MT * cum) / 1288), r_hi = (int)(((long)MT * (cum + 20 - qb)) / 1288);
    const float* gn = ((const float*)F.in[20]) + l * 128;
    const float g0 = gn[lane], g1 = gn[64 + lane];
    for (int r = r_lo + F.wave; r < r_hi; r += NWAVES) {
        const float* go = ((const float*)(F.ws + WS_GO)) + (size_t)r * 1024; const float* z = ((const float*)(F.ws + WS_PROJ)) + (size_t)r * NIN + PZ;
        float o[16], zz[16], ss[8];
#pragma unroll
        for (int i = 0; i < 16; ++i) { o[i] = go[(i >> 1) * 128 + (i & 1) * 64 + lane]; zz[i] = z[(i >> 1) * 128 + (i & 1) * 64 + lane]; }
#pragma unroll
        for (int h = 0; h < 8; ++h) ss[h] = o[2 * h] * o[2 * h] + o[2 * h + 1] * o[2 * h + 1];
#pragma unroll
        for (int ofs = 1; ofs < 64; ofs <<= 1)
#pragma unroll
            for (int h = 0; h < 8; ++h) ss[h] += __shfl_xor(ss[h], ofs);
        bf16* dst = ((bf16*)(F.ws + WS_OMIX)) + (size_t)r * DM + 1024;
#pragma unroll
        for (int h = 0; h < 8; ++h) { const float rs = __builtin_amdgcn_rsqf(ss[h] * (1.0f / 128.0f) + EPS);
            dst[h * 128 + lane] = (bf16)f2bf(o[2 * h] * rs * g0 * (zz[2 * h] * __builtin_amdgcn_rcpf(1.0f + __expf(-zz[2 * h])))); dst[h * 128 + 64 + lane] = (bf16)f2bf(o[2 * h + 1] * rs * g1 * (zz[2 * h + 1] * __builtin_amdgcn_rcpf(1.0f + __expf(-zz[2 * h + 1])))); }
    }
}

struct Soft { float m[4], l[4], a0[4], a1[4]; };
__device__ __forceinline__ void soft_init(Soft& s) {
#pragma unroll
    for (int i = 0; i < 4; ++i) { s.m[i] = -INFINITY; s.l[i] = 0.f; s.a0[i] = 0.f; s.a1[i] = 0.f; }
}
__device__ __forceinline__ void attn_block(const LAS float* qs, const float* kptr, const float* vbase, int vstride, int k_lo, int k_hi, int lane, Soft& st, float (&sout)[4]) {
    const bool valid = lane >= k_lo && lane <= k_hi;
    float s[4] = {0.f, 0.f, 0.f, 0.f};
    if (valid) {
#pragma unroll 1
        for (int half = 0; half < 2; ++half) { f32x4 kk[16];
#pragma unroll
            for (int i = 0; i < 16; ++i) kk[i] = *(const f32x4*)(kptr + half * 64 + i * 4);
#pragma unroll
            for (int i = 0; i < 16; ++i)
#pragma unroll
                for (int hh = 0; hh < 4; ++hh) { const f32x4 qq = *(const LAS f32x4*)(qs + hh * 128 + half * 64 + i * 4); s[hh] += (kk[i].x * qq.x + kk[i].y * qq.y) + (kk[i].z * qq.z + kk[i].w * qq.w); } }
    }
    float p[4];
#pragma unroll
    for (int hh = 0; hh < 4; ++hh) {
        s[hh] = valid ? s[hh] * 0.08838834764831845f : -INFINITY; sout[hh] = s[hh];
        const float mn = fmaxf(st.m[hh], wave_max(s[hh]));
        const float corr = (st.m[hh] == -INFINITY) ? 0.f : expf(st.m[hh] - mn);
        p[hh] = valid ? expf(s[hh] - mn) : 0.f;
        st.l[hh] = st.l[hh] * corr + wave_sum(p[hh]); st.a0[hh] *= corr; st.a1[hh] *= corr; st.m[hh] = mn;
    }
    int k = k_lo;
#pragma unroll 1
    for (; k + 7 <= k_hi; k += 8) { float v0[8], v1[8];
#pragma unroll
        for (int e = 0; e < 8; ++e) { const float* vr = vbase + (size_t)(k + e) * vstride; v0[e] = vr[lane]; v1[e] = vr[64 + lane]; }
#pragma unroll
        for (int e = 0; e < 8; ++e)
#pragma unroll
            for (int hh = 0; hh < 4; ++hh) { const float pb = __shfl(p[hh], k + e); st.a0[hh] += pb * v0[e]; st.a1[hh] += pb * v1[e]; } }
#pragma unroll 1
    for (; k <= k_hi; ++k) { const float* vr = vbase + (size_t)k * vstride; const float v0 = vr[lane], v1 = vr[64 + lane];
#pragma unroll
        for (int hh = 0; hh < 4; ++hh) { const float pb = __shfl(p[hh], k); st.a0[hh] += pb * v0; st.a1[hh] += pb * v1; } }
}

__device__ __forceinline__ void phase_nsa_sample(Frame& F, int l) {
    if (F.bid >= MS * 2) return;
    const int tid = F.tid, lane = F.lane, wid = F.wave;
    const int s = F.bid >> 1, g = F.bid & 1, r = MP + s;
    LAS float* qs = (LAS float*)F.lds;
    LAS float* imps = qs + 512;
    LAS unsigned* selw = (LAS unsigned*)(imps + 256);
    LAS float* part = imps + 512;
    constexpr int PST = 520;
    const float* QFp = (const float*)(F.ws + WS_QF); const float* CBSp = (const float*)(F.ws + WS_CBS); const float* GATp = (const float*)(F.ws + WS_GATES);
    const float* cache_sel = (const float*)F.in[3]; const float* cache_win = (const float*)F.in[4]; const int* page_table = (const int*)F.in[7];
    __syncthreads();
    qs[tid] = QFp[((size_t)r * 8 + g * 4) * 128 + tid];
    __syncthreads();
    Soft sc, ss, sw; soft_init(sc); soft_init(ss); soft_init(sw);
    float sraw[4] = {0.f, 0.f, 0.f, 0.f}, sdum[4];
    const float* kcb = CBSp + (((size_t)(l * 2 + 0) * 4096) + ((size_t)s * 256) * 2 + g) * 128; const float* vcb = kcb + (size_t)4096 * 128;
    if (wid < 4) attn_block(qs, kcb + ((size_t)wid * 64 + lane) * 256, vcb + (size_t)wid * 64 * 256, 256, 0, 63, lane, sc, sraw);
    { LAS float* pp = part + (wid * 3 + 0) * PST;
#pragma unroll
      for (int hh = 0; hh < 4; ++hh) { if (lane == 0) { pp[hh] = sc.m[hh]; pp[4 + hh] = sc.l[hh]; } pp[8 + hh * 128 + lane] = sc.a0[hh]; pp[8 + hh * 128 + 64 + lane] = sc.a1[hh]; } }
    __syncthreads();
    if (wid < 4) {
        float imp = 0.f;
#pragma unroll
        for (int hh = 0; hh < 4; ++hh) { float M = -INFINITY;
#pragma unroll
            for (int w = 0; w < 4; ++w) M = fmaxf(M, part[(w * 3) * PST + hh]);
            float L = 0.f;
#pragma unroll
            for (int w = 0; w < 4; ++w) L += part[(w * 3) * PST + 4 + hh] * expf(part[(w * 3) * PST + hh] - M);
            imp += expf(sraw[hh] - M) / L; }
        imps[wid * 64 + lane] = imp;
    }
    __syncthreads();
    if (wid < 4) {
        const int j = tid; const float mine = imps[j]; int cnt = 0;
#pragma unroll 2
        for (int jj = 1; jj <= 254; ++jj) { const float o = imps[jj]; cnt += (o > mine || (o == mine && jj < j)) ? 1 : 0; }
        const bool sel = (j == 0) || (j == 255) || (j >= 1 && j <= 254 && cnt < 13);
        const unsigned long long bal = __ballot(sel);
        if (lane == 0) { selw[wid * 2] = (unsigned)bal; selw[wid * 2 + 1] = (unsigned)(bal >> 32); }
    }
    __syncthreads();
    if (wid < 4) {
        const int j = tid; const unsigned lo = selw[wid * 2], hi = selw[wid * 2 + 1];
        const unsigned long long bal = ((unsigned long long)hi << 32) | lo;
        if ((bal >> lane) & 1ull) { int pos = __popcll(bal & ((1ull << lane) - 1ull));
            for (int w = 0; w < wid; ++w) pos += __popc(selw[w * 2]) + __popc(selw[w * 2 + 1]);
            if (pos < 15) selw[8 + pos] = (unsigned)j; }
    }
    __syncthreads();
#pragma unroll 1
    for (int t = wid; t < 25; t += 8) {
        if (t < 15) { const int idx = (int)selw[8 + t];
            const int phys = page_table[s * NPG + (idx >> 1)];
            const float* blk = cache_sel + (((((size_t)phys * NL + l) * NKV + g) * 2 + (idx & 1)) * 64) * 256;
            attn_block(qs, blk + (size_t)lane * 256, blk + 128, 256, 0, 63, lane, ss, sdum);
        } else if (t == 15) { const float* nw = F.out + O_SSEL + (((size_t)s * NL + l) * NKV + g) * 256;
            attn_block(qs, nw, nw + 128, 256, 0, 0, lane, ss, sdum);
        } else if (t < 24) { const int c = t - 16; const float* wb = cache_win + ((((size_t)s * NL + l) * NKV + g) * WIN) * 256;
            attn_block(qs, wb + ((size_t)c * 64 + lane) * 256, wb + (size_t)c * 64 * 256 + 128, 256, 0, 63, lane, sw, sdum);
        } else { const float* nw = F.out + O_SWIN + ((((size_t)s * NL + l) * NKV + g) * WIN + (WIN - 1)) * 256;
            attn_block(qs, nw, nw + 128, 256, 0, 0, lane, sw, sdum); }
    }
    { LAS float* p1 = part + (wid * 3 + 1) * PST; LAS float* p2 = part + (wid * 3 + 2) * PST;
#pragma unroll
      for (int hh = 0; hh < 4; ++hh) { if (lane == 0) { p1[hh] = ss.m[hh]; p1[4 + hh] = ss.l[hh]; p2[hh] = sw.m[hh]; p2[4 + hh] = sw.l[hh]; }
          p1[8 + hh * 128 + lane] = ss.a0[hh]; p1[8 + hh * 128 + 64 + lane] = ss.a1[hh]; p2[8 + hh * 128 + lane] = sw.a0[hh]; p2[8 + hh * 128 + 64 + lane] = sw.a1[hh]; } }
    __syncthreads();
    { const int hh = tid >> 7, d = tid & 127; float res = 0.f;
#pragma unroll
      for (int br = 0; br < 3; ++br) { const int nw = br == 0 ? 4 : 8; float M = -INFINITY;
          for (int w = 0; w < nw; ++w) M = fmaxf(M, part[(w * 3 + br) * PST + hh]);
          float L = 0.f, A = 0.f;
          for (int w = 0; w < nw; ++w) { const float mw = part[(w * 3 + br) * PST + hh]; if (mw == -INFINITY) continue; const float e = expf(mw - M);
              L += part[(w * 3 + br) * PST + 4 + hh] * e; A += part[(w * 3 + br) * PST + 8 + hh * 128 + d] * e; }
          const float gt = GATp[(size_t)r * 24 + (g * 4 + hh) * 3 + br];
          res += L > 0.f ? gt * A / L : 0.f; }
      ((bf16*)(F.ws + WS_OMIX))[(size_t)r * DM + (g * 4 + hh) * 128 + d] = (bf16)f2bf(res); }
    __syncthreads();
}

namespace att {
typedef short s16x4 __attribute__((ext_vector_type(4)));
typedef float f32x16 __attribute__((ext_vector_type(16)));
constexpr int SHM = 16384;
constexpr float SCALE = 0.08838834764831845f, THR = 8.f, C2 = 1.4426950408889634f * SCALE;
#define ATT_KSWZ(row, colB) ((row) * 256 + ((colB) ^ (((row) & 7) << 4)))
#define ATT_SBAR() __builtin_amdgcn_sched_barrier(0)
__device__ __forceinline__ int v_st(int k, int c) { const int kk = (k & ~0xC) | ((k & 4) << 1) | ((k & 8) >> 1); return ((kk >> 3) * 4 + (c >> 5)) * 512 + ((kk & 7) * 32 + (c & 31)) * 2; }
__device__ __forceinline__ int v_rd_base(int lane) { return ((lane & 3) << 3) | (((lane >> 2) & 3) << 6) | (((lane >> 4) & 1) << 5) | (((lane >> 5) & 1) << 8); }
constexpr int v_rd_off(int d0, int ks, int half) { return d0 * 512 + ks * 4096 + half * 2048; }
__device__ __forceinline__ int crow(int r, int hi) { return (r & 3) + 8 * (r >> 2) + 4 * hi; }
__device__ __forceinline__ void partialSM(f32x16& p0, f32x16& p1, float& m_reg, float& mn, float& alpha) {
    float pmax = p0[0];
#pragma unroll
    for (int r = 1; r < 16; ++r) pmax = fmaxf(pmax, p0[r]);
#pragma unroll
    for (int r = 0; r < 16; ++r) pmax = fmaxf(pmax, p1[r]);
    { auto rr = __builtin_amdgcn_permlane32_swap(__float_as_uint(pmax), __float_as_uint(pmax), false, false);
      pmax = fmaxf(__uint_as_float(rr[0]), __uint_as_float(rr[1])); }
    if (__builtin_expect(__all((pmax - m_reg) * SCALE <= THR), 1)) { mn = m_reg; alpha = 1.f; }
    else { mn = fmaxf(m_reg, pmax); alpha = __builtin_amdgcn_exp2f((m_reg - mn) * C2); m_reg = mn; }
    const float mnL = -mn * C2;
#pragma unroll
    for (int r = 0; r < 16; ++r) p0[r] = fmaf(p0[r], C2, mnL);
#pragma unroll
    for (int r = 0; r < 16; ++r) p1[r] = fmaf(p1[r], C2, mnL);
#pragma unroll
    for (int r = 0; r < 16; ++r) p0[r] = __builtin_amdgcn_exp2f(p0[r]);
}
__device__ __forceinline__ void finishSM(f32x16& p0, f32x16& p1, float alpha, float& l_reg, bf16x8& pa0, bf16x8& pa1, bf16x8& pa2, bf16x8& pa3) {
#pragma unroll
    for (int r = 0; r < 16; ++r) p1[r] = __builtin_amdgcn_exp2f(p1[r]);
    float ps = 0;
#pragma unroll
    for (int r = 0; r < 16; ++r) ps += p0[r];
#pragma unroll
    for (int r = 0; r < 16; ++r) ps += p1[r];
    { auto rr = __builtin_amdgcn_permlane32_swap(__float_as_uint(ps), __float_as_uint(ps), false, false);
      ps = __uint_as_float(rr[0]) + __uint_as_float(rr[1]); }
    l_reg = l_reg * alpha + ps;
#define ATT_PK4(P, B_, OUT) do { unsigned a0 = pg8::cvt_pk_bf16(P[B_+0], P[B_+1]), a1 = pg8::cvt_pk_bf16(P[B_+2], P[B_+3]);                          \
        unsigned b0 = pg8::cvt_pk_bf16(P[B_+4], P[B_+5]), b1 = pg8::cvt_pk_bf16(P[B_+6], P[B_+7]);                                             \
        auto r0 = __builtin_amdgcn_permlane32_swap(a0, b0, false, false); auto r1 = __builtin_amdgcn_permlane32_swap(a1, b1, false, false); \
        u32x4 w = {r0[0], r1[0], r0[1], r1[1]}; OUT = __builtin_bit_cast(bf16x8, w); } while (0)
    ATT_PK4(p0, 0, pa0); ATT_PK4(p0, 8, pa1); ATT_PK4(p1, 0, pa2); ATT_PK4(p1, 8, pa3);
#undef ATT_PK4
}
template <bool ZERO>
__device__ __forceinline__ void qkt(f32x16& p0, f32x16& p1, const LAS char* Kb, int r32, int hi, const bf16x8* qr) {
    if (ZERO) { p0 = f32x16{}; p1 = f32x16{}; }
    const LAS char* kb[4];
#pragma unroll
    for (int dd = 0; dd < 4; ++dd) kb[dd] = Kb + ATT_KSWZ(r32, (dd * 16 + hi * 8) * 2);
#pragma unroll
    for (int d0 = 0; d0 < 8; ++d0) { const LAS char* a = kb[d0 & 3] + (d0 >> 2) * 128;
        const bf16x8 b0 = *(const LAS bf16x8*)a;
        const bf16x8 b1 = *(const LAS bf16x8*)(a + 32 * 256);
        p0 = __builtin_amdgcn_mfma_f32_32x32x16_bf16(b0, qr[d0], p0, 0, 0, 0);
        p1 = __builtin_amdgcn_mfma_f32_32x32x16_bf16(b1, qr[d0], p1, 0, 0, 0); }
}
__device__ __forceinline__ void pv_tile(f32x16* o, int vb0, bf16x8 pa0, bf16x8 pa1, bf16x8 pa2, bf16x8 pa3) {
#define ATT_TRRD(dst, off) asm volatile("ds_read_b64_tr_b16 %0, %1 offset:%2" : "=&v"(dst) : "v"(vb0), "i"(off) : "memory")
#define ATT_PV_D0(d0) do { s16x4 l0, l1, l2, l3, h0, h1, h2, h3; constexpr int b_ = v_rd_off(d0, 0, 0); \
        ATT_TRRD(l0, b_); ATT_TRRD(h0, b_ + 2048); ATT_TRRD(l1, b_ + 4096); ATT_TRRD(h1, b_ + 6144); ATT_TRRD(l2, b_ + 8192); ATT_TRRD(h2, b_ + 10240); ATT_TRRD(l3, b_ + 12288); ATT_TRRD(h3, b_ + 14336); \
        asm volatile("s_waitcnt lgkmcnt(0)" ::: "memory"); ATT_SBAR();   \
        o[d0] = __builtin_amdgcn_mfma_f32_32x32x16_bf16(pa0, (bf16x8){l0[0], l0[1], l0[2], l0[3], h0[0], h0[1], h0[2], h0[3]}, o[d0], 0, 0, 0);   \
        o[d0] = __builtin_amdgcn_mfma_f32_32x32x16_bf16(pa1, (bf16x8){l1[0], l1[1], l1[2], l1[3], h1[0], h1[1], h1[2], h1[3]}, o[d0], 0, 0, 0);   \
        o[d0] = __builtin_amdgcn_mfma_f32_32x32x16_bf16(pa2, (bf16x8){l2[0], l2[1], l2[2], l2[3], h2[0], h2[1], h2[2], h2[3]}, o[d0], 0, 0, 0);   \
        o[d0] = __builtin_amdgcn_mfma_f32_32x32x16_bf16(pa3, (bf16x8){l3[0], l3[1], l3[2], l3[3], h3[0], h3[1], h3[2], h3[3]}, o[d0], 0, 0, 0); } while (0)
    ATT_PV_D0(0); ATT_PV_D0(1); ATT_PV_D0(2); ATT_PV_D0(3);
#undef ATT_PV_D0
#undef ATT_TRRD
}
}

__device__ __forceinline__ void phase_nsa_mfma(Frame& F, int l) {
    using namespace att;
    const int tid0 = F.tid, wid = F.wave;
    LAS char* V_lds = (LAS char*)F.lds; LAS char* K_lds = V_lds + SHM; LAS char* K2_lds = V_lds + 3 * SHM;
    LAS float* tbl = (LAS float*)(V_lds + 4 * SHM) + wid * 256; LAS float* al_l = tbl; LAS float* sc_l = tbl + 32;
    LAS unsigned* uni = (LAS unsigned*)(V_lds + 4 * SHM + 8192);
    const float NEG = -__builtin_inff();
#pragma unroll 1
    for (int it = F.bid; it < 256; it += F.G) {
        unsigned char* wsl = F.ws; asm volatile("" : "+s"(wsl));
        const float* QFp = (const float*)(wsl + WS_QF); const float* GATp = (const float*)(wsl + WS_GATES); const float* CBPp = (const float*)(wsl + WS_CBP);
        int tid = tid0; asm volatile("" : "+v"(tid));
        const int lane = tid & 63, r32 = lane & 31, hi = lane >> 5;
        const int sr = tid >> 4, sc = (tid & 15) * 8, vst0 = v_st(sr, sc), vst1 = v_st(32 + sr, sc), kws = ATT_KSWZ(sr, sc * 2);
        const int vb0 = (int)(unsigned)(size_t)V_lds + v_rd_base(lane);
        const int xc = it & 7, b = xc >> 1, g = xc & 1, qb = it >> 3;
        const int q0 = qb * 64;
        const int rho = wid * 32 + r32, qi = rho >> 2, hh = rho & 3, trow = b * SEQ + q0 + qi, tq = q0 + qi;
        const unsigned kvoff = (unsigned)((b * NKV + g) * SEQ * HD);
        __syncthreads();
        if (tid == 0) uni[0] = 0u;
        bf16x8 qr[8];
        f32x16 o[4];
        f32x4* ata = (f32x4*)(wsl + WS_ATA) + ((size_t)(it * 8 + wid) * 16) * 64 + lane;
        float m_reg = -1e30f, l_reg = 0.f, mn, alpha;
        f32x16 p0, p1; bf16x8 pa0, pa1, pa2, pa3;
        unsigned selmask;
        {
            bf16x8 ql[8];
            const float* qp = QFp + ((size_t)trow * 8 + g * 4 + hh) * 128 + hi * 8;
#pragma unroll
            for (int d0 = 0; d0 < 8; ++d0) { const f32x4 a = *(const f32x4*)(qp + d0 * 16), c = *(const f32x4*)(qp + d0 * 16 + 4);
                qr[d0] = pack8(a, c); const u32x4 u = __builtin_bit_cast(u32x4, qr[d0]);
                f32x4 ra, rc; ra.x = a.x - __uint_as_float(u.x << 16); ra.y = a.y - __uint_as_float(u.x & 0xffff0000u); ra.z = a.z - __uint_as_float(u.y << 16); ra.w = a.w - __uint_as_float(u.y & 0xffff0000u);
                rc.x = c.x - __uint_as_float(u.z << 16); rc.y = c.y - __uint_as_float(u.z & 0xffff0000u); rc.z = c.z - __uint_as_float(u.w << 16); rc.w = c.w - __uint_as_float(u.w & 0xffff0000u);
                ql[d0] = pack8(ra, rc); }
            { const float* kr = CBPp + ((size_t)(b * 32 + sr) * 2 + g) * 128 + sc; const float* vr = kr + (size_t)256 * 128;
              const f32x4 a = *(const f32x4*)kr, c = *(const f32x4*)(kr + 4); const bf16x8 kh = pack8(a, c); const u32x4 u = __builtin_bit_cast(u32x4, kh);
              f32x4 ra, rc; ra.x = a.x - __uint_as_float(u.x << 16); ra.y = a.y - __uint_as_float(u.x & 0xffff0000u); ra.z = a.z - __uint_as_float(u.y << 16); ra.w = a.w - __uint_as_float(u.y & 0xffff0000u);
              rc.x = c.x - __uint_as_float(u.z << 16); rc.y = c.y - __uint_as_float(u.z & 0xffff0000u); rc.z = c.z - __uint_as_float(u.w << 16); rc.w = c.w - __uint_as_float(u.w & 0xffff0000u);
              unsigned zr; asm volatile("v_mov_b32 %0, 0" : "=v"(zr)); u32x4 z4u; z4u.x = zr; z4u.y = zr; z4u.z = zr; z4u.w = zr;
              const bf16x8 z8 = __builtin_bit_cast(bf16x8, z4u);
              *(LAS bf16x8*)(K_lds + kws) = kh; *(LAS bf16x8*)(K_lds + kws + 32 * 256) = z8;
              *(LAS bf16x8*)(K2_lds + kws) = pack8(ra, rc); *(LAS bf16x8*)(K2_lds + kws + 32 * 256) = z8;
              *(LAS bf16x8*)(V_lds + vst0) = pack8(*(const f32x4*)vr, *(const f32x4*)(vr + 4)); *(LAS bf16x8*)(V_lds + vst1) = z8; }
            __syncthreads();
            qkt<true>(p0, p1, K_lds, r32, hi, qr); qkt<false>(p0, p1, K_lds, r32, hi, ql); qkt<false>(p0, p1, K2_lds, r32, hi, qr);
            const int nvis = (tq + 1) >> 6;
#pragma unroll
            for (int r = 0; r < 16; ++r) { if (crow(r, hi) >= nvis) p0[r] = NEG; p1[r] = NEG; }
            partialSM(p0, p1, m_reg, mn, alpha); finishSM(p0, p1, alpha, l_reg, pa0, pa1, pa2, pa3);
            const int cur = qb;
            if (cur < 16) selmask = (2u << cur) - 1u;
            else {
                const float inv = l_reg > 0.f ? 1.0f / l_reg : 0.f;
                float il[16], ih[16];
#pragma unroll
                for (int r = 0; r < 16; ++r) { float v = p0[r] * inv; v += __shfl_xor(v, 1); v += __shfl_xor(v, 2);
                    const int kj = crow(r, hi); if (kj < 1 || kj > cur - 2) v = -1.f;
                    auto rr = __builtin_amdgcn_permlane32_swap(__float_as_uint(v), __float_as_uint(v), false, false); il[r] = __uint_as_float(rr[0]); ih[r] = __uint_as_float(rr[1]); }
                unsigned part = 0u;
#pragma unroll
                for (int r = 0; r < 16; ++r) { const int kj = crow(r, hi); const float mine = hi ? ih[r] : il[r]; int cnt = 0;
#pragma unroll
                    for (int r2 = 0; r2 < 16; ++r2) { const int j0 = crow(r2, 0), j1 = crow(r2, 1);
                        cnt += (il[r2] > mine || (il[r2] == mine && j0 < kj)) ? 1 : 0; cnt += (ih[r2] > mine || (ih[r2] == mine && j1 < kj)) ? 1 : 0; }
                    const bool sel = (kj == 0) || (kj == cur) || (kj == cur - 1) || (mine >= 0.f && cnt < 13);
                    part |= sel ? (1u << kj) : 0u; }
                auto rr = __builtin_amdgcn_permlane32_swap(part, part, false, false); selmask = rr[0] | rr[1];
            }
            unsigned wu = selmask;
#pragma unroll
            for (int ofs = 1; ofs < 32; ofs <<= 1) wu |= (unsigned)__shfl_xor((int)wu, ofs);
            if (lane == 0) atomicOr((unsigned*)uni, wu);
            asm volatile("" ::: "memory");
#pragma unroll
            for (int d = 0; d < 4; ++d) o[d] = f32x16{};
            pv_tile(o, vb0, pa0, pa1, pa2, pa3);
            if (hi == 0) sc_l[r32] = l_reg > 0.f ? GATp[(size_t)trow * 24 + (g * 4 + hh) * 3 + 0] / l_reg : 0.f;
            asm volatile("s_waitcnt lgkmcnt(0)" ::: "memory");
#pragma unroll
            for (int d = 0; d < 4; ++d)
#pragma unroll
                for (int r4 = 0; r4 < 4; ++r4) { f32x4 v;
#pragma unroll
                    for (int e = 0; e < 4; ++e) { v[e] = o[d][r4 * 4 + e] * sc_l[crow(r4 * 4 + e, hi)]; o[d][r4 * 4 + e] = 0.f; }
                    ata[(d * 4 + r4) * 64] = v; }
            m_reg = -1e30f; l_reg = 0.f;
        }
        __syncthreads();
        const unsigned un = uni[0];
        const unsigned wun = (unsigned)__builtin_amdgcn_readfirstlane((int)({ unsigned w_ = selmask;
#pragma unroll
            for (int ofs = 1; ofs < 32; ofs <<= 1) w_ |= (unsigned)__shfl_xor((int)w_, ofs); w_; }));
#pragma unroll 1
        for (int br = 1; br <= 2; ++br) {
            const bf16* Kp = (const bf16*)(wsl + (br == 1 ? WS_KSB : WS_KWB)) + kvoff; const bf16* Vp = (const bf16*)(wsl + (br == 1 ? WS_VSB : WS_VWB)) + kvoff;
            unsigned tiles = br == 1 ? (un & ((2u << qb) - 1u)) : ((2u << qb) - 1u) & ~((qb >= 9) ? ((1u << (qb - 8)) - 1u) : 0u);
            bf16x8 st_k0, st_k1, st_v0, st_v1;
#define ATT_LOAD(jt) do { const size_t ro = (size_t)((jt) * 64 + sr) * HD + sc; st_k0 = *(const bf16x8*)(Kp + ro); st_k1 = *(const bf16x8*)(Kp + ro + 32 * HD); st_v0 = *(const bf16x8*)(Vp + ro); st_v1 = *(const bf16x8*)(Vp + ro + 32 * HD); } while (0)
#define ATT_WRITE(bo) do { *(LAS bf16x8*)(K_lds + (bo) + kws) = st_k0; *(LAS bf16x8*)(K_lds + (bo) + kws + 32 * 256) = st_k1; *(LAS bf16x8*)(V_lds + (bo) + vst0) = st_v0; *(LAS bf16x8*)(V_lds + (bo) + vst1) = st_v1; } while (0)
            int j = __builtin_ctz(tiles); tiles &= tiles - 1u;
            ATT_LOAD(j);
            __syncthreads();
            ATT_WRITE(0);
            int jn = tiles ? __builtin_ctz(tiles) : -1;
            if (jn >= 0) ATT_LOAD(jn);
            __syncthreads();
            int cur = 0;
#pragma unroll 1
            while (true) {
                const bool act = br == 2 || ((wun >> j) & 1u);
                if (act) {
                    qkt<true>(p0, p1, K_lds + cur, r32, hi, qr);
                    if (br == 1) {
                        if (!((selmask >> j) & 1u)) {
#pragma unroll
                            for (int r = 0; r < 16; ++r) { p0[r] = NEG; p1[r] = NEG; } }
                        if (j == qb) {
#pragma unroll
                            for (int r = 0; r < 16; ++r) { if (crow(r, hi) > qi) p0[r] = NEG; if (crow(r, hi) + 32 > qi) p1[r] = NEG; } }
                    } else if (j == qb || j == qb - 8) {
                        const int dq = tq - j * 64;
#pragma unroll
                        for (int r = 0; r < 16; ++r) { if ((unsigned)(dq - crow(r, hi)) > 512u) p0[r] = NEG; if ((unsigned)(dq - crow(r, hi) - 32) > 512u) p1[r] = NEG; }
                    }
                    partialSM(p0, p1, m_reg, mn, alpha); finishSM(p0, p1, alpha, l_reg, pa0, pa1, pa2, pa3);
                    if (__any(alpha < 1.f)) { if (hi == 0) al_l[r32] = alpha; asm volatile("s_waitcnt lgkmcnt(0)" ::: "memory");
#pragma unroll
                        for (int d = 0; d < 4; ++d)
#pragma unroll
                            for (int r = 0; r < 16; ++r) o[d][r] *= al_l[crow(r, hi)]; }
                    pv_tile(o, vb0 + cur, pa0, pa1, pa2, pa3);
                }
                if (jn < 0) break;
                ATT_WRITE(cur ^ 32768);
                j = jn; tiles &= tiles - 1u; jn = tiles ? __builtin_ctz(tiles) : -1;
                if (jn >= 0) ATT_LOAD(jn);
                __syncthreads();
                cur ^= 32768;
            }
#undef ATT_LOAD
#undef ATT_WRITE
            if (hi == 0) sc_l[r32] = l_reg > 0.f ? GATp[(size_t)trow * 24 + (g * 4 + hh) * 3 + br] / l_reg : 0.f;
            asm volatile("s_waitcnt lgkmcnt(0)" ::: "memory");
#pragma unroll
            for (int d = 0; d < 4; ++d)
#pragma unroll
                for (int r4 = 0; r4 < 4; ++r4) { f32x4 v = ata[(d * 4 + r4) * 64];
#pragma unroll
                    for (int e = 0; e < 4; ++e) { v[e] += o[d][r4 * 4 + e] * sc_l[crow(r4 * 4 + e, hi)]; o[d][r4 * 4 + e] = v[e]; }
                    if (br == 1) { ata[(d * 4 + r4) * 64] = v;
#pragma unroll
                        for (int e = 0; e < 4; ++e) o[d][r4 * 4 + e] = 0.f; } }
            m_reg = -1e30f; l_reg = 0.f;
        }
        bf16* OM = (bf16*)(wsl + WS_OMIX);
#pragma unroll
        for (int r = 0; r < 16; ++r) { const int rw = wid * 32 + crow(r, hi); bf16* op = OM + (size_t)(b * SEQ + q0 + (rw >> 2)) * DM + (g * 4 + (rw & 3)) * 128;
#pragma unroll
            for (int d = 0; d < 4; ++d) { const float v = o[d][r]; const float vn = __shfl_xor(v, 1);
                if ((r32 & 1) == 0) *(unsigned*)(op + d * 32 + r32) = pg8::cvt_pk_bf16(v, vn); } }
    }
    __syncthreads();
}

__device__ __forceinline__ void phase_resid(Frame& F, int l, int which  ) {
    const int lane = F.lane, gw = F.bid * NWAVES + F.wave, NGW = F.G * NWAVES;
    const float* gpost = (which == 0 ? ((const float*)F.in[22]) : ((const float*)F.in[27])) + l * DM;
    for (int r = gw; r < MT; r += NGW) {
        const float* md = ((float*)(F.ws + WS_MOD)) + ((size_t)l * 12 + modrow(r)) * 12288;
        const float* ga = md + (which == 0 ? 4096 : 10240);
        const f32x4* xr = (const f32x4*)((which == 0) ? xrow_in(F, l, r) : ((float*)(F.ws + WS_X)) + (size_t)r * DM) + lane;
        const u32x2* mr = (const u32x2*)(((const bf16*)(F.ws + WS_MIX)) + (size_t)r * DM) + lane;
        f32x4 v[8], m[8]; float ss = 0.f;
#pragma unroll
        for (int j = 0; j < 8; ++j) { v[j] = xr[64 * j]; const u32x2 mb = mr[64 * j]; m[j] = (f32x4){__uint_as_float(mb.x << 16), __uint_as_float(mb.x & 0xffff0000u), __uint_as_float(mb.y << 16), __uint_as_float(mb.y & 0xffff0000u)}; ss += (m[j].x * m[j].x + m[j].y * m[j].y) + (m[j].z * m[j].z + m[j].w * m[j].w); }
        ss = wave_sum(ss);
        const float rs = 1.0f / sqrtf(ss * (1.0f / DM) + EPS);
#pragma unroll
        for (int j = 0; j < 8; ++j) { const int c = (lane + 64 * j) * 4; v[j] = v[j] + *(const f32x4*)(ga + c) * (m[j] * rs * *(const f32x4*)(gpost + c)); }
        if (which == 1 && l == NL - 1) {
            f32x4* o = (f32x4*)(r < MP ? F.out + O_YP + (size_t)r * DM : F.out + O_YS + (size_t)(r - MP) * DM) + lane;
#pragma unroll
            for (int j = 0; j < 8; ++j) o[64 * j] = v[j];
        } else {
            f32x4* xo = (f32x4*)(((float*)(F.ws + WS_X)) + (size_t)r * DM) + lane;
#pragma unroll
            for (int j = 0; j < 8; ++j) xo[64 * j] = v[j];
            if (which == 0) norm_mod_store(v, ((const float*)F.in[23]) + l * DM, md + 6144, md + 8192, ((bf16*)(F.ws + WS_H)) + (size_t)r * DM, lane);
            else { const float* md2 = ((float*)(F.ws + WS_MOD)) + ((size_t)(l + 1) * 12 + modrow(r)) * 12288; norm_mod_store(v, ((const float*)F.in[12]) + (l + 1) * DM, md2, md2 + 2048, ((bf16*)(F.ws + WS_H)) + (size_t)r * DM, lane); }
        }
    }
}

constexpr int PH_LAYER0 = 3, PH_PER_LAYER = 10, NPHASE = PH_LAYER0 + NL * PH_PER_LAYER;
#ifndef PHMASK
#define PHMASK 0xFFFFFFFFu
#endif
#define EN(b) (((PHMASK) >> (b)) & 1u)
#ifndef REP_MASK
#define REP_MASK 0u
#endif
#ifndef REP_N
#define REP_N 3
#endif
#define REPS(b, on) (((((REP_MASK) >> (b)) & 1u) && (on)) ? 1 + (REP_N) : 1)
#define IN(k) (lo <= (k) && (k) < hi)
#define SEAM(k) do { if (IN(k) && IN((k) + 1)) xcd_barrier(bar); } while (0)
template <int l>
__device__ __forceinline__ void layer_phases(Frame& F, const int lo, const int hi, const XcdBarrier& bar) {

        const int p0 = PH_LAYER0 + l * PH_PER_LAYER;
        if (EN(3) && IN(p0 + 0)) for (int rep = 0; rep < REPS(3, l == 0); ++rep, ((REP_MASK) ? __syncthreads() : (void)0)) {
            if constexpr (l == 0) { if (F.bid & 1) phase_cmp_direct(F); }
            pg8::Gemm g{((bf16*)(F.ws + WS_H)), ((bf16*)(F.ws + WS_WIN)) + (size_t)l * NIN * DM, DM, DM}; pg8::StaticOrder S; S.init(MP, NIN, F.G, F.bid); pg8::EpiF32 E{((float*)(F.ws + WS_PROJ)), NIN};
            pg8::gemm_phase<pg8::EpiF32, pg8::StaticOrder, true, true>(F.lds, g, S, E);
            if (F.bid >= 96)
                skinny_wave<0, 64>(F, ((bf16*)(F.ws + WS_H)) + (size_t)MP * DM, DM, ((bf16*)(F.ws + WS_WIN)) + (size_t)l * NIN * DM, DM, NIN / 16, ((float*)(F.ws + WS_PROJ)), nullptr, NIN, (F.bid - 96) * NWAVES + F.wave, 160 * NWAVES);
            __syncthreads();
            if (l == 0) { if (F.bid >= 224) tr_range(F, TR_I_L + TR_I_IN, TR_I_OUT, (F.bid - 224) * NWAVES + F.wave, 32 * NWAVES);
                          else if (F.bid >= 96) tr_range(F, TR_I_L, TR_I_IN, (F.bid - 96) * NWAVES + F.wave, 128 * NWAVES); }
            else { if (F.bid >= 96) tr_range(F, TR_I_L + TR_I_IN + TR_I_OUT + TR_I_GU, TR_I_DN, (F.bid - 96) * NWAVES + F.wave, 160 * NWAVES); }
            if constexpr (l == 0) { if (!(F.bid & 1)) phase_cmp_direct(F); }
        }
        SEAM(p0 + 0);
        if (EN(4) && IN(p0 + 1)) for (int rep = 0; rep < REPS(4, l == 0); ++rep, ((REP_MASK) ? __syncthreads() : (void)0)) { phase_postproj(F, l); }
        SEAM(p0 + 1);
        if (EN(5) && IN(p0 + 2)) for (int rep = 0; rep < REPS(5, l == 0); ++rep, ((REP_MASK) ? __syncthreads() : (void)0)) {
            pg8::Gemm g{((bf16*)(F.ws + WS_AP)), ((bf16*)(F.ws + WS_W1)) + (size_t)l * 2 * 256 * 8192, 256, 8192}; pg8::SplitOrder S{64, F.G, F.bid, 32, 1}; pg8::EpiPart E{((float*)(F.ws + WS_HIDP)), (size_t)512 * 256};
            pg8::gemm_phase<pg8::EpiPart, pg8::SplitOrder, true, true>(F.lds, g, S, E);
#ifndef NO_SCAN
            phase_gdn_scan_naive(F, l);
#endif
            phase_gdn_pre(F, l);
        }
        SEAM(p0 + 2);
        if (EN(6) && IN(p0 + 3)) for (int rep = 0; rep < REPS(6, l == 0); ++rep, ((REP_MASK) ? __syncthreads() : (void)0)) { cmp_finish<32>(F, ((float*)(F.ws + WS_HIDP)), (size_t)512 * 256, 512, 256, ((const float*)F.in[16]) + (size_t)l * 2 * 32768, ((float*)(F.ws + WS_CBP)), 64);
            cmp_finish16<4>(F, ((float*)(F.ws + WS_HIDS)), (size_t)16384 * 256, 8192, 4096, ((const float*)F.in[16]), ((float*)(F.ws + WS_CBS)), 64, l * 8192, ((const float*)(F.ws + WS_PEC)));
            phase_gdn_scan(F, l); }
        SEAM(p0 + 3);
        if (EN(7) && IN(p0 + 4)) for (int rep = 0; rep < REPS(7, l == 0); ++rep, ((REP_MASK) ? __syncthreads() : (void)0)) { phase_nsa_mfma(F, l); phase_nsa_sample(F, l); phase_gdn_out(F, l); }
        SEAM(p0 + 4);
        if (EN(8) && IN(p0 + 5)) for (int rep = 0; rep < REPS(8, l == 0); ++rep, ((REP_MASK) ? __syncthreads() : (void)0)) {
            pg8::Gemm g{((bf16*)(F.ws + WS_OMIX)), ((bf16*)(F.ws + WS_WOUT)) + (size_t)l * DM * DM, DM, DM}; pg8::StaticOrder S; S.init(MP, DM, F.G, F.bid); pg8::EpiBf16 E{((bf16*)(F.ws + WS_MIX)), DM};
            pg8::gemm_phase<pg8::EpiBf16, pg8::StaticOrder, true, true>(F.lds, g, S, E);
            skinny_gemm<2, 8>(F, ((bf16*)(F.ws + WS_OMIX)) + (size_t)MP * DM, DM, ((bf16*)(F.ws + WS_WOUT)) + (size_t)l * DM * DM, DM, DM / 16, nullptr, ((bf16*)(F.ws + WS_MIX)), DM);
        }
        SEAM(p0 + 5);
        if (EN(9) && IN(p0 + 6)) for (int rep = 0; rep < REPS(9, l == 0); ++rep, ((REP_MASK) ? __syncthreads() : (void)0)) { phase_resid(F, l, 0); }
        SEAM(p0 + 6);
        if (EN(10) && IN(p0 + 7)) for (int rep = 0; rep < REPS(10, l == 0); ++rep, ((REP_MASK) ? __syncthreads() : (void)0)) {
            pg8::Gemm g{((bf16*)(F.ws + WS_H)), ((bf16*)(F.ws + WS_WGU)) + (size_t)l * NGU * DM, DM, DM}; pg8::StaticOrder S; S.init(MP, NGU, F.G, F.bid); pg8::EpiSwiGLU E{((bf16*)(F.ws + WS_ACT)), DFF};
            pg8::gemm_phase<pg8::EpiSwiGLU, pg8::StaticOrder, true, true>(F.lds, g, S, E);
            if (F.bid >= 128)
                skinny_wave<1, 64>(F, ((bf16*)(F.ws + WS_H)) + (size_t)MP * DM, DM, ((bf16*)(F.ws + WS_WGU)) + (size_t)l * NGU * DM, DM, DFF / 16, nullptr, ((bf16*)(F.ws + WS_ACT)), DFF, (F.bid - 128) * NWAVES + F.wave, 128 * NWAVES);
            __syncthreads();
            if (l == 0 && F.bid >= 128) tr_range(F, TR_I_L + TR_I_IN + TR_I_OUT, TR_I_GU, (F.bid - 128) * NWAVES + F.wave, 128 * NWAVES);
        }
        SEAM(p0 + 7);
        if (EN(11) && IN(p0 + 8)) for (int rep = 0; rep < REPS(11, l == 0); ++rep, ((REP_MASK) ? __syncthreads() : (void)0)) {
            pg8::Gemm g{((bf16*)(F.ws + WS_ACT)), ((bf16*)(F.ws + WS_WDN)) + (size_t)l * DM * DFF, DFF, DFF}; pg8::StaticOrder S; S.init(MP, DM, F.G, F.bid); pg8::EpiBf16 E{((bf16*)(F.ws + WS_MIX)), DM};
            pg8::gemm_phase<pg8::EpiBf16, pg8::StaticOrder, true, true>(F.lds, g, S, E);
            skinny_gemm<2, 22>(F, ((bf16*)(F.ws + WS_ACT)) + (size_t)MP * DFF, DFF, ((bf16*)(F.ws + WS_WDN)) + (size_t)l * DM * DFF, DFF, DM / 16, nullptr, ((bf16*)(F.ws + WS_MIX)), DM);
        }
        SEAM(p0 + 8);
        if (EN(12) && IN(p0 + 9)) for (int rep = 0; rep < REPS(12, l == 0); ++rep, ((REP_MASK) ? __syncthreads() : (void)0)) { phase_resid(F, l, 1); }
        SEAM(p0 + 9);
    }

__global__ void __launch_bounds__(NTHR, 2) mega(Args args) {
    extern __shared__ __attribute__((aligned(16))) unsigned char lds_raw[];
    Frame F;
    F.lds = (LAS unsigned char*)lds_raw;
    F.tid = threadIdx.x; F.lane = F.tid & 63; F.wave = __builtin_amdgcn_readfirstlane(F.tid >> 6); F.G = gridDim.x; F.bid = blockIdx.x;
    F.in = args.in; F.out = args.out; F.ws = args.ws;
    unsigned char* ws = args.ws;
    volatile LAS unsigned* MISC = (volatile LAS unsigned*)(F.lds + MISC_OFF);
    if (F.tid < 16) MISC[F.tid] = 0u;
    __syncthreads();
    const int lo = args.ph_lo, hi = args.ph_hi;
    unsigned* barw = (unsigned*)(ws + WS_CTL) + CW_BAR;
    XcdBarrier bar; bar.bar = barw; bar.x = 0; bar.st = MISC + 8;
    if (hi - lo > 1) bar = xcd_barrier_post(barw, MISC + 8);

    if (EN(0) && IN(0)) for (int rep = 0; rep < REPS(0, true); ++rep, ((REP_MASK) ? __syncthreads() : (void)0)) { phase_prologue(F); }
    SEAM(0);
    if (EN(1) && IN(1)) for (int rep = 0; rep < REPS(1, true); ++rep, ((REP_MASK) ? __syncthreads() : (void)0)) {
        ada_reduce(F);
    }
    SEAM(1);
    if (EN(2) && IN(2)) for (int rep = 0; rep < REPS(2, true); ++rep, ((REP_MASK) ? __syncthreads() : (void)0)) { phase_norm1(F, 0); pe_w1(F); }
    SEAM(2);
    layer_phases<0>(F, lo, hi, bar);
    layer_phases<1>(F, lo, hi, bar);
#undef IN
#undef SEAM
}

extern "C" void kernel_launch(void* const* d_in, const int* in_sizes, int n_in, void* d_out, int out_size, void* d_ws, size_t ws_size, hipStream_t stream) {
    static int grid = 0;
    if (grid == 0) {
        if (n_in != 28 || (size_t)out_size != O_END || ws_size < WS_END) { fprintf(stderr, "kernel_launch: unexpected shapes: n_in %d out %d (want %zu) ws %zu (want %zu)\n", n_in, out_size, (size_t)O_END, ws_size, (size_t)WS_END); grid = -1; return; }
        int dev = 0, cus = 0, per_cu = 0;
        if (hipGetDevice(&dev) != hipSuccess || hipDeviceGetAttribute(&cus, hipDeviceAttributeMultiprocessorCount, dev) != hipSuccess) { grid = -1; return; }
        if (hipFuncSetAttribute((const void*)mega, hipFuncAttributeMaxDynamicSharedMemorySize, LDS_BYTES) != hipSuccess) { fprintf(stderr, "kernel_launch: hipFuncSetAttribute failed\n"); grid = -1; return; }
        if (hipOccupancyMaxActiveBlocksPerMultiprocessor(&per_cu, (const void*)mega, NTHR, LDS_BYTES) != hipSuccess || per_cu < 1) fprintf(stderr, "kernel_launch: occupancy query reports %d\n", per_cu);
        (void)hipGetLastError();
        grid = cus;
    }
    if (grid < 0) return;
    if (hipMemsetAsync((char*)d_ws + WS_CTL, 0, CTL_BYTES, stream) != hipSuccess) return;
    Args a{};
    for (int i = 0; i < 28; ++i) a.in[i] = d_in[i];
    a.out = (float*)d_out; a.ws = (unsigned char*)d_ws;
#if ONE_LAUNCH
    a.ph_lo = 0; a.ph_hi = NPHASE;
    hipLaunchKernelGGL(mega, dim3(grid), dim3(NTHR), LDS_BYTES, stream, a);
#else
    for (int p = 0; p < NPHASE; ++p) { a.ph_lo = p; a.ph_hi = p + 1; hipLaunchKernelGGL(mega, dim3(grid), dim3(NTHR), LDS_BYTES, stream, a); }
#endif
}
```

```cpp
#include <hip/hip_runtime.h>
#include <cstdio>
#include <cstdint>

#ifndef ONE_LAUNCH
#define ONE_LAUNCH 1
#endif

#define LAS __attribute__((address_space(3)))
typedef unsigned short bf16;
typedef unsigned u32x4 __attribute__((ext_vector_type(4)));
typedef unsigned u32x2 __attribute__((ext_vector_type(2)));
typedef float f32x4 __attribute__((ext_vector_type(4)));
typedef float f32x2 __attribute__((ext_vector_type(2)));
typedef short bf16x8 __attribute__((ext_vector_type(8)));

namespace pg8 {
#define PG8_LAS __attribute__((address_space(3)))
typedef unsigned short bf16_t;
constexpr int BM = 256, BK = 64, HALF = 128, HTB = HALF * BK * 2  , STAGE_BYTES = 8 * HTB, NXCD = 8, WGM = 8;

__host__ __device__ __forceinline__ int lds_byte(int r, int c) { const int st = (r >> 4) * 2 + (c >> 5), rr = r & 15, cc = c & 31, ob = rr * 64 + cc * 2; return st * 1024 + (ob ^ (((ob >> 9) & 1) << 5)); }
__host__ __device__ __forceinline__ void stage_rc(int b, int& R, int& C) { const int st = b / 1024, sb = b % 1024, swz = sb ^ (((sb >> 9) & 1) << 5); R = (st >> 1) * 16 + swz / 64; C = (st & 1) * 32 + (swz % 64) / 2; }
__host__ __device__ __forceinline__ int perm32(int rho) { const int n = rho >> 4, i = rho & 15; return 8 * (i >> 2) + 4 * n + (i & 3); }

struct Unit { int pm, pn, pk; };
struct Gemm { const bf16_t* A; const bf16_t* Bt; int K; int ld; };

struct StaticOrder {
    int nM, nN, nwg, G, c;
    __host__ __device__ void init(int M, int N, int G_, int c_) { nM = M / BM; nN = N / BM; nwg = nM * nN; G = G_; c = c_; }
    __host__ __device__ bool next(int i, Unit& u) const {
        const long L = (long)i * G + c; if (L >= nwg) return false;
        int wgid = (int)L; { const int q = nwg / NXCD, r = nwg % NXCD, xcd = wgid % NXCD, off = wgid / NXCD; wgid = (xcd < r ? xcd * (q + 1) : r * (q + 1) + (xcd - r) * q) + off; }
        const int nig = WGM * nN, gid = wgid / nig, fm = gid * WGM, gsz = (nM - fm) < WGM ? (nM - fm) : WGM;
        u.pm = fm + ((wgid % nig) % gsz); u.pn = (wgid % nig) / gsz; u.pk = 0; return true;
    }
    __device__ __forceinline__ void a_ready(const Unit&) const {}
    __device__ __forceinline__ void done(const Unit&) const {}
};
struct OneUnit {
    int L, nsplit, pn_div;
    __host__ __device__ bool next(int i, Unit& u) const { if (i != 0 || L < 0) return false; u.pk = L % nsplit; u.pm = L / nsplit; u.pn = u.pm / pn_div; return true; }
    __device__ __forceinline__ void a_ready(const Unit&) const {}
    __device__ __forceinline__ void done(const Unit&) const {}
};
struct SplitOrder {
    int nU, G, c, nsplit, pn_div;
    __host__ __device__ bool next(int i, Unit& u) const {
        const long L = (long)i * G + c; if (L >= nU) return false;
        u.pk = (int)(L % nsplit); u.pm = (int)(L / nsplit); u.pn = u.pm / pn_div; return true;
    }
    __device__ __forceinline__ void a_ready(const Unit&) const {}
    __device__ __forceinline__ void done(const Unit&) const {}
};

typedef __bf16 bf16x2_v __attribute__((ext_vector_type(2)));
__device__ __forceinline__ unsigned cvt_pk_bf16(float lo, float hi) { const f32x2 v = {lo, hi}; return __builtin_bit_cast(unsigned, __builtin_convertvector(v, bf16x2_v)); }

struct EpiF32 {
    static constexpr bool PERM = false, AFTER_DRAIN = false;
    float* C; int ldc;
    __device__ __forceinline__ void operator()(const f32x4 (&acc)[2][2][4][2], const Unit& u, int wr, int wc, int fr, int fq) const {
        const int row0 = u.pm * BM + wr * 64 + fr, col0 = u.pn * BM + wc * 32 + 4 * fq;
#pragma unroll
        for (int ai = 0; ai < 2; ++ai)
#pragma unroll
            for (int m = 0; m < 4; ++m) { float* rowp = C + (size_t)(row0 + ai * HALF + m * 16) * ldc + col0;
#pragma unroll
                for (int bj = 0; bj < 2; ++bj)
#pragma unroll
                    for (int n = 0; n < 2; ++n) *(f32x4*)(rowp + bj * HALF + n * 16) = acc[ai][bj][m][n]; }
    }
    __device__ __forceinline__ void fused(f32x4 (&)[2][2][4][2], const Unit&, int, int, int, int, PG8_LAS unsigned char*, int, int) const {}
};
struct EpiBf16 {
    static constexpr bool PERM = true, AFTER_DRAIN = false;
    bf16_t* O; int ldc;
    __device__ __forceinline__ void operator()(const f32x4 (&acc)[2][2][4][2], const Unit& u, int wr, int wc, int fr, int fq) const {
        const int row0 = u.pm * BM + wr * 64 + fr, col0 = u.pn * BM + wc * 32 + 8 * fq;
#pragma unroll
        for (int ai = 0; ai < 2; ++ai)
#pragma unroll
            for (int m = 0; m < 4; ++m) { bf16_t* rowp = O + (size_t)(row0 + ai * HALF + m * 16) * ldc + col0;
#pragma unroll
                for (int bj = 0; bj < 2; ++bj) { const f32x4 v0 = acc[ai][bj][m][0], v1 = acc[ai][bj][m][1];
                    u32x4 w; w.x = cvt_pk_bf16(v0[0], v0[1]); w.y = cvt_pk_bf16(v0[2], v0[3]); w.z = cvt_pk_bf16(v1[0], v1[1]); w.w = cvt_pk_bf16(v1[2], v1[3]);
                    *(u32x4*)(rowp + bj * HALF) = w; } }
    }
    __device__ __forceinline__ void fused(f32x4 (&)[2][2][4][2], const Unit&, int, int, int, int, PG8_LAS unsigned char*, int, int) const {}
};
struct EpiPart {
    static constexpr bool PERM = false, AFTER_DRAIN = false;
    float* C; size_t slab;
    __device__ __forceinline__ void operator()(const f32x4 (&acc)[2][2][4][2], const Unit& u, int wr, int wc, int fr, int fq) const {
        const int row0 = u.pm * BM + wr * 64 + fr, col0 = wc * 32 + 4 * fq;
        float* base = C + (size_t)u.pk * slab;
#pragma unroll
        for (int ai = 0; ai < 2; ++ai)
#pragma unroll
            for (int m = 0; m < 4; ++m) { float* rowp = base + (size_t)(row0 + ai * HALF + m * 16) * 256 + col0;
#pragma unroll
                for (int bj = 0; bj < 2; ++bj)
#pragma unroll
                    for (int n = 0; n < 2; ++n) *(f32x4*)(rowp + bj * HALF + n * 16) = acc[ai][bj][m][n]; }
    }
    __device__ __forceinline__ void fused(f32x4 (&)[2][2][4][2], const Unit&, int, int, int, int, PG8_LAS unsigned char*, int, int) const {}
};
struct EpiSwiGLU {
    static constexpr bool PERM = true, AFTER_DRAIN = false;
    bf16_t* O; int ldc;
    __device__ __forceinline__ void operator()(const f32x4 (&acc)[2][2][4][2], const Unit& u, int wr, int wc, int fr, int fq) const {
        const int row0 = u.pm * BM + wr * 64 + fr, col0 = u.pn * HALF + wc * 32 + 8 * fq;
#pragma unroll
        for (int ai = 0; ai < 2; ++ai)
#pragma unroll
            for (int m = 0; m < 4; ++m) { bf16_t* rowp = O + (size_t)(row0 + ai * HALF + m * 16) * ldc + col0;
                float o[8];
#pragma unroll
                for (int n = 0; n < 2; ++n)
#pragma unroll
                    for (int j = 0; j < 4; ++j) { const float g = acc[ai][0][m][n][j], up = acc[ai][1][m][n][j]; o[n * 4 + j] = g / (1.0f + __expf(-g)) * up; }
                u32x4 w; w.x = cvt_pk_bf16(o[0], o[1]); w.y = cvt_pk_bf16(o[2], o[3]); w.z = cvt_pk_bf16(o[4], o[5]); w.w = cvt_pk_bf16(o[6], o[7]);
                *(u32x4*)rowp = w; }
    }
    __device__ __forceinline__ void fused(f32x4 (&)[2][2][4][2], const Unit&, int, int, int, int, PG8_LAS unsigned char*, int, int) const {}
};

template <class Epi, class Sched, bool ALIGN_EPI = false, bool SP2 = false>
__device__ __forceinline__ void gemm_phase(PG8_LAS unsigned char* lds, const Gemm g, const Sched& S, const Epi& E) {
    const int tid = threadIdx.x, wid = __builtin_amdgcn_readfirstlane(tid >> 6), lane = tid & 63, wr = wid >> 2, wc = wid & 3, fr = lane & 15, fq = lane >> 4;
    int K = g.K, ld = g.ld; asm volatile("" : "+s"(K), "+s"(ld));
    const int nt = K / BK;
    unsigned voffA[2], voffB[2];
#pragma unroll
    for (int i = 0; i < 2; ++i) { int R, C; stage_rc(tid * 16 + i * 8192, R, C); const int Rb = Epi::PERM ? ((R & ~31) + perm32(R & 31)) : R;
        voffA[i] = (unsigned)(R * ld + C) * 2u; voffB[i] = (unsigned)(Rb * ld + C) * 2u; }
    const size_t kstep = (size_t)(BK * 2);
    const size_t hstep = (size_t)HALF * ld * 2;
    const size_t tstep = 2 * hstep;
    const size_t sstep = (size_t)K * 2;
    const unsigned ldsw = (unsigned)wid * 1024u;
    const int aoff = lds_byte(wr * 64 + fr, fq * 8), boff = lds_byte(wc * 32 + fr, fq * 8);
#define PG8_SA(b, h) (((b) * 2 + (h)) * HTB)
#define PG8_SB(b, h) ((4 + (b) * 2 + (h)) * HTB)
#define PG8_STAGE(bufoff, gbase, voff) do { _Pragma("unroll") for (int _i = 0; _i < 2; ++_i) \
        __builtin_amdgcn_global_load_lds((const unsigned*)((const char*)(gbase) + (voff)[_i]), (PG8_LAS unsigned*)(lds + (bufoff) + ldsw + _i * 8192), 16, 0, 0); } while (0)
#define PG8_LDA(dst, b, h) do { _Pragma("unroll") for (int m = 0; m < 4; ++m) _Pragma("unroll") for (int k = 0; k < 2; ++k) dst[m][k] = *(const PG8_LAS bf16x8*)(lds + PG8_SA(b, h) + aoff + m * 2048 + k * 1024); } while (0)
#define PG8_LDB(dst, b, h) do { _Pragma("unroll") for (int n = 0; n < 2; ++n) _Pragma("unroll") for (int k = 0; k < 2; ++k) dst[n][k] = *(const PG8_LAS bf16x8*)(lds + PG8_SB(b, h) + boff + n * 2048 + k * 1024); } while (0)
#define PG8_MMA(ai, bj, At, Bt) do { __builtin_amdgcn_s_setprio(1); _Pragma("unroll") for (int m = 0; m < 4; ++m) _Pragma("unroll") for (int n = 0; n < 2; ++n) _Pragma("unroll") for (int k = 0; k < 2; ++k) \
        acc[ai][bj][m][n] = __builtin_amdgcn_mfma_f32_16x16x32_bf16(Bt[n][k], At[m][k], acc[ai][bj][m][n], 0, 0, 0); __builtin_amdgcn_s_setprio(0); } while (0)
#define PG8_WAIT_V(n) asm volatile("s_waitcnt vmcnt(" #n ")" ::: "memory")
#define PG8_WAIT_L(n) asm volatile("s_waitcnt lgkmcnt(" #n ")" ::: "memory")
#define PG8_BAR __builtin_amdgcn_s_barrier()
#define PG8_SCHED __builtin_amdgcn_sched_barrier(0)
    Unit cur, nxt; int ui = 0;
    if (!S.next(0, cur)) return;
    f32x4 acc[2][2][4][2];
#pragma unroll
    for (int a = 0; a < 2; ++a)
#pragma unroll
        for (int b = 0; b < 2; ++b)
#pragma unroll
            for (int m = 0; m < 4; ++m)
#pragma unroll
                for (int n = 0; n < 2; ++n) acc[a][b][m][n] = (f32x4){0.f, 0.f, 0.f, 0.f};
    bf16x8 At[4][2], B0[2][2], B1[2][2];
    const char* cA = (const char*)g.A + (size_t)cur.pm * tstep + (size_t)cur.pk * sstep; const char* cB = (const char*)g.Bt + (size_t)cur.pn * tstep + (size_t)cur.pk * sstep;
    S.a_ready(cur);
    if constexpr (SP2) {
        PG8_STAGE(PG8_SB(0, 0), cB, voffB); PG8_STAGE(PG8_SB(0, 1), cB + hstep, voffB); PG8_STAGE(PG8_SA(0, 0), cA, voffA); PG8_STAGE(PG8_SA(0, 1), cA + hstep, voffA);
        if (wr == 1) PG8_BAR;
        PG8_WAIT_V(2); PG8_BAR;
        PG8_STAGE(PG8_SB(1, 0), cB + kstep, voffB); PG8_STAGE(PG8_SA(1, 0), cA + kstep, voffA); PG8_STAGE(PG8_SB(1, 1), cB + hstep + kstep, voffB);
        PG8_WAIT_V(6); PG8_BAR;
    } else {
        PG8_STAGE(PG8_SB(0, 0), cB, voffB); PG8_STAGE(PG8_SA(0, 0), cA, voffA); PG8_STAGE(PG8_SB(0, 1), cB + hstep, voffB); PG8_STAGE(PG8_SA(0, 1), cA + hstep, voffA);
        if (wr == 1) PG8_BAR;
        PG8_WAIT_V(4); PG8_BAR;
        PG8_STAGE(PG8_SB(1, 0), cB + kstep, voffB); PG8_STAGE(PG8_SA(1, 0), cA + kstep, voffA); PG8_STAGE(PG8_SB(1, 1), cB + hstep + kstep, voffB);
        PG8_WAIT_V(6); PG8_BAR;
    }
    for (;;) {
        const bool has_next = S.next(ui + 1, nxt);
        const char* nA = has_next ? (const char*)g.A + (size_t)nxt.pm * tstep + (size_t)nxt.pk * sstep : cA; const char* nB = has_next ? (const char*)g.Bt + (size_t)nxt.pn * tstep + (size_t)nxt.pk * sstep : cB;
        for (int t = 0; t < nt; t += 2) {
            const bool last = (t == nt - 2);
            const char* a1 = cA + (size_t)(t + 1) * kstep;
            const char* a2 = last ? nA : cA + (size_t)(t + 2) * kstep; const char* b2 = last ? nB : cB + (size_t)(t + 2) * kstep;
            const char* a3 = a2 + kstep; const char* b3 = b2 + kstep;
            if (last && has_next) S.a_ready(nxt);
            if constexpr (SP2) {
            PG8_LDB(B0, 0, 0); PG8_LDB(B1, 0, 1); PG8_SCHED; PG8_LDA(At, 0, 0); PG8_STAGE(PG8_SA(1, 1), a1 + hstep, voffA);
            PG8_WAIT_V(8); PG8_WAIT_L(0); PG8_BAR; PG8_MMA(0, 0, At, B0); PG8_MMA(0, 1, At, B1); PG8_BAR; PG8_SCHED;
            PG8_LDA(At, 0, 1); PG8_STAGE(PG8_SB(0, 0), b2, voffB); PG8_STAGE(PG8_SB(0, 1), b2 + hstep, voffB); PG8_STAGE(PG8_SA(0, 0), a2, voffA);
            PG8_WAIT_V(8); PG8_WAIT_L(0); PG8_BAR; PG8_MMA(1, 0, At, B0); PG8_MMA(1, 1, At, B1); PG8_BAR; PG8_SCHED;
            PG8_LDB(B0, 1, 0); PG8_LDB(B1, 1, 1); PG8_SCHED; PG8_LDA(At, 1, 0); PG8_STAGE(PG8_SA(0, 1), a2 + hstep, voffA);
            PG8_WAIT_V(8); PG8_WAIT_L(0); PG8_BAR; PG8_MMA(0, 0, At, B0); PG8_MMA(0, 1, At, B1); PG8_BAR; PG8_SCHED;
            PG8_LDA(At, 1, 1); PG8_STAGE(PG8_SB(1, 0), b3, voffB); PG8_STAGE(PG8_SB(1, 1), b3 + hstep, voffB); PG8_STAGE(PG8_SA(1, 0), a3, voffA);
            PG8_WAIT_V(8); PG8_WAIT_L(0); PG8_BAR; PG8_MMA(1, 0, At, B0); PG8_MMA(1, 1, At, B1); PG8_BAR; PG8_SCHED;
            } else {
            PG8_LDB(B0, 0, 0); PG8_SCHED; PG8_LDA(At, 0, 0); PG8_STAGE(PG8_SA(1, 1), a1 + hstep, voffA);
            PG8_WAIT_L(8); PG8_BAR; PG8_WAIT_L(0); PG8_MMA(0, 0, At, B0); PG8_BAR; PG8_SCHED;
            PG8_LDB(B1, 0, 1); PG8_STAGE(PG8_SB(0, 0), b2, voffB);
            PG8_BAR; PG8_WAIT_L(0); PG8_MMA(0, 1, At, B1); PG8_BAR;
            PG8_LDA(At, 0, 1); PG8_STAGE(PG8_SA(0, 0), a2, voffA);
            PG8_BAR; PG8_WAIT_L(0); PG8_MMA(1, 0, At, B0); PG8_BAR; PG8_SCHED;
            PG8_STAGE(PG8_SB(0, 1), b2 + hstep, voffB);
            PG8_WAIT_V(6); PG8_BAR; PG8_MMA(1, 1, At, B1); PG8_BAR;
            PG8_LDB(B0, 1, 0); PG8_SCHED; PG8_LDA(At, 1, 0); PG8_STAGE(PG8_SA(0, 1), a2 + hstep, voffA);
            PG8_WAIT_L(8); PG8_BAR; PG8_WAIT_L(0); PG8_MMA(0, 0, At, B0); PG8_BAR; PG8_SCHED;
            PG8_LDB(B1, 1, 1); PG8_STAGE(PG8_SB(1, 0), b3, voffB);
            PG8_BAR; PG8_WAIT_L(0); PG8_MMA(0, 1, At, B1); PG8_BAR;
            PG8_LDA(At, 1, 1); PG8_STAGE(PG8_SA(1, 0), a3, voffA);
            PG8_BAR; PG8_WAIT_L(0); PG8_MMA(1, 0, At, B0); PG8_BAR; PG8_SCHED;
            PG8_STAGE(PG8_SB(1, 1), b3 + hstep, voffB);
            PG8_WAIT_V(6); PG8_BAR; PG8_MMA(1, 1, At, B1); PG8_BAR;
            }
        }
        if constexpr (ALIGN_EPI) { if (wr == 0) PG8_BAR; }
        if constexpr (!Epi::AFTER_DRAIN) { E(acc, cur, wr, wc, fr, fq); S.done(cur); }
        if (!has_next) break;
#pragma unroll
        for (int a = 0; a < 2; ++a)
#pragma unroll
            for (int b = 0; b < 2; ++b)
#pragma unroll
                for (int m = 0; m < 4; ++m)
#pragma unroll
                    for (int n = 0; n < 2; ++n) acc[a][b][m][n] = (f32x4){0.f, 0.f, 0.f, 0.f};
        cur = nxt; cA = nA; cB = nB; ++ui;
        if constexpr (ALIGN_EPI) { if (wr == 1) PG8_BAR; }
    }
    PG8_WAIT_V(0);
    if constexpr (!ALIGN_EPI) { if (wr == 0) PG8_BAR; }
    PG8_BAR;
    if constexpr (Epi::AFTER_DRAIN) { E.fused(acc, cur, wr, wc, fr, fq, lds, wid, lane); S.done(cur); }
#undef PG8_SA
#undef PG8_SB
#undef PG8_STAGE
#undef PG8_LDA
#undef PG8_LDB
#undef PG8_MMA
#undef PG8_WAIT_V
#undef PG8_WAIT_L
#undef PG8_BAR
#undef PG8_SCHED
}
}

constexpr int DM = 2048, NB = 4, SEQ = 2048, NL = 2, DB = 8, PAST = 16384, PAGE = 128, HD = 128;
constexpr int NH = 8, NKV = 2, HPG = 4, GH = 8, WIN = 512, CONVCH = 3072, DFF = 5632, INW = 6696;
constexpr int MP = NB * SEQ, MS = DB, MT = MP + MS, MPAD = 8448, NIN = 6912, NGU = 2 * DFF, NPG = PAST / PAGE;
constexpr float EPS = 1e-6f;
constexpr int PQ = 0, PKV = 1024, PCONV = 2560, PZ = 5632, PGL = 6656, PA = 6680, PBB = 6688;

constexpr size_t O_YP = 0, O_YS = O_YP + (size_t)MP * DM, O_PCMP = O_YS + (size_t)MS * DM, O_PSEL = O_PCMP + (size_t)NB * NL * NKV * SEQ * 2 * HD,
    O_PWIN = O_PSEL + (size_t)NB * NL * NKV * SEQ * 2 * HD, O_PGDN = O_PWIN + (size_t)NB * NL * NKV * WIN * 2 * HD, O_PCONV = O_PGDN + (size_t)NB * NL * GH * HD * HD,
    O_SCMP = O_PCONV + (size_t)NB * NL * 3 * CONVCH, O_SSEL = O_SCMP + (size_t)DB * NL * NKV * 2 * HD, O_SWIN = O_SSEL + (size_t)DB * NL * NKV * 2 * HD,
    O_SGDN = O_SWIN + (size_t)DB * NL * NKV * WIN * 2 * HD, O_SCONV = O_SGDN + (size_t)DB * NL * GH * HD * HD, O_END = O_SCONV + (size_t)DB * NL * 3 * CONVCH;

constexpr size_t MiB = 1u << 20;
constexpr size_t al(size_t x) { return (x + MiB - 1) / MiB * MiB; }
constexpr size_t WS_CTL = 0, CTL_BYTES = 1 * MiB;
constexpr size_t WS_WIN = WS_CTL + CTL_BYTES;
constexpr size_t WS_WOUT = WS_WIN + al((size_t)NL * NIN * DM * 2);
constexpr size_t WS_WGU = WS_WOUT + al((size_t)NL * DM * DM * 2);
constexpr size_t WS_WDN = WS_WGU + al((size_t)NL * NGU * DM * 2);
constexpr size_t WS_W1 = WS_WDN + al((size_t)NL * DM * DFF * 2);
constexpr size_t WS_MODP = WS_W1 + al((size_t)4 * 256 * 8192 * 2);
constexpr size_t WS_MOD = WS_MODP + al((size_t)8 * 2 * 12 * 12288 * 4);
constexpr size_t WS_ROPE = WS_MOD + al((size_t)2 * 12 * 12288 * 4);
constexpr size_t WS_X = WS_ROPE + al((size_t)2049 * 32 * 4);
constexpr size_t WS_H = WS_X + al((size_t)MPAD * DM * 4);
constexpr size_t WS_PROJ = WS_H + al((size_t)MPAD * DM * 2);
constexpr size_t WS_QF = WS_PROJ + al((size_t)MPAD * NIN * 4);
constexpr size_t WS_KWF = WS_QF + al((size_t)MT * 1024 * 4);
constexpr size_t WS_GATES = WS_KWF + al((size_t)NB * NKV * SEQ * 256 * 4);
constexpr size_t WS_GQ = WS_GATES + al((size_t)MT * 24 * 4);
constexpr size_t WS_GK = WS_GQ + al((size_t)MT * 1024 * 4);
constexpr size_t WS_GV = WS_GK + al((size_t)MT * 1024 * 4);
constexpr size_t WS_GO = WS_GV + al((size_t)MT * 1024 * 4);
constexpr size_t WS_GG = WS_GO + al((size_t)MT * 1024 * 4);
constexpr size_t WS_GB = WS_GG + al((size_t)MT * 8 * 4);
constexpr size_t WS_AS = WS_GB + al((size_t)MT * 8 * 4);
constexpr size_t WS_AP = WS_AS + al((size_t)4 * 4096 * 8192 * 2);
constexpr size_t WS_HIDS = WS_AP + al((size_t)2 * 256 * 8192 * 2);
constexpr size_t WS_HIDP = WS_HIDS + al((size_t)4 * 16384 * 256 * 4);
constexpr size_t WS_CBS = WS_HIDP + al((size_t)32 * 512 * 256 * 4);
constexpr size_t WS_CBP = WS_CBS + al((size_t)16384 * 128 * 4);
constexpr size_t WS_OMIX = WS_CBP + al((size_t)512 * 128 * 4);
constexpr size_t WS_MIX = WS_OMIX + al((size_t)MPAD * DM * 2);
constexpr size_t WS_ACT = WS_MIX + al((size_t)MPAD * DM * 4);
constexpr size_t WS_KSB = WS_ACT + al((size_t)MPAD * DFF * 2);
constexpr size_t KVB_SZ = (size_t)NB * NKV * SEQ * HD * 2;
constexpr size_t WS_VSB = WS_KSB + al(KVB_SZ), WS_KWB = WS_VSB + al(KVB_SZ), WS_VWB = WS_KWB + al(KVB_SZ);
constexpr size_t WS_ATA = WS_VWB + al(KVB_SZ);
constexpr size_t WS_GFR = WS_ATA + al((size_t)256 * 8 * 16 * 64 * 16);
constexpr size_t FR_W = 0, FR_Q = 16384, FR_K = 32768, FR_QK = 49152, FR_U = 57344, FR_CH = 90112;
constexpr size_t WS_GDEC = WS_GFR + al((size_t)1024 * FR_CH);
constexpr size_t WS_PEC = WS_GDEC + al(1024 * 4);
constexpr size_t WS_W1B = WS_PEC + al(1024 * 4);
constexpr size_t WS_END = WS_W1B + al((size_t)4 * 256 * 8192 * 2);

constexpr int CW_BAR = 4096;

constexpr int RING_BYTES = 131072, LDS_BYTES = 163840, MISC_OFF = LDS_BYTES - 256;
constexpr int NWAVES = 8, NTHR = 512;

__device__ __forceinline__ unsigned f2bf(float f) { unsigned u = __float_as_uint(f); return (u + 0x7fffu + ((u >> 16) & 1u)) >> 16; }
__device__ __forceinline__ unsigned pk2(float lo, float hi) { return f2bf(lo) | (f2bf(hi) << 16); }
__device__ __forceinline__ float wave_sum(float v) {
#pragma unroll
    for (int o = 1; o < 64; o <<= 1) v += __shfl_xor(v, o);
    return v;
}
__device__ __forceinline__ float wave_max(float v) {
#pragma unroll
    for (int o = 1; o < 64; o <<= 1) v = fmaxf(v, __shfl_xor(v, o));
    return v;
}
__device__ __forceinline__ float sigm(float x) { return 1.0f / (1.0f + expf(-x)); }
__device__ __forceinline__ float siluf(float x) { return x / (1.0f + expf(-x)); }
__device__ __forceinline__ float softplusf(float x) { return fmaxf(x, 0.f) + log1pf(expf(-fabsf(x))); }
__device__ __forceinline__ float gelu_tanh(float x) { return 0.5f * x * (1.0f + tanhf(0.7978845608028654f * (x + 0.044715f * x * x * x))); }

__constant__ double ROPE_INV[16] = {1.0, 0.44036660267178046, 0.19392274474868576, 0.08539710028576561, 0.03760603093086393, 0.016560440080994446, 0.007292664737217109,
    0.003211445994752591, 0.001414213562373095, 0.000622772421914596, 0.0002742481756762073, 0.00012076973741146504, 5.318295896944988e-05, 2.341999896140934e-05,
    1.031338537721246e-05, 4.5416704806078695e-06};

__device__ __forceinline__ void sincos_d(double a, float& c, float& s) {
    const double k = rint(a * 0.6366197723675814);
    const double r = (a - k * 1.5707963267948966) - k * 6.123233995736766e-17;
    const int q = (int)((long long)k & 3);
    const double r2 = r * r;
    const double sp = r * (1.0 + r2 * (-1.0 / 6 + r2 * (1.0 / 120 + r2 * (-1.0 / 5040 + r2 * (1.0 / 362880 + r2 * (-1.0 / 39916800 + r2 * (1.0 / 6227020800.0)))))));
    const double cp = 1.0 + r2 * (-0.5 + r2 * (1.0 / 24 + r2 * (-1.0 / 720 + r2 * (1.0 / 40320 + r2 * (-1.0 / 3628800 + r2 * (1.0 / 479001600 + r2 * (-1.0 / 87178291200.0)))))));
    double ss, cc;
    if (q == 0) { ss = sp; cc = cp; } else if (q == 1) { ss = cp; cc = -sp; } else if (q == 2) { ss = -sp; cc = -cp; } else { ss = -cp; cc = sp; }
    c = (float)cc; s = (float)ss;
}

#define XB_TMO      128
#define XB_XCNT(j)  (256  + 64 * (j))
#define XB_XSUB(j)  (1280 + 64 * (j))
#define XB_XGEN(j)  (2304 + 64 * (j))
#define XB_TOP      3328
#define XB_TOPGEN   3392
#define XCD_BAR_WORDS 3456
#define XB_SPIN_CAP (1u << 22)
__device__ __forceinline__ unsigned xb_ld(unsigned* p)              { return __hip_atomic_load(p, __ATOMIC_RELAXED, __HIP_MEMORY_SCOPE_AGENT); }
__device__ __forceinline__ unsigned xb_add(unsigned* p, unsigned v) { return __hip_atomic_fetch_add(p, v, __ATOMIC_RELAXED, __HIP_MEMORY_SCOPE_AGENT); }
__device__ __forceinline__ unsigned xb_xcc_id() { return (unsigned)__builtin_amdgcn_s_getreg((3 << 11) | 20) & 0xFu; }
#define XB_SPIN(cond, bar) do { unsigned _sp = 0; while (cond) { __builtin_amdgcn_s_sleep(1); \
    if ((++_sp & 255u) == 0u) { if (xb_ld(&(bar)[XB_TMO])) break; if (_sp > XB_SPIN_CAP) { atomicAdd(&(bar)[XB_TMO], 1u); break; } } } } while (0)
struct XcdBarrier { unsigned* bar; unsigned x; volatile LAS unsigned* st; };
__device__ __forceinline__ XcdBarrier xcd_barrier_post(unsigned* bar, volatile LAS unsigned* st) {
    XcdBarrier b; b.bar = bar; b.x = xb_xcc_id(); b.st = st;
    if (threadIdx.x == 0) (void)xb_add(&bar[XB_XCNT(b.x)], 1u);
    return b;
}
__device__ __forceinline__ void xcd_barrier_complete(unsigned* bar, unsigned x, unsigned& nloc, unsigned& nx) {
    const unsigned G = gridDim.x * gridDim.y * gridDim.z;
    unsigned sum, cnt, mine, sp = 0u;
    for (;;) {
        sum = 0u; cnt = 0u; mine = 0u;
#pragma unroll
        for (unsigned j = 0; j < 16; ++j) { const unsigned c = xb_ld(&bar[XB_XCNT(j)]); sum += c; cnt += (c > 0u) ? 1u : 0u; mine = (j == x) ? c : mine; }
        if (sum == G) break;
        __builtin_amdgcn_s_sleep(1);
        if ((++sp & 255u) == 0u) { if (xb_ld(&bar[XB_TMO])) break; if (sp > XB_SPIN_CAP) { atomicAdd(&bar[XB_TMO], 1u); break; } }
    }
    nloc = mine > 0u ? mine : 1u; nx = cnt > 0u ? cnt : 1u;
}
__device__ __forceinline__ void xcd_barrier(const XcdBarrier& b) {
    asm volatile("s_waitcnt vmcnt(0)" ::: "memory");
    __syncthreads();
    if (threadIdx.x == 0) {
        unsigned* bar = b.bar;
        __builtin_amdgcn_s_waitcnt(0);
        unsigned nloc = b.st[0], nx = b.st[1];
        if (nloc == 0u) { xcd_barrier_complete(bar, b.x, nloc, nx); b.st[0] = nloc; b.st[1] = nx; }
        const unsigned old = xb_add(&bar[XB_XSUB(b.x)], 1u);
        const unsigned gen = old / nloc;
        if (old + 1u == (gen + 1u) * nloc) {
            __builtin_amdgcn_fence(__ATOMIC_RELEASE, "agent");
            asm volatile("s_waitcnt vmcnt(0)" ::: "memory");
            const unsigned og = xb_add(&bar[XB_TOP], 1u);
            const unsigned tg = og / nx;
            if (og + 1u == (tg + 1u) * nx) xb_add(&bar[XB_TOPGEN], 1u);
            else XB_SPIN(xb_ld(&bar[XB_TOPGEN]) == tg, bar);
            __builtin_amdgcn_fence(__ATOMIC_ACQUIRE, "agent");
            xb_add(&bar[XB_XGEN(b.x)], 1u);
            asm volatile("s_waitcnt vmcnt(0)" ::: "memory");
        } else {
            XB_SPIN(xb_ld(&bar[XB_XGEN(b.x)]) == gen, bar);
            __builtin_amdgcn_fence(__ATOMIC_ACQUIRE, "agent");
            asm volatile("s_waitcnt vmcnt(0)" ::: "memory");
        }
    }
    __syncthreads();
}

struct Args { const void* in[28]; float* out; unsigned char* ws; int ph_lo, ph_hi; };

struct Frame {
    LAS unsigned char* lds;
    int tid, lane, wave, G, bid;
    const void* const* in; float* out; unsigned char* ws;
};


template <class Map>
__device__ __forceinline__ void tr_item(const Map& mp, int K, int NNEW, bf16* WT, LAS float* scr, int item, int lane, bf16* WB = nullptr) {
    const int nblk = NNEW / 64, kb = item / nblk, nb = item % nblk, k0 = 64 * kb, n0 = 64 * nb;
    const float* colp; int stride; const bool ok = mp(n0 + lane, colp, stride);
#pragma unroll
    for (int h = 0; h < 2; ++h) { float tv[32];
#pragma unroll
        for (int i = 0; i < 32; ++i) tv[i] = ok ? colp[(size_t)(k0 + 32 * h + i) * stride] : 0.f;
#pragma unroll
        for (int i = 0; i < 32; ++i) scr[(32 * h + i) * 65 + lane] = tv[i]; }
    asm volatile("s_waitcnt lgkmcnt(0)" ::: "memory");
    const int c = lane & 7;
#pragma unroll
    for (int j = 0; j < 8; ++j) { const int n = (lane >> 3) + 8 * j; const LAS float* s = scr + (8 * c) * 65 + n;
        u32x4 o; o.x = pk2(s[0 * 65], s[1 * 65]); o.y = pk2(s[2 * 65], s[3 * 65]); o.z = pk2(s[4 * 65], s[5 * 65]); o.w = pk2(s[6 * 65], s[7 * 65]);
        *(u32x4*)(WT + (size_t)(n0 + n) * K + k0 + 8 * c) = o;
        if (WB) *(u32x4*)(WB + ((size_t)((k0 >> 5) + (c >> 2)) * NNEW + n0 + n) * 32 + (c & 3) * 8) = o; }
    asm volatile("s_waitcnt lgkmcnt(0)" ::: "memory");
}
struct MapIn { const float* W; __device__ __forceinline__ bool operator()(int n, const float*& p, int& st) const {
    int o; if (n < 2560) o = n; else if (n < 5632) o = n + 24; else if (n < 6656) o = n + 40; else if (n < 6680) o = n - 4096; else if (n < 6696) o = n - 1024; else o = -1;
    st = INW; p = W + (o < 0 ? 0 : o); return o >= 0; } };
struct MapPlain { const float* W; int N; __device__ __forceinline__ bool operator()(int n, const float*& p, int& st) const { st = N; p = W + n; return true; } };
struct MapBase { const float* base; int stride, n0; __device__ __forceinline__ bool operator()(int n, const float*& p, int& st) const { st = stride; p = base + (n - n0); return true; } };

__device__ __forceinline__ const float* xrow_in(const Frame& F, int l, int r) {
    if (l == 0) return r < MP ? ((const float*)F.in[0]) + (size_t)r * DM : ((const float*)F.in[1]) + (size_t)(r - MP) * DM;
    return ((float*)(F.ws + WS_X)) + (size_t)r * DM;
}
__device__ __forceinline__ int modrow(int r) { return r < MP ? (r >> 11) : 4 + (r - MP); }

__device__ __forceinline__ void norm_mod_store(const f32x4 (&v)[8], const float* gain, const float* sh, const float* sc, bf16* orow, int lane) {
    float ss = 0.f;
#pragma unroll
    for (int j = 0; j < 8; ++j) ss += (v[j].x * v[j].x + v[j].y * v[j].y) + (v[j].z * v[j].z + v[j].w * v[j].w);
    ss = wave_sum(ss);
    const float rs = 1.0f / sqrtf(ss * (1.0f / DM) + EPS);
#pragma unroll
    for (int j = 0; j < 8; ++j) { const int c = (lane + 64 * j) * 4;
        const f32x4 g = *(const f32x4*)(gain + c), a = *(const f32x4*)(sc + c), b = *(const f32x4*)(sh + c);
        const f32x4 h = v[j] * rs * g * (a + 1.0f) + b;
        u32x2 o; o.x = pk2(h.x, h.y); o.y = pk2(h.z, h.w); *(u32x2*)(orow + c) = o; }
}

constexpr int TR_I_IN = (DM / 64) * (NIN / 64), TR_I_OUT = (DM / 64) * (DM / 64), TR_I_GU = (DM / 64) * (NGU / 64), TR_I_DN = (DFF / 64) * (DM / 64), TR_I_W1 = (8192 / 64) * (256 / 64);
constexpr int TR_I_L = TR_I_IN + TR_I_OUT + TR_I_GU + TR_I_DN;
__device__ __forceinline__ void tr_range(Frame& F, int first, int count, int rank, int nw) {
    LAS float* scr = (LAS float*)(F.lds + F.wave * 16896);
    const int lane = F.lane;
#pragma unroll 1
    for (int it = first + rank; it < first + count; it += nw) {
        int r = it;
        if (r < 2 * TR_I_L) {
            const int l = r / TR_I_L; r -= l * TR_I_L;
            if (r < TR_I_IN) { MapIn mp{((const float*)F.in[13]) + (size_t)l * DM * INW}; tr_item(mp, DM, NIN, ((bf16*)(F.ws + WS_WIN)) + (size_t)l * NIN * DM, scr, r, lane); continue; } r -= TR_I_IN;
            if (r < TR_I_OUT) { MapPlain mp{((const float*)F.in[21]) + (size_t)l * DM * DM, DM}; tr_item(mp, DM, DM, ((bf16*)(F.ws + WS_WOUT)) + (size_t)l * DM * DM, scr, r, lane); continue; } r -= TR_I_OUT;
            if (r < TR_I_GU) { const int n0 = (r % (NGU / 64)) * 64, tt = n0 >> 8, rr = n0 & 255;
                if (rr < 128) { MapBase mp{((const float*)F.in[24]) + (size_t)l * DM * DFF + tt * 128 + rr, DFF, n0}; tr_item(mp, DM, NGU, ((bf16*)(F.ws + WS_WGU)) + (size_t)l * NGU * DM, scr, r, lane); }
                else { MapBase mp{((const float*)F.in[25]) + (size_t)l * DM * DFF + tt * 128 + rr - 128, DFF, n0}; tr_item(mp, DM, NGU, ((bf16*)(F.ws + WS_WGU)) + (size_t)l * NGU * DM, scr, r, lane); }
                continue; } r -= TR_I_GU;
            { MapPlain mp{((const float*)F.in[26]) + (size_t)l * DFF * DM, DM}; tr_item(mp, DFF, DM, ((bf16*)(F.ws + WS_WDN)) + (size_t)l * DM * DFF, scr, r, lane); continue; }
        }
        r -= 2 * TR_I_L;
        { const int m = r / TR_I_W1; r -= m * TR_I_W1; MapPlain mp{((const float*)F.in[15]) + (size_t)m * 8192 * 256, 256}; tr_item(mp, 8192, 256, ((bf16*)(F.ws + WS_W1)) + (size_t)m * 256 * 8192, scr, r, lane, ((bf16*)(F.ws + WS_W1B)) + (size_t)m * 256 * 8192); }
    }
}

__device__ __forceinline__ void phase_prologue(Frame& F) {
    const int tid = F.tid, lane = F.lane, G = F.G;
    {
        LAS float* sc = (LAS float*)F.lds;
        for (int it = F.bid; it < 2 * 24 * 8; it += G) {
            const int ks = it & 7, chunk = (it >> 3) % 24, l = it / 192;
            for (int i = tid; i < 12 * 256; i += NTHR) { const int row = i >> 8, k = i & 255;
                const float c = row < 4 ? ((const float*)F.in[8])[row * DM + ks * 256 + k] : ((const float*)F.in[9])[(row - 4) * DM + ks * 256 + k]; sc[i] = siluf(c); }
            __syncthreads();
            const int n = chunk * 512 + tid;
            float acc[12];
#pragma unroll
            for (int r = 0; r < 12; ++r) acc[r] = 0.f;
            const float* w = ((const float*)F.in[10]) + ((size_t)l * DM + ks * 256) * 12288 + n;
#pragma unroll 1
            for (int k0 = 0; k0 < 256; k0 += 16) { float wv[16];
#pragma unroll
                for (int u = 0; u < 16; ++u) wv[u] = w[(size_t)(k0 + u) * 12288];
#pragma unroll
                for (int u = 0; u < 16; ++u)
#pragma unroll
                    for (int r = 0; r < 12; ++r) acc[r] += sc[r * 256 + k0 + u] * wv[u]; }
#pragma unroll
            for (int r = 0; r < 12; ++r) ((float*)(F.ws + WS_MODP))[((size_t)(ks * 2 + l) * 12 + r) * 12288 + n] = acc[r];
            __syncthreads();
        }
    }
    for (int i = F.bid * NTHR + tid; i < 2049 * 16; i += G * NTHR) {
        const int p = i >> 4, k = i & 15; const double pos = p < 2048 ? (double)p : (double)PAST;
        float c, s; sincos_d(pos * ROPE_INV[k], c, s); ((float*)(F.ws + WS_ROPE))[2 * i] = c; ((float*)(F.ws + WS_ROPE))[2 * i + 1] = s;
    }
    for (int i = F.bid * NTHR + tid; i < (MPAD - MT) * DM / 2; i += G * NTHR) { ((unsigned*)(((bf16*)(F.ws + WS_H)) + (size_t)MT * DM))[i] = 0u; ((unsigned*)(((bf16*)(F.ws + WS_OMIX)) + (size_t)MT * DM))[i] = 0u; }
    __syncthreads();
    tr_range(F, 0, TR_I_L, F.bid * NWAVES + F.wave, G * NWAVES);
    tr_range(F, 2 * TR_I_L, 4 * TR_I_W1, F.bid * NWAVES + F.wave, G * NWAVES);
}

__device__ __forceinline__ void ada_reduce(Frame& F) {
    for (int i = F.bid * NTHR + F.tid; i < 2 * 12 * 12288; i += F.G * NTHR) {
        const int n = i % 12288, l = i / (12 * 12288);
        float s = ((const float*)F.in[11])[l * 12288 + n];
#pragma unroll
        for (int ks = 0; ks < 8; ++ks) s += ((float*)(F.ws + WS_MODP))[(size_t)ks * (2 * 12 * 12288) + i];
        ((float*)(F.ws + WS_MOD))[i] = s;
    }
}

__device__ __forceinline__ void pe_w1(Frame& F) {
    const int gw = F.bid * NWAVES + F.wave;
    if (gw >= 1024) return;
    const bf16* wr = ((const bf16*)(F.ws + WS_W1)) + (size_t)gw * 8192; const float* pe = ((const float*)F.in[14]) + (size_t)(gw >> 8) * 8192;
    float s = 0.f;
#pragma unroll 4
    for (int i = 0; i < 16; ++i) { const int k = i * 512 + F.lane * 8;
        const u32x4 w = *(const u32x4*)(wr + k); const f32x4 p0 = *(const f32x4*)(pe + k), p1 = *(const f32x4*)(pe + k + 4);
        s += __uint_as_float(w.x << 16) * p0.x + __uint_as_float(w.x & 0xffff0000u) * p0.y + __uint_as_float(w.y << 16) * p0.z + __uint_as_float(w.y & 0xffff0000u) * p0.w
           + __uint_as_float(w.z << 16) * p1.x + __uint_as_float(w.z & 0xffff0000u) * p1.y + __uint_as_float(w.w << 16) * p1.z + __uint_as_float(w.w & 0xffff0000u) * p1.w; }
    s = wave_sum(s);
    if (F.lane == 0) ((float*)(F.ws + WS_PEC))[gw] = s;
}

template <int NSPLIT>
__device__ __forceinline__ void cmp_finish(Frame& F, const float* hid, size_t slab, int rows, int rows_per_mat, const float* w2base, float* outp, int bid0 = 0, int row0 = 0, const float* cadd = nullptr) {
    LAS float* hs = (LAS float*)F.lds;
    if (F.bid < bid0) return;
    for (int it = F.bid - bid0; it < rows / 4; it += F.G - bid0) {
#pragma unroll
        for (int i0 = 0; i0 < 2; ++i0) { const int i = F.tid + i0 * NTHR; const int rr = i >> 8, n = i & 255; const size_t R = (size_t)row0 + (size_t)it * 4 + rr;
            float pv[NSPLIT];
#pragma unroll
            for (int ks = 0; ks < NSPLIT; ++ks) pv[ks] = hid[(size_t)ks * slab + R * 256 + n];
            float s = cadd ? cadd[(R / rows_per_mat) * 256 + n] : 0.f;
#pragma unroll
            for (int ks = 0; ks < NSPLIT; ++ks) s += pv[ks];
            hs[i] = gelu_tanh(s); }
        __syncthreads();
        const int rr = F.tid >> 7, c = F.tid & 127; const size_t R = (size_t)row0 + (size_t)it * 4 + rr;
        const float* w2 = w2base + (R / rows_per_mat) * 32768;
        float acc = 0.f;
#pragma unroll 1
        for (int n0 = 0; n0 < 256; n0 += 32) { float wv[32];
#pragma unroll
            for (int u = 0; u < 32; ++u) wv[u] = w2[(n0 + u) * 128 + c];
#pragma unroll
            for (int u = 0; u < 32; ++u) acc += hs[rr * 256 + n0 + u] * wv[u]; }
        outp[R * 128 + c] = acc;
        __syncthreads();
    }
}

template <int NSPLIT>
__device__ __forceinline__ void cmp_finish16(Frame& F, const float* hid, size_t slab, int rows, int rows_per_mat, const float* w2base, float* outp, int bid0 = 0, int row0 = 0, const float* cadd = nullptr) {
    LAS float* hs = (LAS float*)F.lds;
    if (F.bid < bid0) return;
    for (int it = F.bid - bid0; it < rows / 16; it += F.G - bid0) {
        const size_t R0 = (size_t)row0 + (size_t)it * 16; const int mat = (int)(R0 / rows_per_mat);
#pragma unroll
        for (int i0 = 0; i0 < 8; ++i0) { const int i = F.tid + i0 * NTHR; const int rr = i >> 8, n = i & 255; const size_t R = R0 + rr;
            float pv[NSPLIT];
#pragma unroll
            for (int ks = 0; ks < NSPLIT; ++ks) pv[ks] = hid[(size_t)ks * slab + R * 256 + n];
            float s = cadd ? cadd[mat * 256 + n] : 0.f;
#pragma unroll
            for (int ks = 0; ks < NSPLIT; ++ks) s += pv[ks];
            hs[i] = gelu_tanh(s); }
        __syncthreads();
        const int g = F.tid >> 7, c = F.tid & 127;
        const float* w2 = w2base + (size_t)mat * 32768;
        float acc[4] = {0.f, 0.f, 0.f, 0.f};
#pragma unroll 1
        for (int n0 = 0; n0 < 256; n0 += 32) { float wv[32];
#pragma unroll
            for (int u = 0; u < 32; ++u) wv[u] = w2[(n0 + u) * 128 + c];
#pragma unroll
            for (int u = 0; u < 32; ++u)
#pragma unroll
                for (int r = 0; r < 4; ++r) acc[r] += hs[(g * 4 + r) * 256 + n0 + u] * wv[u]; }
#pragma unroll
        for (int r = 0; r < 4; ++r) outp[(R0 + g * 4 + r) * 128 + c] = acc[r];
        __syncthreads();
    }
}

__device__ __forceinline__ void phase_norm1(Frame& F, int l) {
    const int gw = F.bid * NWAVES + F.wave, NGW = F.G * NWAVES;
    for (int r = gw; r < MT; r += NGW) {
        const f32x4* xr = (const f32x4*)xrow_in(F, l, r) + F.lane;
        f32x4 v[8];
#pragma unroll
        for (int j = 0; j < 8; ++j) v[j] = xr[64 * j];
        const float* md = ((float*)(F.ws + WS_MOD)) + ((size_t)l * 12 + modrow(r)) * 12288;
        norm_mod_store(v, ((const float*)F.in[12]) + l * DM, md, md + 2048, ((bf16*)(F.ws + WS_H)) + (size_t)r * DM, F.lane);
    }
}

__device__ __forceinline__ void phase_postproj(Frame& F, int l, int parts = 7) {
    const int lane = F.lane, gw = F.bid * NWAVES + F.wave, NGW = F.G * NWAVES;
    const int j = lane & 31, hs = lane >> 5;
    float* PROJp = (float*)(F.ws + WS_PROJ);
    if (parts & 1)
#pragma unroll 1
    for (int r = gw; r < MT; r += NGW) {
        const float* pr = PROJp + (size_t)r * NIN;
        const bool isP = r < MP; const int b = isP ? (r >> 11) : (r - MP), t = isP ? (r & 2047) : 0;
        const float* rp = ((float*)(F.ws + WS_ROPE)) + (size_t)(isP ? t : 2048) * 32;
        f32x4 cs, sn;
#pragma unroll
        for (int e = 0; e < 4; ++e) { const int i = (4 * j + e) & 15; cs[e] = rp[2 * i]; sn[e] = rp[2 * i + 1]; }
        f32x4 qv[4], kv[3], vv[3];
#pragma unroll
        for (int i = 0; i < 4; ++i) qv[i] = *(const f32x4*)(pr + PQ + i * 256 + lane * 4);
#pragma unroll
        for (int s = 0; s < 3; ++s) { kv[s] = *(const f32x4*)(pr + PKV + s * 512 + lane * 4); vv[s] = *(const f32x4*)(pr + PKV + s * 512 + 256 + lane * 4); }
#pragma unroll
        for (int i = 0; i < 4; ++i) { f32x4 x = qv[i], o;
#pragma unroll
            for (int e = 0; e < 4; ++e) o[e] = __shfl_xor(x[e], 4);
            if (j < 4) x = x * cs - o * sn; else if (j < 8) x = x * cs + o * sn;
            *(f32x4*)(((float*)(F.ws + WS_QF)) + ((size_t)r * 8 + 2 * i + hs) * 128 + 4 * j) = x; }
        const int g = hs;
#pragma unroll
        for (int s = 0; s < 3; ++s) { f32x4 x = kv[s], o; const f32x4 v = vv[s];
#pragma unroll
            for (int e = 0; e < 4; ++e) o[e] = __shfl_xor(x[e], 4);
            if (j < 4) x = x * cs - o * sn; else if (j < 8) x = x * cs + o * sn;
            float* dst;
            if (s < 2) {
                if (isP) dst = F.out + (s == 0 ? O_PCMP : O_PSEL) + ((((size_t)b * NL + l) * NKV + g) * SEQ + t) * 256;
                else dst = F.out + (s == 0 ? O_SCMP : O_SSEL) + (((size_t)b * NL + l) * NKV + g) * 256;
            } else {
                dst = isP ? nullptr : F.out + O_SWIN + ((((size_t)b * NL + l) * NKV + g) * WIN + (WIN - 1)) * 256;
            }
            if (dst) { *(f32x4*)(dst + 4 * j) = x; *(f32x4*)(dst + 128 + 4 * j) = v; }
            if (s >= 1 && isP) { const size_t o2 = (((size_t)b * NKV + g) * SEQ + t) * HD + 4 * j;
                u32x2 kk, v2; kk.x = pg8::cvt_pk_bf16(x.x, x.y); kk.y = pg8::cvt_pk_bf16(x.z, x.w); v2.x = pg8::cvt_pk_bf16(v.x, v.y); v2.y = pg8::cvt_pk_bf16(v.z, v.w);
                *(u32x2*)((bf16*)(F.ws + (s == 1 ? WS_KSB : WS_KWB)) + o2) = kk; *(u32x2*)((bf16*)(F.ws + (s == 1 ? WS_VSB : WS_VWB)) + o2) = v2; }
            if (s == 2 && isP && t >= SEQ - WIN) { float* d2 = F.out + O_PWIN + ((((size_t)b * NL + l) * NKV + g) * WIN + (t - (SEQ - WIN))) * 256;
                *(f32x4*)(d2 + 4 * j) = x; *(f32x4*)(d2 + 128 + 4 * j) = v; }
            if (s == 0 && isP) {
                const int tt = t & 63; const size_t arow = ((size_t)b * 32 + (t >> 6)) * 2 + g;
                const float* pek = ((const float*)F.in[14]) + (((size_t)l * 2 + 0) * 64 + tt) * 128 + 4 * j;
                const f32x4 pk = *(const f32x4*)pek, pv = *(const f32x4*)(pek + 64 * 128);
                const f32x4 xa = x + pk, va = v + pv;
                u32x2 kk, v2; kk.x = pg8::cvt_pk_bf16(xa.x, xa.y); kk.y = pg8::cvt_pk_bf16(xa.z, xa.w); v2.x = pg8::cvt_pk_bf16(va.x, va.y); v2.y = pg8::cvt_pk_bf16(va.z, va.w);
                bf16* ak = ((bf16*)(F.ws + WS_AP)) + arow * 8192 + tt * 128 + 4 * j;
                *(u32x2*)ak = kk; *(u32x2*)(ak + (size_t)256 * 8192) = v2;
            }
        }
        if (lane < 24) ((float*)(F.ws + WS_GATES))[(size_t)r * 24 + lane] = sigm(pr[PGL + lane]);
        if (lane < 8) { ((float*)(F.ws + WS_GG))[(size_t)r * 8 + lane] = -expf(((const float*)F.in[18])[l * 8 + lane]) * softplusf(pr[PA + lane] + ((const float*)F.in[19])[l * 8 + lane]); ((float*)(F.ws + WS_GB))[(size_t)r * 8 + lane] = sigm(pr[PBB + lane]); }
        const float* stc = ((const float*)F.in[6]) + ((size_t)(isP ? 0 : b) * NL + l) * 3 * CONVCH;
        if (isP) { if (t >= SEQ - 3) { float* d = F.out + O_PCONV + (((size_t)b * NL + l) * 3 + (t - (SEQ - 3))) * CONVCH;
#pragma unroll
                for (int i = 0; i < 12; ++i) *(f32x4*)(d + i * 256 + lane * 4) = *(const f32x4*)(pr + PCONV + i * 256 + lane * 4); } }
        else { float* d = F.out + O_SCONV + ((size_t)b * NL + l) * 3 * CONVCH;
#pragma unroll
            for (int i = 0; i < 12; ++i) { const int c = i * 256 + lane * 4; *(f32x4*)(d + c) = *(const f32x4*)(stc + CONVCH + c); *(f32x4*)(d + CONVCH + c) = *(const f32x4*)(stc + 2 * CONVCH + c);
                *(f32x4*)(d + 2 * CONVCH + c) = *(const f32x4*)(pr + PCONV + c); } }
    }
    if (parts & 2) {
        const float* cwp = ((const float*)F.in[17]) + (size_t)l * 4 * CONVCH;
        const int NITEM = 12 * (NB * 32 + MS);
#pragma unroll 1
        for (int it = NGW - 1 - gw; it < NITEM; it += NGW) {
            const int cg = it % 12, tb = it / 12; const int part = cg >> 2;
            const int c = cg * 256 + lane * 4, head = (cg & 3) * 2 + hs;
            const bool isP = tb < NB * 32; const int b = isP ? (tb >> 5) : (tb - NB * 32);
            const int row0 = isP ? b * SEQ + (tb & 31) * 64 : MP + b, t0 = isP ? (tb & 31) * 64 : 0, nt = isP ? 64 : 1;
            f32x4 w0 = *(const f32x4*)(cwp + c), w1 = *(const f32x4*)(cwp + CONVCH + c), w2 = *(const f32x4*)(cwp + 2 * CONVCH + c), w3 = *(const f32x4*)(cwp + 3 * CONVCH + c);
            f32x4 x0, x1, x2; const f32x4 z4 = (f32x4){0.f, 0.f, 0.f, 0.f};
            if (isP) { if (t0 > 0) { x0 = *(const f32x4*)(PROJp + (size_t)(row0 - 3) * NIN + PCONV + c); x1 = *(const f32x4*)(PROJp + (size_t)(row0 - 2) * NIN + PCONV + c); x2 = *(const f32x4*)(PROJp + (size_t)(row0 - 1) * NIN + PCONV + c); }
                       else { x0 = z4; x1 = z4; x2 = z4; } }
            else { const float* stc = ((const float*)F.in[6]) + ((size_t)b * NL + l) * 3 * CONVCH + c; x0 = *(const f32x4*)stc; x1 = *(const f32x4*)(stc + CONVCH); x2 = *(const f32x4*)(stc + 2 * CONVCH); }
            float* dstb = (part == 0 ? ((float*)(F.ws + WS_GQ)) : part == 1 ? ((float*)(F.ws + WS_GK)) : ((float*)(F.ws + WS_GV)));
            const float qs = part == 0 ? 0.08838834764831845f : 1.0f;
            f32x4 xq[8];
#pragma unroll
            for (int u = 0; u < 8; ++u) xq[u] = (u < nt) ? *(const f32x4*)(PROJp + (size_t)(row0 + u) * NIN + PCONV + c) : z4;
#pragma unroll 1
            for (int tt0 = 0; tt0 < nt; tt0 += 8) {
                f32x4 xn[8];
#pragma unroll
                for (int u = 0; u < 8; ++u) xn[u] = xq[u];
                if (tt0 + 8 < nt) {
#pragma unroll
                    for (int u = 0; u < 8; ++u) xq[u] = *(const f32x4*)(PROJp + (size_t)(row0 + tt0 + 8 + u) * NIN + PCONV + c); }
                f32x4 y[8]; float ss[8];
#pragma unroll
                for (int u = 0; u < 8; ++u) {
                    const f32x4 xm3 = u >= 3 ? xn[u - 3 < 0 ? 0 : u - 3] : (u == 0 ? x0 : u == 1 ? x1 : x2);
                    const f32x4 xm2 = u >= 2 ? xn[u - 2 < 0 ? 0 : u - 2] : (u == 0 ? x1 : x2);
                    const f32x4 xm1 = u >= 1 ? xn[u - 1 < 0 ? 0 : u - 1] : x2;
                    f32x4 v = xm3 * w0 + xm2 * w1 + xm1 * w2 + xn[u] * w3;
#pragma unroll
                    for (int e = 0; e < 4; ++e) v[e] = v[e] * __builtin_amdgcn_rcpf(1.0f + __expf(-v[e]));
                    y[u] = v; ss[u] = (v.x * v.x + v.y * v.y) + (v.z * v.z + v.w * v.w); }
                if (part < 2) {
#pragma unroll
                    for (int o = 1; o < 32; o <<= 1)
#pragma unroll
                        for (int u = 0; u < 8; ++u) ss[u] += __shfl_xor(ss[u], o);
#pragma unroll
                    for (int u = 0; u < 8; ++u) y[u] = y[u] * (__builtin_amdgcn_rsqf(ss[u] + EPS) * qs); }
#pragma unroll
                for (int u = 0; u < 8; ++u) if (tt0 + u < nt) *(f32x4*)(dstb + ((size_t)(row0 + tt0 + u) * 8 + head) * 128 + 4 * j) = y[u];
                x0 = xn[5]; x1 = xn[6]; x2 = xn[7];
            }
        }
    }
    if (parts & 4)
    for (size_t i = (size_t)F.bid * NTHR + F.tid; i < (size_t)DB * NKV * 511 * 64; i += (size_t)F.G * NTHR) {
        const int q4 = (int)(i & 63); const size_t rest = i >> 6; const int row = (int)(rest % 511); const int bg = (int)(rest / 511); const int b = bg >> 1, g = bg & 1;
        const size_t base = (((size_t)b * NL + l) * NKV + g) * WIN;
        *(f32x4*)(F.out + O_SWIN + (base + row) * 256 + q4 * 4) = *(const f32x4*)(((const float*)F.in[4]) + (base + row + 1) * 256 + q4 * 4);
    }
}

__device__ __forceinline__ void phase_gdn_scan_naive(Frame& F, int l) {
    const int vb = F.bid;
    if (vb >= 32) return;
    const int pi = __builtin_amdgcn_readfirstlane(32 + vb * 2 + (F.tid >> 8)), w = F.tid & 255, col = w >> 1, half = w & 1;
    const int seq = pi >> 3, h = pi & 7;
    const bool isP = seq < 4; const int T = isP ? SEQ : 1; const int row0 = isP ? seq * SEQ : MP + (seq - 4);
    float S[64];
    if (isP) {
#pragma unroll
        for (int d = 0; d < 64; ++d) S[d] = 0.f;
    } else { const float* s0 = ((const float*)F.in[5]) + (((size_t)(seq - 4) * NL + l) * GH + h) * 16384 + (size_t)half * 64 * 128 + col;
#pragma unroll
        for (int d = 0; d < 64; ++d) S[d] = s0[d * 128]; }
    const float* GKp = (const float*)(F.ws + WS_GK); const float* GQp = (const float*)(F.ws + WS_GQ); const float* GVp = (const float*)(F.ws + WS_GV);
    const float* GGp = (const float*)(F.ws + WS_GG); const float* GBp = (const float*)(F.ws + WS_GB); float* GOp = (float*)(F.ws + WS_GO);
#pragma unroll 1
    for (int t = 0; t < T; ++t) {
        const size_t rh = (size_t)(row0 + t) * 8 + h;
        const f32x4* kp = (const f32x4*)(GKp + rh * 128 + half * 64); const f32x4* qp = (const f32x4*)(GQp + rh * 128 + half * 64);
        const float v = GVp[rh * 128 + col], gg = GGp[rh], beta = GBp[rh];
        const float eg = expf(gg);
        f32x4 kk[16];
        float ks0 = 0.f, ks1 = 0.f;
#pragma unroll
        for (int i = 0; i < 16; ++i) { kk[i] = kp[i]; ks0 += kk[i].x * S[4 * i] + kk[i].z * S[4 * i + 2]; ks1 += kk[i].y * S[4 * i + 1] + kk[i].w * S[4 * i + 3]; }
        float kS = ks0 + ks1; kS += __shfl_xor(kS, 1);
        const float cc = beta * (v - eg * kS);
        float o0 = 0.f, o1 = 0.f;
#pragma unroll
        for (int i = 0; i < 16; ++i) { const f32x4 qq = qp[i];
            S[4 * i] = eg * S[4 * i] + kk[i].x * cc; S[4 * i + 1] = eg * S[4 * i + 1] + kk[i].y * cc; S[4 * i + 2] = eg * S[4 * i + 2] + kk[i].z * cc; S[4 * i + 3] = eg * S[4 * i + 3] + kk[i].w * cc;
            o0 += S[4 * i] * qq.x + S[4 * i + 2] * qq.z; o1 += S[4 * i + 1] * qq.y + S[4 * i + 3] * qq.w; }
        float o = o0 + o1; o += __shfl_xor(o, 1);
        if (half == 0) GOp[rh * 128 + col] = o;
    }
    float* so = F.out + (isP ? O_PGDN + (((size_t)seq * NL + l) * GH + h) * 16384 : O_SGDN + (((size_t)(seq - 4) * NL + l) * GH + h) * 16384) + (size_t)half * 64 * 128 + col;
#pragma unroll
    for (int d = 0; d < 64; ++d) so[d * 128] = S[d];
}


__device__ __forceinline__ bf16x8 pack8(f32x4 a, f32x4 b) {
    u32x4 u; u.x = pg8::cvt_pk_bf16(a.x, a.y); u.y = pg8::cvt_pk_bf16(a.z, a.w); u.z = pg8::cvt_pk_bf16(b.x, b.y); u.w = pg8::cvt_pk_bf16(b.z, b.w);
    return __builtin_bit_cast(bf16x8, u);
}
#define MFMA16(a, b, c) __builtin_amdgcn_mfma_f32_16x16x32_bf16((a), (b), (c), 0, 0, 0)


template <int MODE, int PER>
__device__ __forceinline__ void skinny_gemm(Frame& F, const bf16* A, int lda, const bf16* Bt, int K, int nitems, float* outF, bf16* outB, int ldc) {
    const int lane = F.lane, wid = F.wave, q = lane >> 4, r16 = lane & 15;
    LAS float* red = (LAS float*)F.lds;
#pragma unroll 1
    for (int it = F.G - 1 - F.bid; it < nitems; it += F.G) {
        const int n0 = MODE != 1 ? it * 16 : (it >> 3) * 256 + (it & 7) * 16;
        const bf16* ap = A + (size_t)(r16 & 7) * lda + q * 8 + (size_t)wid * PER * 32;
        const bf16* bp0 = Bt + (size_t)(n0 + r16) * K + q * 8 + (size_t)wid * PER * 32;
        f32x4 acc0 = (f32x4){0.f, 0.f, 0.f, 0.f}, acc1 = acc0;
        constexpr int U = (PER % 11 == 0) ? 11 : 8;
#pragma unroll 1
        for (int s0 = 0; s0 < PER; s0 += U) {
            bf16x8 af[U], w0[U], w1[U];
#pragma unroll
            for (int u = 0; u < U; ++u) { af[u] = *(const bf16x8*)(ap + (s0 + u) * 32); w0[u] = *(const bf16x8*)(bp0 + (s0 + u) * 32); if (MODE == 1) w1[u] = *(const bf16x8*)(bp0 + (size_t)128 * K + (s0 + u) * 32); }
#pragma unroll
            for (int u = 0; u < U; ++u) { acc0 = MFMA16(w0[u], af[u], acc0); if (MODE == 1) acc1 = MFMA16(w1[u], af[u], acc1); }
        }
        *(LAS f32x4*)(red + (wid * 2 + 0) * 256 + lane * 4) = acc0;
        if (MODE == 1) *(LAS f32x4*)(red + (wid * 2 + 1) * 256 + lane * 4) = acc1;
        __syncthreads();
        if (wid == 0 && r16 < 8) {
            f32x4 s0v = (f32x4){0.f, 0.f, 0.f, 0.f}, s1v = s0v;
#pragma unroll
            for (int w = 0; w < 8; ++w) { s0v = s0v + *(const LAS f32x4*)(red + (w * 2 + 0) * 256 + lane * 4); if (MODE == 1) s1v = s1v + *(const LAS f32x4*)(red + (w * 2 + 1) * 256 + lane * 4); }
            if (MODE == 0) *(f32x4*)(outF + (size_t)(MP + r16) * ldc + n0 + 4 * q) = s0v;
            else if (MODE == 2) { u32x2 w2; w2.x = pg8::cvt_pk_bf16(s0v[0], s0v[1]); w2.y = pg8::cvt_pk_bf16(s0v[2], s0v[3]); *(u32x2*)(outB + (size_t)(MP + r16) * ldc + n0 + 4 * q) = w2; }
            else { float o[4];
#pragma unroll
                for (int j = 0; j < 4; ++j) o[j] = s0v[j] / (1.0f + __expf(-s0v[j])) * s1v[j];
                u32x2 w2; w2.x = pg8::cvt_pk_bf16(o[0], o[1]); w2.y = pg8::cvt_pk_bf16(o[2], o[3]);
                *(u32x2*)(outB + (size_t)(MP + r16) * ldc + it * 16 + 4 * q) = w2; }
        }
        __syncthreads();
    }
}


template <int MODE, int KSTEPS>
__device__ __forceinline__ void skinny_wave(Frame& F, const bf16* A, int lda, const bf16* Bt, int K, int nitems, float* outF, bf16* outB, int ldc, int rank, int nw) {
    const int lane = F.lane, q = lane >> 4, r16 = lane & 15;
#pragma unroll 1
    for (int it = rank; it < nitems; it += nw) {
        const int n0 = MODE == 0 ? it * 16 : (it >> 3) * 256 + (it & 7) * 16;
        const bf16* ap = A + (size_t)(r16 & 7) * lda + q * 8;
        const bf16* bp = Bt + (size_t)(n0 + r16) * K + q * 8;
        f32x4 acc0 = (f32x4){0.f, 0.f, 0.f, 0.f}, acc1 = acc0;
        constexpr int U = MODE == 0 ? 16 : 8;
#pragma unroll 1
        for (int s0 = 0; s0 < KSTEPS; s0 += U) { bf16x8 af[U], w0[U], w1[U];
#pragma unroll
            for (int u = 0; u < U; ++u) { af[u] = *(const bf16x8*)(ap + (s0 + u) * 32); w0[u] = *(const bf16x8*)(bp + (s0 + u) * 32); if (MODE == 1) w1[u] = *(const bf16x8*)(bp + (size_t)128 * K + (s0 + u) * 32); }
#pragma unroll
            for (int u = 0; u < U; ++u) { if (MODE == 1) { acc0 = MFMA16(w0[u], af[u], acc0); acc1 = MFMA16(w1[u], af[u], acc1); }
                else { if (u & 1) acc1 = MFMA16(w0[u], af[u], acc1); else acc0 = MFMA16(w0[u], af[u], acc0); } } }
        if (r16 < 8) {
            if (MODE == 0) *(f32x4*)(outF + (size_t)(MP + r16) * ldc + n0 + 4 * q) = acc0 + acc1;
            else { float o[4];
#pragma unroll
                for (int j = 0; j < 4; ++j) o[j] = acc0[j] / (1.0f + __expf(-acc0[j])) * acc1[j];
                u32x2 w2; w2.x = pg8::cvt_pk_bf16(o[0], o[1]); w2.y = pg8::cvt_pk_bf16(o[2], o[3]);
                *(u32x2*)(outB + (size_t)(MP + r16) * ldc + it * 16 + 4 * q) = w2; }
        }
    }
}
__device__ __forceinline__ void phase_cmp_direct(Frame& F) {
    const int lane = F.lane, wid = F.wave, q = lane >> 4, r16 = lane & 15;
    LAS unsigned char* lb = F.lds;
    constexpr int BB = 16384;
    const float* cache = (const float*)F.in[2]; const int* page_table = (const int*)F.in[7];
    const bf16* W1B = (const bf16*)(F.ws + WS_W1B); float* HID = (float*)(F.ws + WS_HIDS);
#pragma unroll 1
    for (int u = F.bid; u < 256; u += F.G) {
        const int combo = (u & 7) | (((u >> 3) & 1) << 3), mat = combo >> 2, pk = combo & 3, rt = u >> 4, l = mat >> 1, kv = mat & 1;
        const int rot = rt * 4;
        const float* arow[2];
#pragma unroll
        for (int mt = 0; mt < 2; ++mt) { const int m = rt * 256 + wid * 32 + mt * 16 + r16; const int b = m >> 9, j = (m >> 1) & 255, g = m & 1;
            const int phys = page_table[b * NPG + (j >> 1)];
            arow[mt] = cache + ((((size_t)phys * NL + l) * NKV + g) * PAGE + (j & 1) * 64) * 256 + kv * 128 + (size_t)(16 * pk) * 256 + 8 * q; }
        const bf16* brow[2];
#pragma unroll
        for (int i = 0; i < 2; ++i) brow[i] = W1B + (size_t)mat * 256 * 8192 + ((size_t)(64 * pk) * 256 + wid * 32 + i * 16 + (lane >> 2)) * 32 + (((lane & 3) ^ ((0x78 >> (2 * (lane >> 4))) & 3)) * 8);
#define CMPD_B(t, slot) do { _Pragma("unroll") for (int i = 0; i < 2; ++i) \
            __builtin_amdgcn_global_load_lds((const unsigned*)(brow[i] + (((t) + rot) & 63) * 8192), (LAS unsigned*)(lb + (slot) * BB + (wid * 2 + i) * 1024), 16, 0, 0); } while (0)
#define CMPD_A(t, j) do { const int tt = ((t) + rot) & 63; _Pragma("unroll") for (int mt = 0; mt < 2; ++mt) { const float* ap = arow[mt] + (tt >> 2) * 256 + (tt & 3) * 32; \
            ar[j][2 * mt] = *(const f32x4*)ap; ar[j][2 * mt + 1] = *(const f32x4*)(ap + 4); } } while (0)
        f32x4 acc[2][16];
#pragma unroll
        for (int mt = 0; mt < 2; ++mt)
#pragma unroll
            for (int nt = 0; nt < 16; ++nt) acc[mt][nt] = (f32x4){0.f, 0.f, 0.f, 0.f};
        f32x4 ar[4][4];
        __syncthreads();
#pragma unroll
        for (int j = 0; j < 4; ++j) { CMPD_B(j, j); CMPD_A(j, j); }
        const int boff = r16 * 64 + ((q ^ ((0x78 >> (2 * ((r16 >> 2) & 3))) & 3)) << 4);
        int slot = 0;
#pragma unroll 1
        for (int t0 = 0; t0 < 64; t0 += 4) {
#pragma unroll
            for (int j = 0; j < 4; ++j) {
                const int t = t0 + j;
                if (t0 < 60) asm volatile("s_waitcnt vmcnt(18) lgkmcnt(0)" ::: "memory"); else asm volatile("s_waitcnt vmcnt(0) lgkmcnt(0)" ::: "memory");
                __builtin_amdgcn_s_barrier();
                const LAS unsigned char* bb = lb + slot * BB + boff;
                bf16x8 af[2];
#pragma unroll
                for (int mt = 0; mt < 2; ++mt) af[mt] = pack8(ar[j][2 * mt], ar[j][2 * mt + 1]);
                int ns = slot + 4; if (ns >= 5) ns -= 5;
                if (t0 < 60) { CMPD_B(t + 4, ns); CMPD_A(t + 4, j); }
#pragma unroll
                for (int g2 = 0; g2 < 8; ++g2) { bf16x8 bf[2];
#pragma unroll
                    for (int e = 0; e < 2; ++e) bf[e] = *(const LAS bf16x8*)(bb + (2 * g2 + e) * 1024);
                    __builtin_amdgcn_sched_barrier(0);
#pragma unroll
                    for (int e = 0; e < 2; ++e) { acc[0][2 * g2 + e] = MFMA16(bf[e], af[0], acc[0][2 * g2 + e]); acc[1][2 * g2 + e] = MFMA16(bf[e], af[1], acc[1][2 * g2 + e]); } }
                slot = slot + 1; if (slot >= 5) slot = 0;
            }
        }
#undef CMPD_A
#undef CMPD_B
        float* hp = HID + (size_t)pk * ((size_t)16384 * 256);
#pragma unroll
        for (int mt = 0; mt < 2; ++mt) { float* rp = hp + (size_t)(mat * 4096 + rt * 256 + wid * 32 + mt * 16 + r16) * 256 + 4 * q;
#pragma unroll
            for (int nt = 0; nt < 16; ++nt) *(f32x4*)(rp + 16 * nt) = acc[mt][nt]; }
    }
    __syncthreads();
}

#ifndef GP_W0
#define GP_W0 128
#define GP_NW 8
#endif
__device__ __forceinline__ void phase_gdn_pre(Frame& F, int l) {
    if (F.bid < GP_W0 || F.wave >= GP_NW) return;
    const int NGW = (F.G - GP_W0) * GP_NW, gw = (F.bid - GP_W0) * GP_NW + F.wave;
    const int lane0 = F.lane;
    LAS float* Af = (LAS float*)(F.lds + F.wave * 16896);
    LAS unsigned char* Tb = (LAS unsigned char*)Af;
    const float* GQp = (const float*)(F.ws + WS_GQ); const float* GKp = (const float*)(F.ws + WS_GK); const float* GVp = (const float*)(F.ws + WS_GV);
    const float* GGp = (const float*)(F.ws + WS_GG); const float* GBp = (const float*)(F.ws + WS_GB); float* GDECp = (float*)(F.ws + WS_GDEC);
#pragma unroll 1
    for (int it = gw; it < 1024; it += NGW) {
        int lane = lane0; asm volatile("" : "+v"(lane));
        const int q = lane >> 4, r16 = lane & 15;
        const int c = it & 31, p = it >> 5, h = p & 7, b = p >> 3;
        const int row0 = b * SEQ + c * 64;
        unsigned char* fr = F.ws + WS_GFR + (size_t)it * FR_CH;
        const float gg = GGp[(size_t)(row0 + lane) * 8 + h], bt = GBp[(size_t)(row0 + lane) * 8 + h];
        float gc = gg;
#pragma unroll
        for (int o = 1; o < 64; o <<= 1) { const float tt = __shfl_up(gc, o); if (lane >= o) gc += tt; }
        const float gl = __shfl(gc, 63);
        if (lane == 0) GDECp[it] = __expf(gl);
        bf16x8 kf[4][4];
#pragma unroll
        for (int mt = 0; mt < 4; ++mt)
#pragma unroll
            for (int s = 0; s < 4; ++s) { const float* kr = GKp + ((size_t)(row0 + 16 * mt + r16) * 8 + h) * 128 + 32 * s + 4 * q; kf[mt][s] = pack8(*(const f32x4*)kr, *(const f32x4*)(kr + 16)); }
        asm volatile("s_waitcnt lgkmcnt(0)" ::: "memory");
#pragma unroll
        for (int mt = 0; mt < 4; ++mt)
#pragma unroll
            for (int nt = 0; nt <= mt; ++nt) {
                f32x4 acc = (f32x4){0.f, 0.f, 0.f, 0.f};
#pragma unroll
                for (int s = 0; s < 4; ++s) acc = MFMA16(kf[mt][s], kf[nt][s], acc);
                const int j = 16 * nt + r16; const float gcj = __shfl(gc, j);
#pragma unroll
                for (int r = 0; r < 4; ++r) { const int i = 16 * mt + 4 * q + r; const float gi = __shfl(gc, i), bi = __shfl(bt, i);
                    Af[i * 64 + j] = (j < i) ? bi * acc[r] * __expf(gi - gcj) : 0.f; }
            }
        {
            bf16x8 qf[4][4];
#pragma unroll
            for (int mt = 0; mt < 4; ++mt) { const float egi = __expf(__shfl(gc, 16 * mt + r16));
#pragma unroll
                for (int s = 0; s < 4; ++s) { const float* qr = GQp + ((size_t)(row0 + 16 * mt + r16) * 8 + h) * 128 + 32 * s + 4 * q;
                    const f32x4 a = *(const f32x4*)qr, b2 = *(const f32x4*)(qr + 16); qf[mt][s] = pack8(a, b2);
                    *(bf16x8*)(fr + FR_Q + ((mt * 4 + s) * 64 + lane) * 16) = pack8(a * egi, b2 * egi); } }
#pragma unroll
            for (int nt = 0; nt < 4; ++nt) { const int i = 16 * nt + r16; const float gci = __shfl(gc, i);
#pragma unroll
                for (int sp = 0; sp < 2; ++sp) { f32x4 v0 = (f32x4){0.f, 0.f, 0.f, 0.f}, v1 = v0;
                    if (2 * sp <= nt) { f32x4 acc = (f32x4){0.f, 0.f, 0.f, 0.f};
#pragma unroll
                        for (int s = 0; s < 4; ++s) acc = MFMA16(kf[2 * sp][s], qf[nt][s], acc);
#pragma unroll
                        for (int r = 0; r < 4; ++r) { const int jp = 32 * sp + 4 * q + r; const float gj = __shfl(gc, jp); v0[r] = (jp <= i) ? acc[r] * __expf(gci - gj) : 0.f; } }
                    if (2 * sp + 1 <= nt) { f32x4 acc = (f32x4){0.f, 0.f, 0.f, 0.f};
#pragma unroll
                        for (int s = 0; s < 4; ++s) acc = MFMA16(kf[2 * sp + 1][s], qf[nt][s], acc);
#pragma unroll
                        for (int r = 0; r < 4; ++r) { const int jp = 32 * sp + 16 + 4 * q + r; const float gj = __shfl(gc, jp); v1[r] = (jp <= i) ? acc[r] * __expf(gci - gj) : 0.f; } }
                    *(bf16x8*)(fr + FR_QK + ((nt * 2 + sp) * 64 + lane) * 16) = pack8(v0, v1); } }
        }
        float t[64];
#pragma unroll
        for (int i = 0; i < 64; ++i) {
            float acc = (lane == i) ? 1.f : 0.f;
#pragma unroll
            for (int j4 = 0; j4 < (i + 3) / 4; ++j4) { const f32x4 a = *(const LAS f32x4*)(Af + i * 64 + j4 * 4);
                if (4 * j4 + 0 < i) acc -= a.x * t[4 * j4 + 0];
                if (4 * j4 + 1 < i) acc -= a.y * t[4 * j4 + 1];
                if (4 * j4 + 2 < i) acc -= a.z * t[4 * j4 + 2];
                if (4 * j4 + 3 < i) acc -= a.w * t[4 * j4 + 3]; }
            t[i] = acc;
            if ((i & 3) == 3) asm volatile("" ::: "memory");
        }
        asm volatile("s_waitcnt lgkmcnt(0)" ::: "memory");
        { const float sb = bt, sg = bt * __expf(gc);
#pragma unroll
          for (int i = 0; i < 64; ++i) { const int off = i * 128 + ((((lane >> 3) ^ (i & 7)) << 4) + (lane & 7) * 2);
              *(LAS unsigned short*)(Tb + off) = (unsigned short)f2bf(t[i] * sb); *(LAS unsigned short*)(Tb + 8192 + off) = (unsigned short)f2bf(t[i] * sg); } }
        asm volatile("s_waitcnt lgkmcnt(0)" ::: "memory");
        {
            bf16x8 ta[4][2];
#pragma unroll
            for (int mt = 0; mt < 4; ++mt)
#pragma unroll
                for (int sp = 0; sp < 2; ++sp) ta[mt][sp] = *(const LAS bf16x8*)(Tb + (16 * mt + r16) * 128 + (((4 * sp + q) ^ (r16 & 7)) << 4));
#pragma unroll 4
            for (int n8 = 0; n8 < 8; ++n8) { bf16x8 vb[2];
#pragma unroll
                for (int sp = 0; sp < 2; ++sp) { float x[8];
#pragma unroll
                    for (int jj = 0; jj < 8; ++jj) x[jj] = GVp[((size_t)(row0 + 32 * sp + 8 * q + jj) * 8 + h) * 128 + 16 * n8 + r16];
                    vb[sp] = pack8((f32x4){x[0], x[1], x[2], x[3]}, (f32x4){x[4], x[5], x[6], x[7]}); }
#pragma unroll
                for (int mt = 0; mt < 4; ++mt) { f32x4 acc = (f32x4){0.f, 0.f, 0.f, 0.f};
#pragma unroll
                    for (int sp = 0; sp < 2; ++sp) acc = MFMA16(ta[mt][sp], vb[sp], acc);
                    *(f32x4*)(fr + FR_U + ((n8 * 4 + mt) * 64 + lane) * 16) = acc; } }
        }
        {
            float fdec[2][8]; const float ed = __expf(gl - gc);
#pragma unroll
            for (int sp = 0; sp < 2; ++sp)
#pragma unroll
                for (int j = 0; j < 8; ++j) fdec[sp][j] = __shfl(ed, 32 * sp + (j < 4 ? 4 * q + j : 16 + 4 * q + j - 4));
            bf16x8 tb[4][2];
#pragma unroll
            for (int nt = 0; nt < 4; ++nt)
#pragma unroll
                for (int sp = 0; sp < 2; ++sp) { const int i = 16 * nt + r16;
                    const u32x2 lo = *(const LAS u32x2*)(Tb + 8192 + i * 128 + ((((4 * sp + (q >> 1)) ^ (i & 7)) << 4) + (q & 1) * 8));
                    const u32x2 hi = *(const LAS u32x2*)(Tb + 8192 + i * 128 + ((((4 * sp + 2 + (q >> 1)) ^ (i & 7)) << 4) + (q & 1) * 8));
                    u32x4 w4; w4.x = lo.x; w4.y = lo.y; w4.z = hi.x; w4.w = hi.y; tb[nt][sp] = __builtin_bit_cast(bf16x8, w4); }
#pragma unroll 2
            for (int s = 0; s < 4; ++s) {
                f32x4 acc[2][4];
#pragma unroll
                for (int e = 0; e < 2; ++e)
#pragma unroll
                    for (int nt = 0; nt < 4; ++nt) acc[e][nt] = (f32x4){0.f, 0.f, 0.f, 0.f};
#pragma unroll
                for (int e = 0; e < 2; ++e)
#pragma unroll
                    for (int sp = 0; sp < 2; ++sp) { float x[8];
#pragma unroll
                        for (int j = 0; j < 8; ++j) { const int tok = 32 * sp + (j < 4 ? 4 * q + j : 16 + 4 * q + j - 4);
                            x[j] = GKp[((size_t)(row0 + tok) * 8 + h) * 128 + 16 * (2 * s + e) + r16]; }
                        const bf16x8 ka = pack8((f32x4){x[0], x[1], x[2], x[3]}, (f32x4){x[4], x[5], x[6], x[7]});
#pragma unroll
                        for (int nt = 0; nt < 4; ++nt) acc[e][nt] = MFMA16(ka, tb[nt][sp], acc[e][nt]);
#pragma unroll
                        for (int j = 0; j < 8; ++j) x[j] *= fdec[sp][j];
                        *(bf16x8*)(fr + FR_K + (((2 * s + e) * 2 + sp) * 64 + lane) * 16) = pack8((f32x4){x[0], x[1], x[2], x[3]}, (f32x4){x[4], x[5], x[6], x[7]}); }
#pragma unroll
                for (int nt = 0; nt < 4; ++nt) *(bf16x8*)(fr + FR_W + ((nt * 4 + s) * 64 + lane) * 16) = pack8(-acc[0][nt], -acc[1][nt]);
            }
        }
        asm volatile("s_waitcnt lgkmcnt(0)" ::: "memory");
    }
}

__device__ __forceinline__ void phase_gdn_scan(Frame& F, int l) {
    if (F.bid >= 64) return;
    const int lane = F.lane, wid = F.wave, q = lane >> 4, r16 = lane & 15;
    const int hf = (F.bid >> 3) & 1, p = (F.bid >> 4) * 8 + (F.bid & 7), h = p & 7, b = p >> 3;
    const float* GDECp = (const float*)(F.ws + WS_GDEC); float* GOp = (float*)(F.ws + WS_GO);
    LAS unsigned char* lb = F.lds;
    constexpr int CB = 57344, UB = 16384, UOFF = 2 * CB, DOFF = 2 * CB + 2 * UB;
    __syncthreads();
    if (wid >= 4) {
        const int lw = wid - 4, sl = hf * 4 + lw;
        const unsigned char* fr = F.ws + WS_GFR + (size_t)(p * 32) * FR_CH;
#pragma unroll
        for (int f = 0; f < 14; ++f) __builtin_amdgcn_global_load_lds((const unsigned*)(fr + (lw + 4 * f) * 1024 + lane * 16), (LAS unsigned*)(lb + (lw + 4 * f) * 1024), 16, 0, 0);
        f32x4 u4[4];
#pragma unroll
        for (int mt = 0; mt < 4; ++mt) u4[mt] = *(const f32x4*)(fr + FR_U + ((sl * 4 + mt) * 64 + lane) * 16);
        const float d0 = GDECp[p * 32];
#pragma unroll
        for (int mt = 0; mt < 4; ++mt) *(LAS f32x4*)(lb + UOFF + (lw * 4 + mt) * 1024 + lane * 16) = u4[mt];
        if (wid == 4 && lane == 0) *(LAS float*)(lb + DOFF) = d0;
        asm volatile("s_waitcnt vmcnt(0) lgkmcnt(0)" ::: "memory");
    }
    __builtin_amdgcn_s_barrier();
    f32x4 S[8];
#pragma unroll
    for (int m = 0; m < 8; ++m) S[m] = (f32x4){0.f, 0.f, 0.f, 0.f};
    const int sl = hf * 4 + (wid & 3);
#pragma unroll 1
    for (int c = 0; c < 32; ++c) {
        if (wid >= 4) {
            if (c + 1 < 32) {
                const int lw = wid - 4, nbuf = (c + 1) & 1;
                const unsigned char* fr = F.ws + WS_GFR + (size_t)(p * 32 + c + 1) * FR_CH; LAS unsigned char* nb = lb + nbuf * CB;
#pragma unroll
                for (int f = 0; f < 14; ++f) __builtin_amdgcn_global_load_lds((const unsigned*)(fr + (lw + 4 * f) * 1024 + lane * 16), (LAS unsigned*)(nb + (lw + 4 * f) * 1024), 16, 0, 0);
                f32x4 u4[4];
#pragma unroll
                for (int mt = 0; mt < 4; ++mt) u4[mt] = *(const f32x4*)(fr + FR_U + ((sl * 4 + mt) * 64 + lane) * 16);
                const float dn = GDECp[p * 32 + c + 1];
#pragma unroll
                for (int mt = 0; mt < 4; ++mt) *(LAS f32x4*)(lb + UOFF + nbuf * UB + (lw * 4 + mt) * 1024 + lane * 16) = u4[mt];
                if (wid == 4 && lane == 0) *(LAS float*)(lb + DOFF + nbuf * 64) = dn;
                asm volatile("s_waitcnt vmcnt(0) lgkmcnt(0)" ::: "memory");
            }
        } else {
            const LAS unsigned char* cb = lb + (c & 1) * CB;
            const float dec = *(const LAS float*)(lb + DOFF + (c & 1) * 64);
            f32x4 vn[4], o[4];
#pragma unroll
            for (int mt = 0; mt < 4; ++mt) { vn[mt] = *(const LAS f32x4*)(lb + UOFF + (c & 1) * UB + (wid * 4 + mt) * 1024 + lane * 16); o[mt] = (f32x4){0.f, 0.f, 0.f, 0.f}; }
            bf16x8 Sb[4];
#pragma unroll
            for (int s = 0; s < 4; ++s) Sb[s] = pack8(S[2 * s], S[2 * s + 1]);
#pragma unroll
            for (int s = 0; s < 4; ++s) { bf16x8 wf[4], qf[4];
#pragma unroll
                for (int mt = 0; mt < 4; ++mt) { wf[mt] = *(const LAS bf16x8*)(cb + FR_W + ((mt * 4 + s) * 64 + lane) * 16); qf[mt] = *(const LAS bf16x8*)(cb + FR_Q + ((mt * 4 + s) * 64 + lane) * 16); }
#pragma unroll
                for (int mt = 0; mt < 4; ++mt) { vn[mt] = MFMA16(wf[mt], Sb[s], vn[mt]); o[mt] = MFMA16(qf[mt], Sb[s], o[mt]); } }
            bf16x8 Vb[2];
#pragma unroll
            for (int sp = 0; sp < 2; ++sp) Vb[sp] = pack8(vn[2 * sp], vn[2 * sp + 1]);
#pragma unroll
            for (int m2 = 0; m2 < 4; ++m2) { bf16x8 kf[4];
#pragma unroll
                for (int e = 0; e < 4; ++e) kf[e] = *(const LAS bf16x8*)(cb + FR_K + (((2 * m2 + (e >> 1)) * 2 + (e & 1)) * 64 + lane) * 16);
                S[2 * m2] = S[2 * m2] * dec; S[2 * m2 + 1] = S[2 * m2 + 1] * dec;
                S[2 * m2] = MFMA16(kf[0], Vb[0], S[2 * m2]); S[2 * m2 + 1] = MFMA16(kf[2], Vb[0], S[2 * m2 + 1]);
                S[2 * m2] = MFMA16(kf[1], Vb[1], S[2 * m2]); S[2 * m2 + 1] = MFMA16(kf[3], Vb[1], S[2 * m2 + 1]); }
            { bf16x8 gf[8];
#pragma unroll
              for (int e = 0; e < 8; ++e) gf[e] = *(const LAS bf16x8*)(cb + FR_QK + (e * 64 + lane) * 16);
#pragma unroll
              for (int mt = 0; mt < 4; ++mt) { o[mt] = MFMA16(gf[mt * 2], Vb[0], o[mt]); }
#pragma unroll
              for (int mt = 0; mt < 4; ++mt) { o[mt] = MFMA16(gf[mt * 2 + 1], Vb[1], o[mt]); } }
#pragma unroll
            for (int mt = 0; mt < 4; ++mt)
#pragma unroll
                for (int r = 0; r < 4; ++r) GOp[((size_t)(b * SEQ + c * 64 + 16 * mt + 4 * q + r) * 8 + h) * 128 + sl * 16 + r16] = o[mt][r];
            asm volatile("s_waitcnt lgkmcnt(0)" ::: "memory");
        }
        __builtin_amdgcn_s_barrier();
    }
    if (wid < 4) {
        float* so = F.out + O_PGDN + (((size_t)b * NL + l) * GH + h) * 16384 + sl * 16 + r16;
#pragma unroll
        for (int m = 0; m < 8; ++m)
#pragma unroll
            for (int r = 0; r < 4; ++r) so[(size_t)(16 * m + 4 * q + r) * 128] = S[m][r];
    }
    __syncthreads();
}

__device__ __forceinline__ void phase_gdn_out(Frame& F, int l) {
    if (F.bid < 16 || F.bid >= 128) return;
    const int lane = F.lane, qb = F.bid >> 3;
    int cum = (F.bid & 7) * (25 - qb);
    for (int qq = 2; qq < qb; ++qq) cum += 8 * (25 - qq);
    const int r_lo = (int)(((long)MT * cum) / 1848), r_hi = (int)(((long)MT * (cum + 25 - qb)) / 1848);
    const float* gn = ((const float*)F.in[20]) + l * 128;
    const float g0 = gn[lane], g1 = gn[64 + lane];
    for (int r = r_lo + F.wave; r < r_hi; r += NWAVES) {
        const float* go = ((const float*)(F.ws + WS_GO)) + (size_t)r * 1024; const float* z = ((const float*)(F.ws + WS_PROJ)) + (size_t)r * NIN + PZ;
        float o[16], zz[16], ss[8];
#pragma unroll
        for (int i = 0; i < 16; ++i) { o[i] = go[(i >> 1) * 128 + (i & 1) * 64 + lane]; zz[i] = z[(i >> 1) * 128 + (i & 1) * 64 + lane]; }
#pragma unroll
        for (int h = 0; h < 8; ++h) ss[h] = o[2 * h] * o[2 * h] + o[2 * h + 1] * o[2 * h + 1];
#pragma unroll
        for (int ofs = 1; ofs < 64; ofs <<= 1)
#pragma unroll
            for (int h = 0; h < 8; ++h) ss[h] += __shfl_xor(ss[h], ofs);
        bf16* dst = ((bf16*)(F.ws + WS_OMIX)) + (size_t)r * DM + 1024;
#pragma unroll
        for (int h = 0; h < 8; ++h) { const float rs = __builtin_amdgcn_rsqf(ss[h] * (1.0f / 128.0f) + EPS);
            dst[h * 128 + lane] = (bf16)f2bf(o[2 * h] * rs * g0 * (zz[2 * h] * __builtin_amdgcn_rcpf(1.0f + __expf(-zz[2 * h])))); dst[h * 128 + 64 + lane] = (bf16)f2bf(o[2 * h + 1] * rs * g1 * (zz[2 * h + 1] * __builtin_amdgcn_rcpf(1.0f + __expf(-zz[2 * h + 1])))); }
    }
}

struct Soft { float m[4], l[4], a0[4], a1[4]; };
__device__ __forceinline__ void soft_init(Soft& s) {
#pragma unroll
    for (int i = 0; i < 4; ++i) { s.m[i] = -INFINITY; s.l[i] = 0.f; s.a0[i] = 0.f; s.a1[i] = 0.f; }
}
__device__ __forceinline__ void attn_block(const LAS float* qs, const float* kptr, const float* vbase, int vstride, int k_lo, int k_hi, int lane, Soft& st, float (&sout)[4]) {
    const bool valid = lane >= k_lo && lane <= k_hi;
    float s[4] = {0.f, 0.f, 0.f, 0.f};
    if (valid) {
#pragma unroll 1
        for (int half = 0; half < 2; ++half) { f32x4 kk[16];
#pragma unroll
            for (int i = 0; i < 16; ++i) kk[i] = *(const f32x4*)(kptr + half * 64 + i * 4);
#pragma unroll
            for (int i = 0; i < 16; ++i)
#pragma unroll
                for (int hh = 0; hh < 4; ++hh) { const f32x4 qq = *(const LAS f32x4*)(qs + hh * 128 + half * 64 + i * 4); s[hh] += (kk[i].x * qq.x + kk[i].y * qq.y) + (kk[i].z * qq.z + kk[i].w * qq.w); } }
    }
    float p[4];
#pragma unroll
    for (int hh = 0; hh < 4; ++hh) {
        s[hh] = valid ? s[hh] * 0.08838834764831845f : -INFINITY; sout[hh] = s[hh];
        const float mn = fmaxf(st.m[hh], wave_max(s[hh]));
        const float corr = (st.m[hh] == -INFINITY) ? 0.f : expf(st.m[hh] - mn);
        p[hh] = valid ? expf(s[hh] - mn) : 0.f;
        st.l[hh] = st.l[hh] * corr + wave_sum(p[hh]); st.a0[hh] *= corr; st.a1[hh] *= corr; st.m[hh] = mn;
    }
    int k = k_lo;
#pragma unroll 1
    for (; k + 7 <= k_hi; k += 8) { float v0[8], v1[8];
#pragma unroll
        for (int e = 0; e < 8; ++e) { const float* vr = vbase + (size_t)(k + e) * vstride; v0[e] = vr[lane]; v1[e] = vr[64 + lane]; }
#pragma unroll
        for (int e = 0; e < 8; ++e)
#pragma unroll
            for (int hh = 0; hh < 4; ++hh) { const float pb = __shfl(p[hh], k + e); st.a0[hh] += pb * v0[e]; st.a1[hh] += pb * v1[e]; } }
#pragma unroll 1
    for (; k <= k_hi; ++k) { const float* vr = vbase + (size_t)k * vstride; const float v0 = vr[lane], v1 = vr[64 + lane];
#pragma unroll
        for (int hh = 0; hh < 4; ++hh) { const float pb = __shfl(p[hh], k); st.a0[hh] += pb * v0; st.a1[hh] += pb * v1; } }
}

__device__ __forceinline__ void phase_nsa_sample(Frame& F, int l) {
    if (F.bid >= MS * 2) return;
    const int tid = F.tid, lane = F.lane, wid = F.wave;
    const int s = F.bid >> 1, g = F.bid & 1, r = MP + s;
    LAS float* qs = (LAS float*)F.lds;
    LAS float* imps = qs + 512;
    LAS unsigned* selw = (LAS unsigned*)(imps + 256);
    LAS float* part = imps + 512;
    constexpr int PST = 520;
    const float* QFp = (const float*)(F.ws + WS_QF); const float* CBSp = (const float*)(F.ws + WS_CBS); const float* GATp = (const float*)(F.ws + WS_GATES);
    const float* cache_sel = (const float*)F.in[3]; const float* cache_win = (const float*)F.in[4]; const int* page_table = (const int*)F.in[7];
    __syncthreads();
    qs[tid] = QFp[((size_t)r * 8 + g * 4) * 128 + tid];
    __syncthreads();
    Soft sc, ss, sw; soft_init(sc); soft_init(ss); soft_init(sw);
    float sraw[4] = {0.f, 0.f, 0.f, 0.f}, sdum[4];
    const float* kcb = CBSp + (((size_t)(l * 2 + 0) * 4096) + ((size_t)s * 256) * 2 + g) * 128; const float* vcb = kcb + (size_t)4096 * 128;
    if (wid < 4) attn_block(qs, kcb + ((size_t)wid * 64 + lane) * 256, vcb + (size_t)wid * 64 * 256, 256, 0, 63, lane, sc, sraw);
    { LAS float* pp = part + (wid * 3 + 0) * PST;
#pragma unroll
      for (int hh = 0; hh < 4; ++hh) { if (lane == 0) { pp[hh] = sc.m[hh]; pp[4 + hh] = sc.l[hh]; } pp[8 + hh * 128 + lane] = sc.a0[hh]; pp[8 + hh * 128 + 64 + lane] = sc.a1[hh]; } }
    __syncthreads();
    if (wid < 4) {
        float imp = 0.f;
#pragma unroll
        for (int hh = 0; hh < 4; ++hh) { float M = -INFINITY;
#pragma unroll
            for (int w = 0; w < 4; ++w) M = fmaxf(M, part[(w * 3) * PST + hh]);
            float L = 0.f;
#pragma unroll
            for (int w = 0; w < 4; ++w) L += part[(w * 3) * PST + 4 + hh] * expf(part[(w * 3) * PST + hh] - M);
            imp += expf(sraw[hh] - M) / L; }
        imps[wid * 64 + lane] = imp;
    }
    __syncthreads();
    if (wid < 4) {
        const int j = tid; const float mine = imps[j]; int cnt = 0;
#pragma unroll 2
        for (int jj = 1; jj <= 254; ++jj) { const float o = imps[jj]; cnt += (o > mine || (o == mine && jj < j)) ? 1 : 0; }
        const bool sel = (j == 0) || (j == 255) || (j >= 1 && j <= 254 && cnt < 13);
        const unsigned long long bal = __ballot(sel);
        if (lane == 0) { selw[wid * 2] = (unsigned)bal; selw[wid * 2 + 1] = (unsigned)(bal >> 32); }
    }
    __syncthreads();
    if (wid < 4) {
        const int j = tid; const unsigned lo = selw[wid * 2], hi = selw[wid * 2 + 1];
        const unsigned long long bal = ((unsigned long long)hi << 32) | lo;
        if ((bal >> lane) & 1ull) { int pos = __popcll(bal & ((1ull << lane) - 1ull));
            for (int w = 0; w < wid; ++w) pos += __popc(selw[w * 2]) + __popc(selw[w * 2 + 1]);
            if (pos < 15) selw[8 + pos] = (unsigned)j; }
    }
    __syncthreads();
#pragma unroll 1
    for (int t = wid; t < 25; t += 8) {
        if (t < 15) { const int idx = (int)selw[8 + t];
            const int phys = page_table[s * NPG + (idx >> 1)];
            const float* blk = cache_sel + (((((size_t)phys * NL + l) * NKV + g) * 2 + (idx & 1)) * 64) * 256;
            attn_block(qs, blk + (size_t)lane * 256, blk + 128, 256, 0, 63, lane, ss, sdum);
        } else if (t == 15) { const float* nw = F.out + O_SSEL + (((size_t)s * NL + l) * NKV + g) * 256;
            attn_block(qs, nw, nw + 128, 256, 0, 0, lane, ss, sdum);
        } else if (t < 24) { const int c = t - 16; const float* wb = cache_win + ((((size_t)s * NL + l) * NKV + g) * WIN) * 256;
            attn_block(qs, wb + ((size_t)c * 64 + lane) * 256, wb + (size_t)c * 64 * 256 + 128, 256, 0, 63, lane, sw, sdum);
        } else { const float* nw = F.out + O_SWIN + ((((size_t)s * NL + l) * NKV + g) * WIN + (WIN - 1)) * 256;
            attn_block(qs, nw, nw + 128, 256, 0, 0, lane, sw, sdum); }
    }
    { LAS float* p1 = part + (wid * 3 + 1) * PST; LAS float* p2 = part + (wid * 3 + 2) * PST;
#pragma unroll
      for (int hh = 0; hh < 4; ++hh) { if (lane == 0) { p1[hh] = ss.m[hh]; p1[4 + hh] = ss.l[hh]; p2[hh] = sw.m[hh]; p2[4 + hh] = sw.l[hh]; }
          p1[8 + hh * 128 + lane] = ss.a0[hh]; p1[8 + hh * 128 + 64 + lane] = ss.a1[hh]; p2[8 + hh * 128 + lane] = sw.a0[hh]; p2[8 + hh * 128 + 64 + lane] = sw.a1[hh]; } }
    __syncthreads();
    { const int hh = tid >> 7, d = tid & 127; float res = 0.f;
#pragma unroll
      for (int br = 0; br < 3; ++br) { const int nw = br == 0 ? 4 : 8; float M = -INFINITY;
          for (int w = 0; w < nw; ++w) M = fmaxf(M, part[(w * 3 + br) * PST + hh]);
          float L = 0.f, A = 0.f;
          for (int w = 0; w < nw; ++w) { const float mw = part[(w * 3 + br) * PST + hh]; if (mw == -INFINITY) continue; const float e = expf(mw - M);
              L += part[(w * 3 + br) * PST + 4 + hh] * e; A += part[(w * 3 + br) * PST + 8 + hh * 128 + d] * e; }
          const float gt = GATp[(size_t)r * 24 + (g * 4 + hh) * 3 + br];
          res += L > 0.f ? gt * A / L : 0.f; }
      ((bf16*)(F.ws + WS_OMIX))[(size_t)r * DM + (g * 4 + hh) * 128 + d] = (bf16)f2bf(res); }
    __syncthreads();
}

namespace att {
typedef short s16x4 __attribute__((ext_vector_type(4)));
typedef float f32x16 __attribute__((ext_vector_type(16)));
constexpr int SHM = 16384;
constexpr float SCALE = 0.08838834764831845f, THR = 8.f, C2 = 1.4426950408889634f * SCALE;
#define ATT_KSWZ(row, colB) ((row) * 256 + ((colB) ^ (((row) & 7) << 4)))
#define ATT_SBAR() __builtin_amdgcn_sched_barrier(0)
__device__ __forceinline__ int v_st(int k, int c) { const int kk = (k & ~0xC) | ((k & 4) << 1) | ((k & 8) >> 1); return ((kk >> 3) * 4 + (c >> 5)) * 512 + ((kk & 7) * 32 + (c & 31)) * 2; }
__device__ __forceinline__ int v_rd_base(int lane) { return ((lane & 3) << 3) | (((lane >> 2) & 3) << 6) | (((lane >> 4) & 1) << 5) | (((lane >> 5) & 1) << 8); }
constexpr int v_rd_off(int d0, int ks, int half) { return d0 * 512 + ks * 4096 + half * 2048; }
__device__ __forceinline__ int crow(int r, int hi) { return (r & 3) + 8 * (r >> 2) + 4 * hi; }
__device__ __forceinline__ void partialSM(f32x16& p0, f32x16& p1, float& m_reg, float& mn, float& alpha) {
    float pmax = p0[0];
#pragma unroll
    for (int r = 1; r < 16; ++r) pmax = fmaxf(pmax, p0[r]);
#pragma unroll
    for (int r = 0; r < 16; ++r) pmax = fmaxf(pmax, p1[r]);
    { auto rr = __builtin_amdgcn_permlane32_swap(__float_as_uint(pmax), __float_as_uint(pmax), false, false);
      pmax = fmaxf(__uint_as_float(rr[0]), __uint_as_float(rr[1])); }
    if (__builtin_expect(__all((pmax - m_reg) * SCALE <= THR), 1)) { mn = m_reg; alpha = 1.f; }
    else { mn = fmaxf(m_reg, pmax); alpha = __builtin_amdgcn_exp2f((m_reg - mn) * C2); m_reg = mn; }
    const float mnL = -mn * C2;
#pragma unroll
    for (int r = 0; r < 16; ++r) p0[r] = fmaf(p0[r], C2, mnL);
#pragma unroll
    for (int r = 0; r < 16; ++r) p1[r] = fmaf(p1[r], C2, mnL);
#pragma unroll
    for (int r = 0; r < 16; ++r) p0[r] = __builtin_amdgcn_exp2f(p0[r]);
}
__device__ __forceinline__ void finishSM(f32x16& p0, f32x16& p1, float alpha, float& l_reg, bf16x8& pa0, bf16x8& pa1, bf16x8& pa2, bf16x8& pa3) {
#pragma unroll
    for (int r = 0; r < 16; ++r) p1[r] = __builtin_amdgcn_exp2f(p1[r]);
    float ps = 0;
#pragma unroll
    for (int r = 0; r < 16; ++r) ps += p0[r];
#pragma unroll
    for (int r = 0; r < 16; ++r) ps += p1[r];
    { auto rr = __builtin_amdgcn_permlane32_swap(__float_as_uint(ps), __float_as_uint(ps), false, false);
      ps = __uint_as_float(rr[0]) + __uint_as_float(rr[1]); }
    l_reg = l_reg * alpha + ps;
#define ATT_PK4(P, B_, OUT) do { unsigned a0 = pg8::cvt_pk_bf16(P[B_+0], P[B_+1]), a1 = pg8::cvt_pk_bf16(P[B_+2], P[B_+3]);                          \
        unsigned b0 = pg8::cvt_pk_bf16(P[B_+4], P[B_+5]), b1 = pg8::cvt_pk_bf16(P[B_+6], P[B_+7]);                                             \
        auto r0 = __builtin_amdgcn_permlane32_swap(a0, b0, false, false); auto r1 = __builtin_amdgcn_permlane32_swap(a1, b1, false, false); \
        u32x4 w = {r0[0], r1[0], r0[1], r1[1]}; OUT = __builtin_bit_cast(bf16x8, w); } while (0)
    ATT_PK4(p0, 0, pa0); ATT_PK4(p0, 8, pa1); ATT_PK4(p1, 0, pa2); ATT_PK4(p1, 8, pa3);
#undef ATT_PK4
}
template <bool ZERO>
__device__ __forceinline__ void qkt(f32x16& p0, f32x16& p1, const LAS char* Kb, int r32, int hi, const bf16x8* qr) {
    if (ZERO) { p0 = f32x16{}; p1 = f32x16{}; }
    const LAS char* kb[4];
#pragma unroll
    for (int dd = 0; dd < 4; ++dd) kb[dd] = Kb + ATT_KSWZ(r32, (dd * 16 + hi * 8) * 2);
#pragma unroll
    for (int d0 = 0; d0 < 8; ++d0) { const LAS char* a = kb[d0 & 3] + (d0 >> 2) * 128;
        const bf16x8 b0 = *(const LAS bf16x8*)a;
        const bf16x8 b1 = *(const LAS bf16x8*)(a + 32 * 256);
        p0 = __builtin_amdgcn_mfma_f32_32x32x16_bf16(b0, qr[d0], p0, 0, 0, 0);
        p1 = __builtin_amdgcn_mfma_f32_32x32x16_bf16(b1, qr[d0], p1, 0, 0, 0); }
}
__device__ __forceinline__ void pv_tile(f32x16* o, int vb0, bf16x8 pa0, bf16x8 pa1, bf16x8 pa2, bf16x8 pa3) {
#define ATT_TRRD(dst, off) asm volatile("ds_read_b64_tr_b16 %0, %1 offset:%2" : "=&v"(dst) : "v"(vb0), "i"(off) : "memory")
#define ATT_PV_D0(d0) do { s16x4 l0, l1, l2, l3, h0, h1, h2, h3; constexpr int b_ = v_rd_off(d0, 0, 0); \
        ATT_TRRD(l0, b_); ATT_TRRD(h0, b_ + 2048); ATT_TRRD(l1, b_ + 4096); ATT_TRRD(h1, b_ + 6144); ATT_TRRD(l2, b_ + 8192); ATT_TRRD(h2, b_ + 10240); ATT_TRRD(l3, b_ + 12288); ATT_TRRD(h3, b_ + 14336); \
        asm volatile("s_waitcnt lgkmcnt(0)" ::: "memory"); ATT_SBAR();   \
        o[d0] = __builtin_amdgcn_mfma_f32_32x32x16_bf16(pa0, (bf16x8){l0[0], l0[1], l0[2], l0[3], h0[0], h0[1], h0[2], h0[3]}, o[d0], 0, 0, 0);   \
        o[d0] = __builtin_amdgcn_mfma_f32_32x32x16_bf16(pa1, (bf16x8){l1[0], l1[1], l1[2], l1[3], h1[0], h1[1], h1[2], h1[3]}, o[d0], 0, 0, 0);   \
        o[d0] = __builtin_amdgcn_mfma_f32_32x32x16_bf16(pa2, (bf16x8){l2[0], l2[1], l2[2], l2[3], h2[0], h2[1], h2[2], h2[3]}, o[d0], 0, 0, 0);   \
        o[d0] = __builtin_amdgcn_mfma_f32_32x32x16_bf16(pa3, (bf16x8){l3[0], l3[1], l3[2], l3[3], h3[0], h3[1], h3[2], h3[3]}, o[d0], 0, 0, 0); } while (0)
    ATT_PV_D0(0); ATT_PV_D0(1); ATT_PV_D0(2); ATT_PV_D0(3);
#undef ATT_PV_D0
#undef ATT_TRRD
}
}

__device__ __forceinline__ void phase_nsa_mfma(Frame& F, int l) {
    using namespace att;
    const int tid0 = F.tid, wid = F.wave;
    LAS char* V_lds = (LAS char*)F.lds; LAS char* K_lds = V_lds + SHM; LAS char* K2_lds = V_lds + 3 * SHM;
    LAS float* tbl = (LAS float*)(V_lds + 4 * SHM) + wid * 256; LAS float* al_l = tbl; LAS float* sc_l = tbl + 32;
    LAS unsigned* uni = (LAS unsigned*)(V_lds + 4 * SHM + 8192);
    const float NEG = -__builtin_inff();
#pragma unroll 1
    for (int it = F.bid; it < 256; it += F.G) {
        unsigned char* wsl = F.ws; asm volatile("" : "+s"(wsl));
        const float* QFp = (const float*)(wsl + WS_QF); const float* GATp = (const float*)(wsl + WS_GATES); const float* CBPp = (const float*)(wsl + WS_CBP);
        int tid = tid0; asm volatile("" : "+v"(tid));
        const int lane = tid & 63, r32 = lane & 31, hi = lane >> 5;
        const int sr = tid >> 4, sc = (tid & 15) * 8, vst0 = v_st(sr, sc), vst1 = v_st(32 + sr, sc), kws = ATT_KSWZ(sr, sc * 2);
        const int vb0 = (int)(unsigned)(size_t)V_lds + v_rd_base(lane);
        const int xc = it & 7, b = xc >> 1, g = xc & 1, qb = it >> 3;
        const int q0 = qb * 64;
        const int rho = wid * 32 + r32, qi = rho >> 2, hh = rho & 3, trow = b * SEQ + q0 + qi, tq = q0 + qi;
        const unsigned kvoff = (unsigned)((b * NKV + g) * SEQ * HD);
        __syncthreads();
        if (tid == 0) uni[0] = 0u;
        bf16x8 qr[8];
        f32x16 o[4];
        f32x4* ata = (f32x4*)(wsl + WS_ATA) + ((size_t)(it * 8 + wid) * 16) * 64 + lane;
        float m_reg = -1e30f, l_reg = 0.f, mn, alpha;
        f32x16 p0, p1; bf16x8 pa0, pa1, pa2, pa3;
        unsigned selmask;
        {
            bf16x8 ql[8];
            const float* qp = QFp + ((size_t)trow * 8 + g * 4 + hh) * 128 + hi * 8;
#pragma unroll
            for (int d0 = 0; d0 < 8; ++d0) { const f32x4 a = *(const f32x4*)(qp + d0 * 16), c = *(const f32x4*)(qp + d0 * 16 + 4);
                qr[d0] = pack8(a, c); const u32x4 u = __builtin_bit_cast(u32x4, qr[d0]);
                f32x4 ra, rc; ra.x = a.x - __uint_as_float(u.x << 16); ra.y = a.y - __uint_as_float(u.x & 0xffff0000u); ra.z = a.z - __uint_as_float(u.y << 16); ra.w = a.w - __uint_as_float(u.y & 0xffff0000u);
                rc.x = c.x - __uint_as_float(u.z << 16); rc.y = c.y - __uint_as_float(u.z & 0xffff0000u); rc.z = c.z - __uint_as_float(u.w << 16); rc.w = c.w - __uint_as_float(u.w & 0xffff0000u);
                ql[d0] = pack8(ra, rc); }
            { const float* kr = CBPp + ((size_t)(b * 32 + sr) * 2 + g) * 128 + sc; const float* vr = kr + (size_t)256 * 128;
              const f32x4 a = *(const f32x4*)kr, c = *(const f32x4*)(kr + 4); const bf16x8 kh = pack8(a, c); const u32x4 u = __builtin_bit_cast(u32x4, kh);
              f32x4 ra, rc; ra.x = a.x - __uint_as_float(u.x << 16); ra.y = a.y - __uint_as_float(u.x & 0xffff0000u); ra.z = a.z - __uint_as_float(u.y << 16); ra.w = a.w - __uint_as_float(u.y & 0xffff0000u);
              rc.x = c.x - __uint_as_float(u.z << 16); rc.y = c.y - __uint_as_float(u.z & 0xffff0000u); rc.z = c.z - __uint_as_float(u.w << 16); rc.w = c.w - __uint_as_float(u.w & 0xffff0000u);
              unsigned zr; asm volatile("v_mov_b32 %0, 0" : "=v"(zr)); u32x4 z4u; z4u.x = zr; z4u.y = zr; z4u.z = zr; z4u.w = zr;
              const bf16x8 z8 = __builtin_bit_cast(bf16x8, z4u);
              *(LAS bf16x8*)(K_lds + kws) = kh; *(LAS bf16x8*)(K_lds + kws + 32 * 256) = z8;
              *(LAS bf16x8*)(K2_lds + kws) = pack8(ra, rc); *(LAS bf16x8*)(K2_lds + kws + 32 * 256) = z8;
              *(LAS bf16x8*)(V_lds + vst0) = pack8(*(const f32x4*)vr, *(const f32x4*)(vr + 4)); *(LAS bf16x8*)(V_lds + vst1) = z8; }
            __syncthreads();
            qkt<true>(p0, p1, K_lds, r32, hi, qr); qkt<false>(p0, p1, K_lds, r32, hi, ql); qkt<false>(p0, p1, K2_lds, r32, hi, qr);
            const int nvis = (tq + 1) >> 6;
#pragma unroll
            for (int r = 0; r < 16; ++r) { if (crow(r, hi) >= nvis) p0[r] = NEG; p1[r] = NEG; }
            partialSM(p0, p1, m_reg, mn, alpha); finishSM(p0, p1, alpha, l_reg, pa0, pa1, pa2, pa3);
            const int cur = qb;
            if (cur < 16) selmask = (2u << cur) - 1u;
            else {
                const float inv = l_reg > 0.f ? 1.0f / l_reg : 0.f;
                float il[16], ih[16];
#pragma unroll
                for (int r = 0; r < 16; ++r) { float v = p0[r] * inv; v += __shfl_xor(v, 1); v += __shfl_xor(v, 2);
                    const int kj = crow(r, hi); if (kj < 1 || kj > cur - 2) v = -1.f;
                    auto rr = __builtin_amdgcn_permlane32_swap(__float_as_uint(v), __float_as_uint(v), false, false); il[r] = __uint_as_float(rr[0]); ih[r] = __uint_as_float(rr[1]); }
                unsigned part = 0u;
#pragma unroll
                for (int r = 0; r < 16; ++r) { const int kj = crow(r, hi); const float mine = hi ? ih[r] : il[r]; int cnt = 0;
#pragma unroll
                    for (int r2 = 0; r2 < 16; ++r2) { const int j0 = crow(r2, 0), j1 = crow(r2, 1);
                        cnt += (il[r2] > mine || (il[r2] == mine && j0 < kj)) ? 1 : 0; cnt += (ih[r2] > mine || (ih[r2] == mine && j1 < kj)) ? 1 : 0; }
                    const bool sel = (kj == 0) || (kj == cur) || (kj == cur - 1) || (mine >= 0.f && cnt < 13);
                    part |= sel ? (1u << kj) : 0u; }
                auto rr = __builtin_amdgcn_permlane32_swap(part, part, false, false); selmask = rr[0] | rr[1];
            }
            unsigned wu = selmask;
#pragma unroll
            for (int ofs = 1; ofs < 32; ofs <<= 1) wu |= (unsigned)__shfl_xor((int)wu, ofs);
            if (lane == 0) atomicOr((unsigned*)uni, wu);
            asm volatile("" ::: "memory");
#pragma unroll
            for (int d = 0; d < 4; ++d) o[d] = f32x16{};
            pv_tile(o, vb0, pa0, pa1, pa2, pa3);
            if (hi == 0) sc_l[r32] = l_reg > 0.f ? GATp[(size_t)trow * 24 + (g * 4 + hh) * 3 + 0] / l_reg : 0.f;
            asm volatile("s_waitcnt lgkmcnt(0)" ::: "memory");
#pragma unroll
            for (int d = 0; d < 4; ++d)
#pragma unroll
                for (int r4 = 0; r4 < 4; ++r4) { f32x4 v;
#pragma unroll
                    for (int e = 0; e < 4; ++e) { v[e] = o[d][r4 * 4 + e] * sc_l[crow(r4 * 4 + e, hi)]; o[d][r4 * 4 + e] = 0.f; }
                    ata[(d * 4 + r4) * 64] = v; }
            m_reg = -1e30f; l_reg = 0.f;
        }
        __syncthreads();
        const unsigned un = uni[0];
        const unsigned wun = (unsigned)__builtin_amdgcn_readfirstlane((int)({ unsigned w_ = selmask;
#pragma unroll
            for (int ofs = 1; ofs < 32; ofs <<= 1) w_ |= (unsigned)__shfl_xor((int)w_, ofs); w_; }));
#pragma unroll 1
        for (int br = 1; br <= 2; ++br) {
            const bf16* Kp = (const bf16*)(wsl + (br == 1 ? WS_KSB : WS_KWB)) + kvoff; const bf16* Vp = (const bf16*)(wsl + (br == 1 ? WS_VSB : WS_VWB)) + kvoff;
            unsigned tiles = br == 1 ? (un & ((2u << qb) - 1u)) : ((2u << qb) - 1u) & ~((qb >= 9) ? ((1u << (qb - 8)) - 1u) : 0u);
            bf16x8 st_k0, st_k1, st_v0, st_v1;
#define ATT_LOAD(jt) do { const size_t ro = (size_t)((jt) * 64 + sr) * HD + sc; st_k0 = *(const bf16x8*)(Kp + ro); st_k1 = *(const bf16x8*)(Kp + ro + 32 * HD); st_v0 = *(const bf16x8*)(Vp + ro); st_v1 = *(const bf16x8*)(Vp + ro + 32 * HD); } while (0)
#define ATT_WRITE(bo) do { *(LAS bf16x8*)(K_lds + (bo) + kws) = st_k0; *(LAS bf16x8*)(K_lds + (bo) + kws + 32 * 256) = st_k1; *(LAS bf16x8*)(V_lds + (bo) + vst0) = st_v0; *(LAS bf16x8*)(V_lds + (bo) + vst1) = st_v1; } while (0)
            int j = __builtin_ctz(tiles); tiles &= tiles - 1u;
            ATT_LOAD(j);
            __syncthreads();
            ATT_WRITE(0);
            int jn = tiles ? __builtin_ctz(tiles) : -1;
            if (jn >= 0) ATT_LOAD(jn);
            __syncthreads();
            int cur = 0;
#pragma unroll 1
            while (true) {
                const bool act = br == 2 || ((wun >> j) & 1u);
                if (act) {
                    qkt<true>(p0, p1, K_lds + cur, r32, hi, qr);
                    if (br == 1) {
                        if (!((selmask >> j) & 1u)) {
#pragma unroll
                            for (int r = 0; r < 16; ++r) { p0[r] = NEG; p1[r] = NEG; } }
                        if (j == qb) {
#pragma unroll
                            for (int r = 0; r < 16; ++r) { if (crow(r, hi) > qi) p0[r] = NEG; if (crow(r, hi) + 32 > qi) p1[r] = NEG; } }
                    } else if (j == qb || j == qb - 8) {
                        const int dq = tq - j * 64;
#pragma unroll
                        for (int r = 0; r < 16; ++r) { if ((unsigned)(dq - crow(r, hi)) > 512u) p0[r] = NEG; if ((unsigned)(dq - crow(r, hi) - 32) > 512u) p1[r] = NEG; }
                    }
                    partialSM(p0, p1, m_reg, mn, alpha); finishSM(p0, p1, alpha, l_reg, pa0, pa1, pa2, pa3);
                    if (__any(alpha < 1.f)) { if (hi == 0) al_l[r32] = alpha; asm volatile("s_waitcnt lgkmcnt(0)" ::: "memory");
#pragma unroll
                        for (int d = 0; d < 4; ++d)
#pragma unroll
                            for (int r = 0; r < 16; ++r) o[d][r] *= al_l[crow(r, hi)]; }
                    pv_tile(o, vb0 + cur, pa0, pa1, pa2, pa3);
                }
                if (jn < 0) break;
                ATT_WRITE(cur ^ 32768);
                j = jn; tiles &= tiles - 1u; jn = tiles ? __builtin_ctz(tiles) : -1;
                if (jn >= 0) ATT_LOAD(jn);
                __syncthreads();
                cur ^= 32768;
            }
#undef ATT_LOAD
#undef ATT_WRITE
            if (hi == 0) sc_l[r32] = l_reg > 0.f ? GATp[(size_t)trow * 24 + (g * 4 + hh) * 3 + br] / l_reg : 0.f;
            asm volatile("s_waitcnt lgkmcnt(0)" ::: "memory");
#pragma unroll
            for (int d = 0; d < 4; ++d)
#pragma unroll
                for (int r4 = 0; r4 < 4; ++r4) { f32x4 v = ata[(d * 4 + r4) * 64];
#pragma unroll
                    for (int e = 0; e < 4; ++e) { v[e] += o[d][r4 * 4 + e] * sc_l[crow(r4 * 4 + e, hi)]; o[d][r4 * 4 + e] = v[e]; }
                    if (br == 1) { ata[(d * 4 + r4) * 64] = v;
#pragma unroll
                        for (int e = 0; e < 4; ++e) o[d][r4 * 4 + e] = 0.f; } }
            m_reg = -1e30f; l_reg = 0.f;
        }
        bf16* OM = (bf16*)(wsl + WS_OMIX);
#pragma unroll
        for (int r = 0; r < 16; ++r) { const int rw = wid * 32 + crow(r, hi); bf16* op = OM + (size_t)(b * SEQ + q0 + (rw >> 2)) * DM + (g * 4 + (rw & 3)) * 128;
#pragma unroll
            for (int d = 0; d < 4; ++d) { const float v = o[d][r]; const float vn = __shfl_xor(v, 1);
                if ((r32 & 1) == 0) *(unsigned*)(op + d * 32 + r32) = pg8::cvt_pk_bf16(v, vn); } }
    }
    __syncthreads();
}

__device__ __forceinline__ void phase_resid(Frame& F, int l, int which  ) {
    const int lane = F.lane, gw = F.bid * NWAVES + F.wave, NGW = F.G * NWAVES;
    const float* gpost = (which == 0 ? ((const float*)F.in[22]) : ((const float*)F.in[27])) + l * DM;
    for (int r = gw; r < MT; r += NGW) {
        const float* md = ((float*)(F.ws + WS_MOD)) + ((size_t)l * 12 + modrow(r)) * 12288;
        const float* ga = md + (which == 0 ? 4096 : 10240);
        const f32x4* xr = (const f32x4*)((which == 0) ? xrow_in(F, l, r) : ((float*)(F.ws + WS_X)) + (size_t)r * DM) + lane;
        const u32x2* mr = (const u32x2*)(((const bf16*)(F.ws + WS_MIX)) + (size_t)r * DM) + lane;
        f32x4 v[8], m[8]; float ss = 0.f;
#pragma unroll
        for (int j = 0; j < 8; ++j) { v[j] = xr[64 * j]; const u32x2 mb = mr[64 * j]; m[j] = (f32x4){__uint_as_float(mb.x << 16), __uint_as_float(mb.x & 0xffff0000u), __uint_as_float(mb.y << 16), __uint_as_float(mb.y & 0xffff0000u)}; ss += (m[j].x * m[j].x + m[j].y * m[j].y) + (m[j].z * m[j].z + m[j].w * m[j].w); }
        ss = wave_sum(ss);
        const float rs = 1.0f / sqrtf(ss * (1.0f / DM) + EPS);
#pragma unroll
        for (int j = 0; j < 8; ++j) { const int c = (lane + 64 * j) * 4; v[j] = v[j] + *(const f32x4*)(ga + c) * (m[j] * rs * *(const f32x4*)(gpost + c)); }
        if (which == 1 && l == NL - 1) {
            f32x4* o = (f32x4*)(r < MP ? F.out + O_YP + (size_t)r * DM : F.out + O_YS + (size_t)(r - MP) * DM) + lane;
#pragma unroll
            for (int j = 0; j < 8; ++j) o[64 * j] = v[j];
        } else {
            f32x4* xo = (f32x4*)(((float*)(F.ws + WS_X)) + (size_t)r * DM) + lane;
#pragma unroll
            for (int j = 0; j < 8; ++j) xo[64 * j] = v[j];
            if (which == 0) norm_mod_store(v, ((const float*)F.in[23]) + l * DM, md + 6144, md + 8192, ((bf16*)(F.ws + WS_H)) + (size_t)r * DM, lane);
            else { const float* md2 = ((float*)(F.ws + WS_MOD)) + ((size_t)(l + 1) * 12 + modrow(r)) * 12288; norm_mod_store(v, ((const float*)F.in[12]) + (l + 1) * DM, md2, md2 + 2048, ((bf16*)(F.ws + WS_H)) + (size_t)r * DM, lane); }
        }
    }
}

constexpr int PH_LAYER0 = 3, PH_PER_LAYER = 10, NPHASE = PH_LAYER0 + NL * PH_PER_LAYER;
#ifndef PHMASK
#define PHMASK 0xFFFFFFFFu
#endif
#define EN(b) (((PHMASK) >> (b)) & 1u)
#ifndef REP_MASK
#define REP_MASK 0u
#endif
#ifndef REP_N
#define REP_N 3
#endif
#define REPS(b, on) (((((REP_MASK) >> (b)) & 1u) && (on)) ? 1 + (REP_N) : 1)
#define IN(k) (lo <= (k) && (k) < hi)
#define SEAM(k) do { if (IN(k) && IN((k) + 1)) xcd_barrier(bar); } while (0)
template <int l>
__device__ __forceinline__ void layer_phases(Frame& F, const int lo, const int hi, const XcdBarrier& bar) {

        const int p0 = PH_LAYER0 + l * PH_PER_LAYER;
        if (EN(3) && IN(p0 + 0)) for (int rep = 0; rep < REPS(3, l == 0); ++rep, ((REP_MASK) ? __syncthreads() : (void)0)) {
            if constexpr (l == 0) { if (F.bid & 1) phase_cmp_direct(F); }
            pg8::Gemm g{((bf16*)(F.ws + WS_H)), ((bf16*)(F.ws + WS_WIN)) + (size_t)l * NIN * DM, DM, DM}; pg8::StaticOrder S; S.init(MP, NIN, F.G, F.bid); pg8::EpiF32 E{((float*)(F.ws + WS_PROJ)), NIN};
            pg8::gemm_phase<pg8::EpiF32, pg8::StaticOrder, true, true>(F.lds, g, S, E);
            if (F.bid >= 96)
                skinny_wave<0, 64>(F, ((bf16*)(F.ws + WS_H)) + (size_t)MP * DM, DM, ((bf16*)(F.ws + WS_WIN)) + (size_t)l * NIN * DM, DM, NIN / 16, ((float*)(F.ws + WS_PROJ)), nullptr, NIN, (F.bid - 96) * NWAVES + F.wave, 160 * NWAVES);
            __syncthreads();
            if (l == 0) { if (F.bid >= 224) tr_range(F, TR_I_L + TR_I_IN, TR_I_OUT, (F.bid - 224) * NWAVES + F.wave, 32 * NWAVES);
                          else if (F.bid >= 96) tr_range(F, TR_I_L, TR_I_IN, (F.bid - 96) * NWAVES + F.wave, 128 * NWAVES); }
            else { if (F.bid >= 96) tr_range(F, TR_I_L + TR_I_IN + TR_I_OUT + TR_I_GU, TR_I_DN, (F.bid - 96) * NWAVES + F.wave, 160 * NWAVES); }
            if constexpr (l == 0) { if (!(F.bid & 1)) phase_cmp_direct(F); }
        }
        SEAM(p0 + 0);
        if (EN(4) && IN(p0 + 1)) for (int rep = 0; rep < REPS(4, l == 0); ++rep, ((REP_MASK) ? __syncthreads() : (void)0)) { phase_postproj(F, l); }
        SEAM(p0 + 1);
        if (EN(5) && IN(p0 + 2)) for (int rep = 0; rep < REPS(5, l == 0); ++rep, ((REP_MASK) ? __syncthreads() : (void)0)) {
            pg8::Gemm g{((bf16*)(F.ws + WS_AP)), ((bf16*)(F.ws + WS_W1)) + (size_t)l * 2 * 256 * 8192, 256, 8192}; pg8::SplitOrder S{64, F.G, F.bid, 32, 1}; pg8::EpiPart E{((float*)(F.ws + WS_HIDP)), (size_t)512 * 256};
            pg8::gemm_phase<pg8::EpiPart, pg8::SplitOrder, true, true>(F.lds, g, S, E);
#ifndef NO_SCAN
            phase_gdn_scan_naive(F, l);
#endif
            phase_gdn_pre(F, l);
        }
        SEAM(p0 + 2);
        if (EN(6) && IN(p0 + 3)) for (int rep = 0; rep < REPS(6, l == 0); ++rep, ((REP_MASK) ? __syncthreads() : (void)0)) { cmp_finish<32>(F, ((float*)(F.ws + WS_HIDP)), (size_t)512 * 256, 512, 256, ((const float*)F.in[16]) + (size_t)l * 2 * 32768, ((float*)(F.ws + WS_CBP)), 64);
            cmp_finish16<4>(F, ((float*)(F.ws + WS_HIDS)), (size_t)16384 * 256, 8192, 4096, ((const float*)F.in[16]), ((float*)(F.ws + WS_CBS)), 64, l * 8192, ((const float*)(F.ws + WS_PEC)));
            phase_gdn_scan(F, l); }
        SEAM(p0 + 3);
        if (EN(7) && IN(p0 + 4)) for (int rep = 0; rep < REPS(7, l == 0); ++rep, ((REP_MASK) ? __syncthreads() : (void)0)) { phase_nsa_mfma(F, l); phase_nsa_sample(F, l); phase_gdn_out(F, l); }
        SEAM(p0 + 4);
        if (EN(8) && IN(p0 + 5)) for (int rep = 0; rep < REPS(8, l == 0); ++rep, ((REP_MASK) ? __syncthreads() : (void)0)) {
            pg8::Gemm g{((bf16*)(F.ws + WS_OMIX)), ((bf16*)(F.ws + WS_WOUT)) + (size_t)l * DM * DM, DM, DM}; pg8::StaticOrder S; S.init(MP, DM, F.G, F.bid); pg8::EpiBf16 E{((bf16*)(F.ws + WS_MIX)), DM};
            pg8::gemm_phase<pg8::EpiBf16, pg8::StaticOrder, true, true>(F.lds, g, S, E);
            skinny_gemm<2, 8>(F, ((bf16*)(F.ws + WS_OMIX)) + (size_t)MP * DM, DM, ((bf16*)(F.ws + WS_WOUT)) + (size_t)l * DM * DM, DM, DM / 16, nullptr, ((bf16*)(F.ws + WS_MIX)), DM);
        }
        SEAM(p0 + 5);
        if (EN(9) && IN(p0 + 6)) for (int rep = 0; rep < REPS(9, l == 0); ++rep, ((REP_MASK) ? __syncthreads() : (void)0)) { phase_resid(F, l, 0); }
        SEAM(p0 + 6);
        if (EN(10) && IN(p0 + 7)) for (int rep = 0; rep < REPS(10, l == 0); ++rep, ((REP_MASK) ? __syncthreads() : (void)0)) {
            pg8::Gemm g{((bf16*)(F.ws + WS_H)), ((bf16*)(F.ws + WS_WGU)) + (size_t)l * NGU * DM, DM, DM}; pg8::StaticOrder S; S.init(MP, NGU, F.G, F.bid); pg8::EpiSwiGLU E{((bf16*)(F.ws + WS_ACT)), DFF};
            pg8::gemm_phase<pg8::EpiSwiGLU, pg8::StaticOrder, true, true>(F.lds, g, S, E);
            if (F.bid >= 128)
                skinny_wave<1, 64>(F, ((bf16*)(F.ws + WS_H)) + (size_t)MP * DM, DM, ((bf16*)(F.ws + WS_WGU)) + (size_t)l * NGU * DM, DM, DFF / 16, nullptr, ((bf16*)(F.ws + WS_ACT)), DFF, (F.bid - 128) * NWAVES + F.wave, 128 * NWAVES);
            __syncthreads();
            if (l == 0 && F.bid >= 128) tr_range(F, TR_I_L + TR_I_IN + TR_I_OUT, TR_I_GU, (F.bid - 128) * NWAVES + F.wave, 128 * NWAVES);
        }
        SEAM(p0 + 7);
        if (EN(11) && IN(p0 + 8)) for (int rep = 0; rep < REPS(11, l == 0); ++rep, ((REP_MASK) ? __syncthreads() : (void)0)) {
            pg8::Gemm g{((bf16*)(F.ws + WS_ACT)), ((bf16*)(F.ws + WS_WDN)) + (size_t)l * DM * DFF, DFF, DFF}; pg8::StaticOrder S; S.init(MP, DM, F.G, F.bid); pg8::EpiBf16 E{((bf16*)(F.ws + WS_MIX)), DM};
            pg8::gemm_phase<pg8::EpiBf16, pg8::StaticOrder, true, true>(F.lds, g, S, E);
            skinny_gemm<2, 22>(F, ((bf16*)(F.ws + WS_ACT)) + (size_t)MP * DFF, DFF, ((bf16*)(F.ws + WS_WDN)) + (size_t)l * DM * DFF, DFF, DM / 16, nullptr, ((bf16*)(F.ws + WS_MIX)), DM);
        }
        SEAM(p0 + 8);
        if (EN(12) && IN(p0 + 9)) for (int rep = 0; rep < REPS(12, l == 0); ++rep, ((REP_MASK) ? __syncthreads() : (void)0)) { phase_resid(F, l, 1); }
        SEAM(p0 + 9);
    }

__global__ void __launch_bounds__(NTHR, 2) mega(Args args) {
    extern __shared__ __attribute__((aligned(16))) unsigned char lds_raw[];
    Frame F;
    F.lds = (LAS unsigned char*)lds_raw;
    F.tid = threadIdx.x; F.lane = F.tid & 63; F.wave = __builtin_amdgcn_readfirstlane(F.tid >> 6); F.G = gridDim.x; F.bid = blockIdx.x;
    F.in = args.in; F.out = args.out; F.ws = args.ws;
    unsigned char* ws = args.ws;
    volatile LAS unsigned* MISC = (volatile LAS unsigned*)(F.lds + MISC_OFF);
    if (F.tid < 16) MISC[F.tid] = 0u;
    __syncthreads();
    const int lo = args.ph_lo, hi = args.ph_hi;
    unsigned* barw = (unsigned*)(ws + WS_CTL) + CW_BAR;
    XcdBarrier bar; bar.bar = barw; bar.x = 0; bar.st = MISC + 8;
    if (hi - lo > 1) bar = xcd_barrier_post(barw, MISC + 8);

    if (EN(0) && IN(0)) for (int rep = 0; rep < REPS(0, true); ++rep, ((REP_MASK) ? __syncthreads() : (void)0)) { phase_prologue(F); }
    SEAM(0);
    if (EN(1) && IN(1)) for (int rep = 0; rep < REPS(1, true); ++rep, ((REP_MASK) ? __syncthreads() : (void)0)) {
        ada_reduce(F);
    }
    SEAM(1);
    if (EN(2) && IN(2)) for (int rep = 0; rep < REPS(2, true); ++rep, ((REP_MASK) ? __syncthreads() : (void)0)) { phase_norm1(F, 0); pe_w1(F); }
    SEAM(2);
    layer_phases<0>(F, lo, hi, bar);
    layer_phases<1>(F, lo, hi, bar);
#undef IN
#undef SEAM
}

extern "C" void kernel_launch(void* const* d_in, const int* in_sizes, int n_in, void* d_out, int out_size, void* d_ws, size_t ws_size, hipStream_t stream) {
    static int grid = 0;
    if (grid == 0) {
        if (n_in != 28 || (size_t)out_size != O_END || ws_size < WS_END) { fprintf(stderr, "kernel_launch: unexpected shapes: n_in %d out %d (want %zu) ws %zu (want %zu)\n", n_in, out_size, (size_t)O_END, ws_size, (size_t)WS_END); grid = -1; return; }
        int dev = 0, cus = 0, per_cu = 0;
        if (hipGetDevice(&dev) != hipSuccess || hipDeviceGetAttribute(&cus, hipDeviceAttributeMultiprocessorCount, dev) != hipSuccess) { grid = -1; return; }
        if (hipFuncSetAttribute((const void*)mega, hipFuncAttributeMaxDynamicSharedMemorySize, LDS_BYTES) != hipSuccess) { fprintf(stderr, "kernel_launch: hipFuncSetAttribute failed\n"); grid = -1; return; }
        if (hipOccupancyMaxActiveBlocksPerMultiprocessor(&per_cu, (const void*)mega, NTHR, LDS_BYTES) != hipSuccess || per_cu < 1) fprintf(stderr, "kernel_launch: occupancy query reports %d\n", per_cu);
        (void)hipGetLastError();
        grid = cus;
    }
    if (grid < 0) return;
    if (hipMemsetAsync((char*)d_ws + WS_CTL, 0, CTL_BYTES, stream) != hipSuccess) return;
    Args a{};
    for (int i = 0; i < 28; ++i) a.in[i] = d_in[i];
    a.out = (float*)d_out; a.ws = (unsigned char*)d_ws;
#if ONE_LAUNCH
    a.ph_lo = 0; a.ph_hi = NPHASE;
    hipLaunchKernelGGL(mega, dim3(grid), dim3(NTHR), LDS_BYTES, stream, a);
#else
    for (int p = 0; p < NPHASE; ++p) { a.ph_lo = p; a.ph_hi = p + 1; hipLaunchKernelGGL(mega, dim3(grid), dim3(NTHR), LDS_BYTES, stream, a); }
#endif
}
```
